# Optimizing an MI355X kernel written in HIP

```python
import math
import jax, jax.numpy as jnp
from jax import lax
import numpy as np

D_MODEL = 1024
BATCH = 8
SEQ = 2048
DEPTH = 2
DEC_BATCH = 128
DEC_SEQ = 4
PAST_LEN = 16384
PAGE_SIZE = 128

MIX_W = D_MODEL
RET_W = (3 * MIX_W) // 8
S5_W = MIX_W // 4
GLA_W = MIX_W - RET_W - S5_W
RET_HEAD_DIM = 64
RET_HEADS = RET_W // RET_HEAD_DIM
ROPE_BASE = 10000.0
S5_CH_PER_GROUP = 16
S5_GROUPS = S5_W // S5_CH_PER_GROUP
S5_STATE = 64
S5_MIN_NEG = 1e-4
GLA_HEADS = 4
GLA_KEY_W = GLA_W // 2
GLA_DK = GLA_KEY_W // GLA_HEADS
GLA_DV = GLA_W // GLA_HEADS
GLA_RANK = 16
GLA_GATE_TEMP = 16.0
IN_COLS = 4 * RET_W + S5_W + 2 * GLA_KEY_W + 2 * GLA_W + GLA_RANK
D_FF = ((8 * D_MODEL // 3 + 127) // 128) * 128
CONV_W = 3
CHUNK = 64
EPS = 1e-6

kernel_name = 'hymba_style_retention_s5_gla_convffn_step'


def _in_split_points():
    sizes = [RET_W, RET_W, RET_W, RET_W, S5_W, GLA_KEY_W, GLA_KEY_W, GLA_W, GLA_W, GLA_RANK]
    pts, acc = [], 0
    for s in sizes[:-1]:
        acc += s
        pts.append(acc)
    return pts


def _rmsnorm(x, g):
    xf = x.astype(jnp.float32)
    y = xf * lax.rsqrt(jnp.mean(xf * xf, axis=-1, keepdims=True) + EPS)
    return (y * g.astype(jnp.float32)).astype(x.dtype)


def _rotary(x, pos):
    half = x.shape[-1] // 2
    inv = ROPE_BASE ** (-jnp.arange(half, dtype=jnp.float32) / half)
    ang = pos.astype(jnp.float32)[:, None] * inv[None, :]
    cos = jnp.cos(ang)[None, :, None, :]
    sin = jnp.sin(ang)[None, :, None, :]
    x1, x2 = x[..., :half], x[..., half:]
    return jnp.concatenate([x1 * cos - x2 * sin, x1 * sin + x2 * cos], axis=-1)


def _retention_chunked(q, k, v, s0):
    bsz, h, L, dk = q.shape
    dv = v.shape[-1]
    c = min(CHUNK, L)
    n = L // c
    log_gamma = jnp.log(1.0 - 2.0 ** (-5.0 - jnp.arange(h, dtype=jnp.float32)))
    q = q.reshape(bsz, h, n, c, dk)
    k = k.reshape(bsz, h, n, c, dk)
    v = v.reshape(bsz, h, n, c, dv)
    i = jnp.arange(c, dtype=jnp.float32)
    diff = i[:, None] - i[None, :]
    decay_mask = jnp.where(diff >= 0, jnp.exp(log_gamma[:, None, None] * jnp.maximum(diff, 0.0)), 0.0)
    scores = jnp.einsum('bhnid,bhnjd->bhnij', q, k) * decay_mask[None, :, None]
    o_intra = jnp.einsum('bhnij,bhnjv->bhniv', scores, v)
    k_to_end = k * jnp.exp(log_gamma[:, None] * (c - 1.0 - i)[None, :])[None, :, None, :, None]
    kv = jnp.einsum('bhnjd,bhnjv->bhndv', k_to_end, v)
    chunk_decay = jnp.exp(log_gamma * c)[None, :, None, None]

    def step(s, kv_c):
        return chunk_decay * s + kv_c, s

    s_last, s_prev = lax.scan(step, s0, jnp.moveaxis(kv, 2, 0))
    s_prev = jnp.moveaxis(s_prev, 0, 2)
    q_from_start = q * jnp.exp(log_gamma[:, None] * (i + 1.0)[None, :])[None, :, None, :, None]
    o_cross = jnp.einsum('bhnid,bhndv->bhniv', q_from_start, s_prev)
    return (o_intra + o_cross).reshape(bsz, h, L, dv), s_last


def _gla_chunked(q, k, v, log_g, s0):
    bsz, h, L, dk = q.shape
    dv = v.shape[-1]
    c = min(CHUNK, L)
    n = L // c
    q = q.reshape(bsz, h, n, c, dk)
    k = k.reshape(bsz, h, n, c, dk)
    log_g = log_g.reshape(bsz, h, n, c, dk)
    v = v.reshape(bsz, h, n, c, dv)
    b_cum = jnp.cumsum(log_g, axis=3)
    b_end = b_cum[:, :, :, -1:, :]
    q_in = q * jnp.exp(b_cum)
    k_in = k * jnp.exp(-b_cum)
    causal = jnp.tril(jnp.ones((c, c), dtype=bool))
    scores = jnp.where(causal, jnp.einsum('bhnid,bhnjd->bhnij', q_in, k_in), 0.0)
    o_intra = jnp.einsum('bhnij,bhnjv->bhniv', scores, v)
    kv = jnp.einsum('bhnjd,bhnjv->bhndv', k * jnp.exp(b_end - b_cum), v)
    decay = jnp.exp(b_end[:, :, :, 0, :])

    def step(s, inp):
        d_c, kv_c = inp
        return d_c[..., None] * s + kv_c, s

    s_last, s_prev = lax.scan(step, s0, (jnp.moveaxis(decay, 2, 0), jnp.moveaxis(kv, 2, 0)))
    s_prev = jnp.moveaxis(s_prev, 0, 2)
    o_cross = jnp.einsum('bhnid,bhndv->bhniv', q_in, s_prev)
    return (o_intra + o_cross).reshape(bsz, h, L, dv), s_last


def _s5_scan(u, h0_re, h0_im, lam_re, lam_im, log_dt, b_re, b_im, c_re, c_im, d):
    f32 = jnp.float32
    bsz, L, _ = u.shape
    ug = u.reshape(bsz, L, S5_GROUPS, S5_CH_PER_GROUP)
    lr = jnp.minimum(lam_re.astype(f32), -S5_MIN_NEG)
    li = lam_im.astype(f32)
    dt = jnp.exp(log_dt.astype(f32))[:, None]
    mag = jnp.exp(lr * dt)
    ar = mag * jnp.cos(li * dt)
    ai = mag * jnp.sin(li * dt)
    den = lr * lr + li * li
    cr = ((ar - 1.0) * lr + ai * li) / den
    ci = (ai * lr - (ar - 1.0) * li) / den
    b_re = b_re.astype(f32)
    b_im = b_im.astype(f32)
    bbar_re = cr[..., None] * b_re - ci[..., None] * b_im
    bbar_im = cr[..., None] * b_im + ci[..., None] * b_re
    xr = jnp.einsum('blgh,gph->blgp', ug, bbar_re)
    xi = jnp.einsum('blgh,gph->blgp', ug, bbar_im)
    ar_b = jnp.broadcast_to(ar, xr.shape)
    ai_b = jnp.broadcast_to(ai, xr.shape)

    def combine(e1, e2):
        a1r, a1i, b1r, b1i = e1
        a2r, a2i, b2r, b2i = e2
        return (a2r * a1r - a2i * a1i,
                a2r * a1i + a2i * a1r,
                a2r * b1r - a2i * b1i + b2r,
                a2r * b1i + a2i * b1r + b2i)

    _, _, hr, hi = lax.associative_scan(combine, (ar_b, ai_b, xr, xi), axis=1)
    t1 = jnp.arange(1, L + 1, dtype=f32)[:, None, None]
    pmag = jnp.exp(lr * dt * t1)
    pph = li * dt * t1
    pr = pmag * jnp.cos(pph)
    pi = pmag * jnp.sin(pph)
    h0r = h0_re.astype(f32)[:, None]
    h0i = h0_im.astype(f32)[:, None]
    hr = hr + pr * h0r - pi * h0i
    hi = hi + pr * h0i + pi * h0r
    y = jnp.einsum('gcp,blgp->blgc', c_re.astype(f32), hr) - jnp.einsum('gcp,blgp->blgc', c_im.astype(f32), hi)
    y = y.reshape(bsz, L, S5_W) + d.astype(f32) * u
    return y, hr[:, -1], hi[:, -1]


def _layer(x, pos, s_ret, s5r, s5i, s_gla, conv_buf,
           norm_mix_g, w_in, ret_norm_g, ret_norm_b,
           s5_lambda_re, s5_lambda_im, s5_log_dt, s5_b_re, s5_b_im, s5_c_re, s5_c_im, s5_d,
           s5_glu_w, s5_glu_b, gla_gate_w, gla_gate_b, gla_norm_g, w_out,
           norm_ffn_g, ffn_w_in, ffn_conv_w, ffn_conv_b, ffn_w_out):
    f32 = jnp.float32
    bsz, L, _ = x.shape
    h = _rmsnorm(x, norm_mix_g)
    proj = (h @ w_in).astype(f32)
    rq, rk, rv, rg, su, gq, gk, gv, gg, glr = jnp.split(proj, _in_split_points(), axis=-1)
    rq = _rotary(rq.reshape(bsz, L, RET_HEADS, RET_HEAD_DIM), pos)
    rk = _rotary(rk.reshape(bsz, L, RET_HEADS, RET_HEAD_DIM), pos) * (RET_HEAD_DIM ** -0.5)
    rv = rv.reshape(bsz, L, RET_HEADS, RET_HEAD_DIM)
    o_ret, s_ret_new = _retention_chunked(rq.transpose(0, 2, 1, 3), rk.transpose(0, 2, 1, 3),
                                          rv.transpose(0, 2, 1, 3), s_ret.astype(f32))
    o_ret = o_ret.transpose(0, 2, 1, 3)
    mu = jnp.mean(o_ret, axis=-1, keepdims=True)
    var = jnp.mean(jnp.square(o_ret - mu), axis=-1, keepdims=True)
    o_ret = ((o_ret - mu) * lax.rsqrt(var + EPS)).reshape(bsz, L, RET_W)
    o_ret = (o_ret * ret_norm_g.astype(f32) + ret_norm_b.astype(f32)) * jax.nn.silu(rg)
    y5, s5r_new, s5i_new = _s5_scan(su, s5r, s5i, s5_lambda_re, s5_lambda_im, s5_log_dt,
                                    s5_b_re, s5_b_im, s5_c_re, s5_c_im, s5_d)
    y5 = jax.nn.gelu(y5)
    o_s5 = y5 * jax.nn.sigmoid(y5 @ s5_glu_w.astype(f32) + s5_glu_b.astype(f32))
    log_g = jax.nn.log_sigmoid(glr @ gla_gate_w.astype(f32) + gla_gate_b.astype(f32)) / GLA_GATE_TEMP
    gq = gq.reshape(bsz, L, GLA_HEADS, GLA_DK).transpose(0, 2, 1, 3) * (GLA_DK ** -0.5)
    gk = gk.reshape(bsz, L, GLA_HEADS, GLA_DK).transpose(0, 2, 1, 3)
    gv = gv.reshape(bsz, L, GLA_HEADS, GLA_DV).transpose(0, 2, 1, 3)
    log_g = log_g.reshape(bsz, L, GLA_HEADS, GLA_DK).transpose(0, 2, 1, 3)
    o_gla, s_gla_new = _gla_chunked(gq, gk, gv, log_g, s_gla.astype(f32))
    o_gla = o_gla.transpose(0, 2, 1, 3)
    o_gla = o_gla * lax.rsqrt(jnp.mean(o_gla * o_gla, axis=-1, keepdims=True) + EPS) * gla_norm_g.astype(f32)
    o_gla = o_gla.reshape(bsz, L, GLA_W) * jax.nn.silu(gg)
    mix = jnp.concatenate([o_ret, o_s5, o_gla], axis=-1).astype(x.dtype)
    x = x + mix @ w_out
    h = _rmsnorm(x, norm_ffn_g)
    up = h @ ffn_w_in
    a, gate = jnp.split(up, 2, axis=-1)
    padded = jnp.concatenate([conv_buf.astype(a.dtype), a], axis=1)
    conv = ffn_conv_b + padded[:, 0:L] * ffn_conv_w[0]
    for t in range(1, CONV_W):
        conv = conv + padded[:, t:t + L] * ffn_conv_w[t]
    conv_new = padded[:, L:]
    x = x + (jax.nn.gelu(conv) * gate) @ ffn_w_out
    return x, s_ret_new, s5r_new, s5i_new, s_gla_new, conv_new


def _run_trunk(x, pos, s_ret, s5r, s5i, s_gla, conv, norm_mix_g, w_in, ret_norm_g, ret_norm_b,
               s5_lambda_re, s5_lambda_im, s5_log_dt, s5_b_re, s5_b_im, s5_c_re, s5_c_im, s5_d,
               s5_glu_w, s5_glu_b, gla_gate_w, gla_gate_b, gla_norm_g, w_out,
               norm_ffn_g, ffn_w_in, ffn_conv_w, ffn_conv_b, ffn_w_out, norm_final_g):
    new_ret, new_s5r, new_s5i, new_gla, new_conv = [], [], [], [], []
    for l in range(DEPTH):
        x, a1, a2, a3, a4, a5 = _layer(
            x, pos, s_ret[l], s5r[l], s5i[l], s_gla[l], conv[l],
            norm_mix_g[l], w_in[l], ret_norm_g[l], ret_norm_b[l],
            s5_lambda_re[l], s5_lambda_im[l], s5_log_dt[l], s5_b_re[l], s5_b_im[l],
            s5_c_re[l], s5_c_im[l], s5_d[l], s5_glu_w[l], s5_glu_b[l],
            gla_gate_w[l], gla_gate_b[l], gla_norm_g[l], w_out[l],
            norm_ffn_g[l], ffn_w_in[l], ffn_conv_w[l], ffn_conv_b[l], ffn_w_out[l])
        new_ret.append(a1)
        new_s5r.append(a2)
        new_s5i.append(a3)
        new_gla.append(a4)
        new_conv.append(a5)
    y = _rmsnorm(x, norm_final_g)
    return (y, jnp.stack(new_ret), jnp.stack(new_s5r), jnp.stack(new_s5i),
            jnp.stack(new_gla), jnp.stack(new_conv))


def setup_inputs(seed: int = 0) -> dict:
    key = jax.random.key(seed)
    ks = jax.random.split(key, 32)
    f32 = jnp.float32

    def nrm(i, shape, scale):
        return jax.random.normal(ks[i], shape, f32) * scale

    G, P, H16 = S5_GROUPS, S5_STATE, S5_CH_PER_GROUP
    return {
        'x_prompt': nrm(0, (BATCH, SEQ, D_MODEL), 1.0),
        'x_sample': nrm(1, (DEC_BATCH, DEC_SEQ, D_MODEL), 1.0),
        'state_ret': nrm(2, (DEPTH, DEC_BATCH, RET_HEADS, RET_HEAD_DIM, RET_HEAD_DIM), 0.3),
        'state_s5_re': nrm(3, (DEPTH, DEC_BATCH, G, P), 0.5),
        'state_s5_im': nrm(4, (DEPTH, DEC_BATCH, G, P), 0.5),
        'state_gla': nrm(5, (DEPTH, DEC_BATCH, GLA_HEADS, GLA_DK, GLA_DV), 0.3),
        'state_ffn_conv': nrm(6, (DEPTH, DEC_BATCH, CONV_W - 1, D_FF), 1.0),
        'norm_mix_g': 1.0 + nrm(7, (DEPTH, D_MODEL), 0.02),
        'w_in': nrm(8, (DEPTH, D_MODEL, IN_COLS), D_MODEL ** -0.5),
        'ret_norm_g': 1.0 + nrm(9, (DEPTH, RET_W), 0.02),
        'ret_norm_b': nrm(10, (DEPTH, RET_W), 0.02),
        's5_lambda_re': -0.5 + nrm(11, (DEPTH, G, P), 0.01),
        's5_lambda_im': jnp.pi * jnp.arange(P, dtype=f32) + nrm(12, (DEPTH, G, P), 0.01),
        's5_log_dt': jax.random.uniform(ks[13], (DEPTH, G), f32, math.log(1e-3), math.log(1e-1)),
        's5_b_re': nrm(14, (DEPTH, G, P, H16), (2.0 * H16) ** -0.5),
        's5_b_im': nrm(15, (DEPTH, G, P, H16), (2.0 * H16) ** -0.5),
        's5_c_re': nrm(16, (DEPTH, G, H16, P), (2.0 * P) ** -0.5),
        's5_c_im': nrm(17, (DEPTH, G, H16, P), (2.0 * P) ** -0.5),
        's5_d': nrm(18, (DEPTH, S5_W), 0.5),
        's5_glu_w': nrm(19, (DEPTH, S5_W, S5_W), S5_W ** -0.5),
        's5_glu_b': nrm(20, (DEPTH, S5_W), 0.02),
        'gla_gate_w': nrm(21, (DEPTH, GLA_RANK, GLA_KEY_W), GLA_RANK ** -0.5),
        'gla_gate_b': nrm(22, (DEPTH, GLA_KEY_W), 0.1),
        'gla_norm_g': 1.0 + nrm(23, (DEPTH, GLA_DV), 0.02),
        'w_out': nrm(24, (DEPTH, MIX_W, D_MODEL), MIX_W ** -0.5),
        'norm_ffn_g': 1.0 + nrm(25, (DEPTH, D_MODEL), 0.02),
        'ffn_w_in': nrm(26, (DEPTH, D_MODEL, 2 * D_FF), D_MODEL ** -0.5),
        'ffn_conv_w': nrm(27, (DEPTH, CONV_W, D_FF), CONV_W ** -0.5),
        'ffn_conv_b': nrm(28, (DEPTH, D_FF), 0.02),
        'ffn_w_out': nrm(29, (DEPTH, D_FF, D_MODEL), D_FF ** -0.5),
        'norm_final_g': 1.0 + nrm(30, (D_MODEL,), 0.02),
    }


def reference(x_prompt, x_sample, state_ret, state_s5_re, state_s5_im, state_gla, state_ffn_conv,
              norm_mix_g, w_in, ret_norm_g, ret_norm_b,
              s5_lambda_re, s5_lambda_im, s5_log_dt, s5_b_re, s5_b_im, s5_c_re, s5_c_im, s5_d,
              s5_glu_w, s5_glu_b, gla_gate_w, gla_gate_b, gla_norm_g, w_out,
              norm_ffn_g, ffn_w_in, ffn_conv_w, ffn_conv_b, ffn_w_out, norm_final_g):
    f32 = jnp.float32
    bp, lp, _ = x_prompt.shape
    bs, ls, _ = x_sample.shape
    pos_prompt = jnp.arange(lp, dtype=jnp.int32)
    pos_sample = PAST_LEN + jnp.arange(ls, dtype=jnp.int32)
    z_ret = jnp.zeros((DEPTH, bp, RET_HEADS, RET_HEAD_DIM, RET_HEAD_DIM), f32)
    z_s5 = jnp.zeros((DEPTH, bp, S5_GROUPS, S5_STATE), f32)
    z_gla = jnp.zeros((DEPTH, bp, GLA_HEADS, GLA_DK, GLA_DV), f32)
    z_conv = jnp.zeros((DEPTH, bp, CONV_W - 1, D_FF), x_prompt.dtype)
    y_prompt, ret_p, s5re_p, s5im_p, gla_p, conv_p = _run_trunk(
        x_prompt, pos_prompt, z_ret, z_s5, z_s5, z_gla, z_conv,
        norm_mix_g, w_in, ret_norm_g, ret_norm_b,
        s5_lambda_re, s5_lambda_im, s5_log_dt, s5_b_re, s5_b_im, s5_c_re, s5_c_im, s5_d,
        s5_glu_w, s5_glu_b, gla_gate_w, gla_gate_b, gla_norm_g, w_out,
        norm_ffn_g, ffn_w_in, ffn_conv_w, ffn_conv_b, ffn_w_out, norm_final_g)
    y_sample, ret_s, s5re_s, s5im_s, gla_s, conv_s = _run_trunk(
        x_sample, pos_sample, state_ret, state_s5_re, state_s5_im, state_gla, state_ffn_conv,
        norm_mix_g, w_in, ret_norm_g, ret_norm_b,
        s5_lambda_re, s5_lambda_im, s5_log_dt, s5_b_re, s5_b_im, s5_c_re, s5_c_im, s5_d,
        s5_glu_w, s5_glu_b, gla_gate_w, gla_gate_b, gla_norm_g, w_out,
        norm_ffn_g, ffn_w_in, ffn_conv_w, ffn_conv_b, ffn_w_out, norm_final_g)
    return (y_prompt, y_sample, ret_p, ret_s, s5re_p, s5re_s, s5im_p, s5im_s, gla_p, gla_s, conv_p, conv_s)
```

```cpp
#include <hip/hip_runtime.h>
#include <hip/hip_cooperative_groups.h>
#include <cstdio>
#include <cstdint>
namespace cg = cooperative_groups;
namespace pg8 {
#define PG8_LAS __attribute__((address_space(3)))
typedef unsigned short bf16_t;
typedef short bf16x8 __attribute__((ext_vector_type(8)));
typedef float f32x4 __attribute__((ext_vector_type(4)));
typedef unsigned u32x4 __attribute__((ext_vector_type(4)));
constexpr int BM = 256, BK = 64, HALF = 128, HTB = HALF * BK * 2  , STAGE_BYTES = 8 * HTB, NXCD = 8, WGM = 8;

__host__ __device__ __forceinline__ int lds_byte(int r, int c) { const int st = (r >> 4) * 2 + (c >> 5), rr = r & 15, cc = c & 31, ob = rr * 64 + cc * 2; return st * 1024 + (ob ^ (((ob >> 9) & 1) << 5)); }
__host__ __device__ __forceinline__ void stage_rc(int b, int& R, int& C) { const int st = b / 1024, sb = b % 1024, swz = sb ^ (((sb >> 9) & 1) << 5); R = (st >> 1) * 16 + swz / 64; C = (st & 1) * 32 + (swz % 64) / 2; }
__host__ __device__ __forceinline__ int perm32(int rho) { const int n = rho >> 4, i = rho & 15; return 8 * (i >> 2) + 4 * n + (i & 3); }

struct Unit { int pm, pn, ko; };
struct Gemm { const bf16_t* A; const bf16_t* Bt; int M, N, K, KL, MS; };

struct StaticOrder {
    int nM, nN, nwg, G, c;
    __host__ __device__ void init(int M, int N, int G_, int c_) { nM = M / BM; nN = N / BM; nwg = nM * nN; G = G_; c = c_; }
    __host__ __device__ bool next(int i, Unit& u) const {
        const long L = (long)i * G + c; if (L >= nwg) return false;
        int wgid = (int)L; { const int q = nwg / NXCD, r = nwg % NXCD, xcd = wgid % NXCD, off = wgid / NXCD; wgid = (xcd < r ? xcd * (q + 1) : r * (q + 1) + (xcd - r) * q) + off; }
        const int nig = WGM * nN, gid = wgid / nig, fm = gid * WGM, gsz = (nM - fm) < WGM ? (nM - fm) : WGM;
        u.pm = fm + ((wgid % nig) % gsz); u.pn = (wgid % nig) / gsz; u.ko = 0; return true;
    }
    __device__ __forceinline__ void a_ready(const Unit&) const {}
    __device__ __forceinline__ void done(const Unit&) const {}
};

__device__ __forceinline__ unsigned cvt_pk_bf16(float lo, float hi) { unsigned r; asm volatile("v_cvt_pk_bf16_f32 %0, %1, %2" : "=v"(r) : "v"(lo), "v"(hi)); return r; }
typedef float f32x2 __attribute__((ext_vector_type(2)));
__device__ __forceinline__ f32x2 gelu_pk(f32x2 v) {
    const f32x2 av = __builtin_elementwise_abs(v), d = av * 0.2316418882f + 1.0f;
    f32x2 t; t.x = __builtin_amdgcn_rcpf(d.x); t.y = __builtin_amdgcn_rcpf(d.y);
    f32x2 q = t * 0.5307027145f + (-0.7265760135f); q = q * t + 0.7107068705f; q = q * t + (-0.142248368f); q = q * t + 0.127414796f; q = q * t;
    const f32x2 s = (v * v) * (-0.72134752044f);
    f32x2 e; e.x = __builtin_amdgcn_exp2f(s.x); e.y = __builtin_amdgcn_exp2f(s.y);
    const f32x2 m = v * (q * e), r = v - m;
    f32x2 o; o.x = v.x < 0.f ? m.x : r.x; o.y = v.y < 0.f ? m.y : r.y; return o;
}

template <int ACT  > struct EpiBf16 {
    static constexpr bool PERM = true, AFTER_DRAIN = false; static_assert(ACT == 0 || ACT == 1, "EpiBf16: ACT is 0 (none) or 1 (gelu_pk)");
    bf16_t* O; int ldc; const float* bias; int split_cols; size_t split_stride; float scale0;
    __device__ __forceinline__ void operator()(const f32x4 (&acc)[2][2][4][2], const Unit& u, int wr, int wc, int fr, int fq) const {
        const int row0 = u.pm * BM + wr * 64 + fr; int colt = u.pn * BM; bf16_t* base = O;
        float sc = 1.f; if (split_cols) { const int t = colt / split_cols; base += (size_t)t * split_stride; colt -= t * split_cols; if (t == 0) sc = scale0; }
        const int col0 = colt + wc * 32 + 8 * fq, bcol0 = u.pn * BM + wc * 32 + 8 * fq;
        f32x4 bv[2][2];
#pragma unroll
        for (int bj = 0; bj < 2; ++bj)
#pragma unroll
            for (int n = 0; n < 2; ++n) bv[bj][n] = bias ? *(const f32x4*)(bias + bcol0 + bj * HALF + 4 * n) : (f32x4){0.f, 0.f, 0.f, 0.f};
#pragma unroll
        for (int ai = 0; ai < 2; ++ai)
#pragma unroll
            for (int m = 0; m < 4; ++m) { bf16_t* rowp = base + (size_t)(row0 + ai * HALF + m * 16) * ldc + col0;
#pragma unroll
                for (int bj = 0; bj < 2; ++bj) { f32x4 v0 = acc[ai][bj][m][0] + bv[bj][0], v1 = acc[ai][bj][m][1] + bv[bj][1];
                    if (ACT == 1) { f32x2 a = gelu_pk((f32x2){v0[0], v0[1]}), b = gelu_pk((f32x2){v0[2], v0[3]}), c = gelu_pk((f32x2){v1[0], v1[1]}), d = gelu_pk((f32x2){v1[2], v1[3]});
                        v0 = (f32x4){a.x, a.y, b.x, b.y}; v1 = (f32x4){c.x, c.y, d.x, d.y}; }
                    v0 = v0 * sc; v1 = v1 * sc; u32x4 w; w.x = cvt_pk_bf16(v0[0], v0[1]); w.y = cvt_pk_bf16(v0[2], v0[3]); w.z = cvt_pk_bf16(v1[0], v1[1]); w.w = cvt_pk_bf16(v1[2], v1[3]);
                    *(u32x4*)(rowp + bj * HALF) = w; } }
    }
};
template <class Epi, class Sched, bool ALIGN_EPI = false, bool SP2 = false>
__device__ __forceinline__ void gemm_phase(PG8_LAS unsigned char* lds, const Gemm g, const Sched& S, const Epi& E) {
    int tid_ = threadIdx.x; asm volatile("" : "+v"(tid_)); const int tid = tid_, wid = __builtin_amdgcn_readfirstlane(tid >> 6), lane = tid & 63, wr = wid >> 2, wc = wid & 3, fr = lane & 15, fq = lane >> 4;
    const int K = g.K, nt = g.KL / BK;
    unsigned voffA[2], voffB[2];
#pragma unroll
    for (int i = 0; i < 2; ++i) { int R, C; stage_rc(tid * 16 + i * 8192, R, C); const int Rb = Epi::PERM ? ((R & ~31) + perm32(R & 31)) : R;
        voffA[i] = (unsigned)(R * K + C) * 2u; voffB[i] = (unsigned)(Rb * K + C) * 2u; }
    const size_t kstep = (size_t)(BK * 2);
    const size_t hstep = (size_t)HALF * K * 2;
    const size_t tstep = 2 * hstep;
    const size_t tstepA = (size_t)g.MS * K * 2;
    const unsigned ldsw = (unsigned)wid * 1024u;
    const int aoff = lds_byte(wr * 64 + fr, fq * 8), boff = lds_byte(wc * 32 + fr, fq * 8);
#define PG8_SA(b, h) (((b) * 2 + (h)) * HTB)
#define PG8_SB(b, h) ((4 + (b) * 2 + (h)) * HTB)
#define PG8_STAGE(bufoff, gbase, voff) do { _Pragma("unroll") for (int _i = 0; _i < 2; ++_i) \
        __builtin_amdgcn_global_load_lds((const unsigned*)((const char*)(gbase) + (voff)[_i]), (PG8_LAS unsigned*)(lds + (bufoff) + ldsw + _i * 8192), 16, 0, 0); } while (0)
#define PG8_LDA(dst, b, h) do { _Pragma("unroll") for (int m = 0; m < 4; ++m) _Pragma("unroll") for (int k = 0; k < 2; ++k) dst[m][k] = *(const PG8_LAS bf16x8*)(lds + PG8_SA(b, h) + aoff + m * 2048 + k * 1024); } while (0)
#define PG8_LDB(dst, b, h) do { _Pragma("unroll") for (int n = 0; n < 2; ++n) _Pragma("unroll") for (int k = 0; k < 2; ++k) dst[n][k] = *(const PG8_LAS bf16x8*)(lds + PG8_SB(b, h) + boff + n * 2048 + k * 1024); } while (0)
#define PG8_MMA(ai, bj, At, Bt) do { __builtin_amdgcn_s_setprio(1); _Pragma("unroll") for (int m = 0; m < 4; ++m) _Pragma("unroll") for (int n = 0; n < 2; ++n) _Pragma("unroll") for (int k = 0; k < 2; ++k) \
        acc[ai][bj][m][n] = __builtin_amdgcn_mfma_f32_16x16x32_bf16(Bt[n][k], At[m][k], acc[ai][bj][m][n], 0, 0, 0); __builtin_amdgcn_s_setprio(0); } while (0)
#define PG8_WAIT_V(n) asm volatile("s_waitcnt vmcnt(" #n ")" ::: "memory")
#define PG8_WAIT_L(n) asm volatile("s_waitcnt lgkmcnt(" #n ")" ::: "memory")
#define PG8_BAR __builtin_amdgcn_s_barrier()
#define PG8_SCHED __builtin_amdgcn_sched_barrier(0)
    Unit cur, nxt; int ui = 0;
    if (!S.next(0, cur)) return;
    f32x4 acc[2][2][4][2];
#pragma unroll
    for (int a = 0; a < 2; ++a)
#pragma unroll
        for (int b = 0; b < 2; ++b)
#pragma unroll
            for (int m = 0; m < 4; ++m)
#pragma unroll
                for (int n = 0; n < 2; ++n) acc[a][b][m][n] = (f32x4){0.f, 0.f, 0.f, 0.f};
    bf16x8 At[4][2], B0[2][2], B1[2][2];
    const char* cA = (const char*)g.A + (size_t)cur.pm * tstepA + (size_t)cur.ko * 2; const char* cB = (const char*)g.Bt + (size_t)cur.pn * tstep + (size_t)cur.ko * 2;
    S.a_ready(cur);
    if constexpr (SP2) {
        PG8_STAGE(PG8_SB(0, 0), cB, voffB); PG8_STAGE(PG8_SB(0, 1), cB + hstep, voffB); PG8_STAGE(PG8_SA(0, 0), cA, voffA); PG8_STAGE(PG8_SA(0, 1), cA + hstep, voffA);
        if (wr == 1) PG8_BAR;
        PG8_WAIT_V(2); PG8_BAR;
        PG8_STAGE(PG8_SB(1, 0), cB + kstep, voffB); PG8_STAGE(PG8_SA(1, 0), cA + kstep, voffA); PG8_STAGE(PG8_SB(1, 1), cB + hstep + kstep, voffB);
        PG8_WAIT_V(6); PG8_BAR;
    } else {
        PG8_STAGE(PG8_SB(0, 0), cB, voffB); PG8_STAGE(PG8_SA(0, 0), cA, voffA); PG8_STAGE(PG8_SB(0, 1), cB + hstep, voffB); PG8_STAGE(PG8_SA(0, 1), cA + hstep, voffA);
        if (wr == 1) PG8_BAR;
        PG8_WAIT_V(4); PG8_BAR;
        PG8_STAGE(PG8_SB(1, 0), cB + kstep, voffB); PG8_STAGE(PG8_SA(1, 0), cA + kstep, voffA); PG8_STAGE(PG8_SB(1, 1), cB + hstep + kstep, voffB);
        PG8_WAIT_V(6); PG8_BAR;
    }
    for (;;) {
        const bool has_next = S.next(ui + 1, nxt);
        const char* nA = has_next ? (const char*)g.A + (size_t)nxt.pm * tstepA + (size_t)nxt.ko * 2 : cA; const char* nB = has_next ? (const char*)g.Bt + (size_t)nxt.pn * tstep + (size_t)nxt.ko * 2 : cB;
        for (int t = 0; t < nt; t += 2) {
            const bool last = (t == nt - 2);
            const char* a1 = cA + (size_t)(t + 1) * kstep;
            const char* a2 = last ? nA : cA + (size_t)(t + 2) * kstep; const char* b2 = last ? nB : cB + (size_t)(t + 2) * kstep;
            const char* a3 = a2 + kstep; const char* b3 = b2 + kstep;
            if (last && has_next) S.a_ready(nxt);
            if constexpr (SP2) {
            PG8_LDB(B0, 0, 0); PG8_LDB(B1, 0, 1); PG8_SCHED; PG8_LDA(At, 0, 0); PG8_STAGE(PG8_SA(1, 1), a1 + hstep, voffA);
            PG8_WAIT_V(8); PG8_WAIT_L(0); PG8_BAR; PG8_MMA(0, 0, At, B0); PG8_MMA(0, 1, At, B1); PG8_BAR; PG8_SCHED;
            PG8_LDA(At, 0, 1); PG8_STAGE(PG8_SB(0, 0), b2, voffB); PG8_STAGE(PG8_SB(0, 1), b2 + hstep, voffB); PG8_STAGE(PG8_SA(0, 0), a2, voffA);
            PG8_WAIT_V(8); PG8_WAIT_L(0); PG8_BAR; PG8_MMA(1, 0, At, B0); PG8_MMA(1, 1, At, B1); PG8_BAR; PG8_SCHED;
            PG8_LDB(B0, 1, 0); PG8_LDB(B1, 1, 1); PG8_SCHED; PG8_LDA(At, 1, 0); PG8_STAGE(PG8_SA(0, 1), a2 + hstep, voffA);
            PG8_WAIT_V(8); PG8_WAIT_L(0); PG8_BAR; PG8_MMA(0, 0, At, B0); PG8_MMA(0, 1, At, B1); PG8_BAR; PG8_SCHED;
            PG8_LDA(At, 1, 1); PG8_STAGE(PG8_SB(1, 0), b3, voffB); PG8_STAGE(PG8_SB(1, 1), b3 + hstep, voffB); PG8_STAGE(PG8_SA(1, 0), a3, voffA);
            PG8_WAIT_V(8); PG8_WAIT_L(0); PG8_BAR; PG8_MMA(1, 0, At, B0); PG8_MMA(1, 1, At, B1); PG8_BAR; PG8_SCHED;
            } else {
            PG8_LDB(B0, 0, 0); PG8_SCHED; PG8_LDA(At, 0, 0); PG8_STAGE(PG8_SA(1, 1), a1 + hstep, voffA);
            PG8_WAIT_L(8); PG8_BAR; PG8_WAIT_L(0); PG8_MMA(0, 0, At, B0); PG8_BAR; PG8_SCHED;
            PG8_LDB(B1, 0, 1); PG8_STAGE(PG8_SB(0, 0), b2, voffB);
            PG8_BAR; PG8_WAIT_L(0); PG8_MMA(0, 1, At, B1); PG8_BAR;
            PG8_LDA(At, 0, 1); PG8_STAGE(PG8_SA(0, 0), a2, voffA);
            PG8_BAR; PG8_WAIT_L(0); PG8_MMA(1, 0, At, B0); PG8_BAR; PG8_SCHED;
            PG8_STAGE(PG8_SB(0, 1), b2 + hstep, voffB);
            PG8_WAIT_V(6); PG8_BAR; PG8_MMA(1, 1, At, B1); PG8_BAR;
            PG8_LDB(B0, 1, 0); PG8_SCHED; PG8_LDA(At, 1, 0); PG8_STAGE(PG8_SA(0, 1), a2 + hstep, voffA);
            PG8_WAIT_L(8); PG8_BAR; PG8_WAIT_L(0); PG8_MMA(0, 0, At, B0); PG8_BAR; PG8_SCHED;
            PG8_LDB(B1, 1, 1); PG8_STAGE(PG8_SB(1, 0), b3, voffB);
            PG8_BAR; PG8_WAIT_L(0); PG8_MMA(0, 1, At, B1); PG8_BAR;
            PG8_LDA(At, 1, 1); PG8_STAGE(PG8_SA(1, 0), a3, voffA);
            PG8_BAR; PG8_WAIT_L(0); PG8_MMA(1, 0, At, B0); PG8_BAR; PG8_SCHED;
            PG8_STAGE(PG8_SB(1, 1), b3 + hstep, voffB);
            PG8_WAIT_V(6); PG8_BAR; PG8_MMA(1, 1, At, B1); PG8_BAR;
            }
        }
        if constexpr (ALIGN_EPI) { if (wr == 0) PG8_BAR; }
        if constexpr (!Epi::AFTER_DRAIN) { E(acc, cur, wr, wc, fr, fq); S.done(cur); }
        if (!has_next) break;
#pragma unroll
        for (int a = 0; a < 2; ++a)
#pragma unroll
            for (int b = 0; b < 2; ++b)
#pragma unroll
                for (int m = 0; m < 4; ++m)
#pragma unroll
                    for (int n = 0; n < 2; ++n) acc[a][b][m][n] = (f32x4){0.f, 0.f, 0.f, 0.f};
        cur = nxt; cA = nA; cB = nB; ++ui;
        if constexpr (ALIGN_EPI) { if (wr == 1) PG8_BAR; }
    }
    PG8_WAIT_V(0);
    if constexpr (!ALIGN_EPI) { if (wr == 0) PG8_BAR; }
    PG8_BAR;
    if constexpr (Epi::AFTER_DRAIN) { E.fused(acc, cur, wr, wc, fr, fq, lds, wid, lane); S.done(cur); }
#undef PG8_SA
#undef PG8_SB
#undef PG8_STAGE
#undef PG8_LDA
#undef PG8_LDB
#undef PG8_MMA
#undef PG8_WAIT_V
#undef PG8_WAIT_L
#undef PG8_BAR
#undef PG8_SCHED
}
}

namespace mk {
typedef unsigned short bf16;
typedef float f32x4 __attribute__((ext_vector_type(4)));
typedef unsigned u32x4 __attribute__((ext_vector_type(4)));
typedef unsigned u32x2 __attribute__((ext_vector_type(2)));

constexpr int D = 1024, TP = 16384, TS = 512, MR = TP + TS;
constexpr int SEQ = 2048, NB = 8, DB = 128, DSEQ = 4;
constexpr int INC = 2960, NPROJ = 3072, DFF = 2816, NUP = 5632;
constexpr int NSEG = 8, LSEG = SEQ / NSEG;
constexpr int NSEG5 = 8, LSEG5 = SEQ / NSEG5, LOG2_LSEG5 = 8;
constexpr int C_RQ = 0, C_RK = 384, C_RV = 768, C_RG = 1152, C_SU = 1536, C_GQ = 1792, C_GK = 1984, C_GV = 2176, C_GG = 2560, C_GLR = 2944;
constexpr float EPS = 1e-6f;

constexpr size_t MiB = 1u << 20;
constexpr size_t WS_W1T = 1 * MiB, WS_W2T = 7 * MiB, WS_W3T = 9 * MiB, WS_W4T = 20 * MiB;
constexpr size_t WS_GLUT = 25 * MiB + 512 * 1024, WS_ROPE = 25 * MiB + 768 * 1024;
constexpr size_t WS_XN = 27 * MiB;
constexpr size_t WS_BIG = 60 * MiB;
constexpr size_t WS_ABUF = WS_BIG, WS_GATE = WS_BIG + (size_t)MR * DFF * 2;
constexpr size_t WS_SEG = 160 * MiB;
constexpr size_t WS_Y5 = 172 * MiB;
constexpr size_t WS_END = WS_GATE + (size_t)MR * DFF * 2;
static_assert(WS_END <= 256 * MiB, "workspace");
static_assert(WS_BIG + (size_t)MR * NPROJ * 2 <= WS_SEG, "proj vs seg");
constexpr size_t SEG_RET = 0;
constexpr size_t SEG_GLA = SEG_RET + (size_t)8 * 6 * (NSEG - 1) * 4096 * 4;
constexpr size_t SEG_S5 = SEG_GLA + (size_t)8 * 4 * (NSEG - 1) * 4672 * 4;
static_assert(WS_SEG + SEG_S5 + (size_t)8 * (NSEG5 - 1) * 2048 * 4 <= WS_Y5, "seg");

constexpr size_t O_Y = 0;
constexpr size_t O_RETP = (size_t)MR * D;
constexpr size_t O_RETS = O_RETP + (size_t)2 * NB * 6 * 4096;
constexpr size_t O_S5RP = O_RETS + (size_t)2 * DB * 6 * 4096;
constexpr size_t O_S5RS = O_S5RP + (size_t)2 * NB * 1024;
constexpr size_t O_S5IP = O_S5RS + (size_t)2 * DB * 1024;
constexpr size_t O_S5IS = O_S5IP + (size_t)2 * NB * 1024;
constexpr size_t O_GLAP = O_S5IS + (size_t)2 * DB * 1024;
constexpr size_t O_GLAS = O_GLAP + (size_t)2 * NB * 4 * 4608;
constexpr size_t O_CONVP = O_GLAS + (size_t)2 * DB * 4 * 4608;
constexpr size_t O_CONVS = O_CONVP + (size_t)2 * NB * 2 * DFF;
constexpr size_t O_END = O_CONVS + (size_t)2 * DB * 2 * DFF;
static_assert(O_END == 31088640, "out size");

constexpr int LDS_BYTES = 147456;

enum { I_XP = 0, I_XS, I_SRET, I_S5R, I_S5I, I_SGLA, I_SCONV, I_NMG, I_WIN, I_RNG, I_RNB, I_LRE, I_LIM, I_LDT, I_BRE, I_BIM, I_CRE, I_CIM, I_S5D,
       I_GLUW, I_GLUB, I_GGW, I_GGB, I_GNG, I_WOUT, I_NFG, I_FWIN, I_FCW, I_FCB, I_FWOUT, I_NFIN, N_IN };

struct Args { const float* in[N_IN]; float* out; unsigned char* ws; };

__device__ __forceinline__ float bflo(unsigned w) { return __uint_as_float(w << 16); }
__device__ __forceinline__ float bfhi(unsigned w) { return __uint_as_float(w & 0xffff0000u); }
__device__ __forceinline__ unsigned pk2(float lo, float hi) { unsigned r; asm("v_cvt_pk_bf16_f32 %0, %1, %2" : "=v"(r) : "v"(lo), "v"(hi)); return r; }
__device__ __forceinline__ unsigned f2bf(float f) { return pk2(f, 0.f) & 0xffffu; }
__device__ __forceinline__ float silu(float x) { return x * __builtin_amdgcn_rcpf(1.f + __builtin_amdgcn_exp2f(-1.4426950408889634f * x)); }
__device__ __forceinline__ float sigmoidf_(float x) { return __builtin_amdgcn_rcpf(1.f + __builtin_amdgcn_exp2f(-1.4426950408889634f * x)); }
__device__ __forceinline__ float gelu_tanh(float x) {
    const float v = x * fmaf(x * x, 0.044715f, 1.f);
    const float e = __builtin_amdgcn_exp2f(v * (2.f * 0.7978845608028654f * 1.4426950408889634f));
    return fmaf(-x, __builtin_amdgcn_rcpf(e + 1.f), x);
}
__device__ __forceinline__ float rdl(float x, int l) { return __int_as_float(__builtin_amdgcn_readlane(__float_as_int(x), l)); }
__device__ __forceinline__ float wave_sum(float v) {
#pragma unroll
    for (int o = 1; o < 64; o <<= 1) v += __shfl_xor(v, o);
    return v;
}

struct EpiRes {
    static constexpr bool PERM = false, AFTER_DRAIN = false;
    const float* baseP; const float* baseS; float* out;
    __device__ __forceinline__ void operator()(const pg8::f32x4 (&acc)[2][2][4][2], const pg8::Unit& u, int wr, int wc, int fr, int fq) const {
        const int row0 = u.pm * 256 + wr * 64 + fr, col0 = u.pn * 256 + wc * 32 + 4 * fq;
        const float* base = (u.pm < TP / 256) ? baseP : (baseS - (size_t)TP * D);
#pragma unroll
        for (int ai = 0; ai < 2; ++ai)
#pragma unroll
            for (int m = 0; m < 4; ++m) { const size_t off = (size_t)(row0 + ai * 128 + m * 16) * D + col0;
#pragma unroll
                for (int bj = 0; bj < 2; ++bj)
#pragma unroll
                    for (int n = 0; n < 2; ++n) { const pg8::f32x4 bs = *(const pg8::f32x4*)(base + off + bj * 128 + n * 16);
                        *(pg8::f32x4*)(out + off + bj * 128 + n * 16) = bs + acc[ai][bj][m][n]; }
                if (m & 1) asm volatile("" ::: "memory"); }
    }
};
struct TailOrder {
    int S, G, c;
    __device__ void init(int S_, int G_, int c_) { S = S_; G = G_; c = c_; }
    __device__ bool next(int i, pg8::Unit& u) const { const int Lq = i * G + c; if (Lq >= 8 * S) return false; const int ks = Lq % S, tile = Lq / S; u.pn = tile & 3; u.pm = TP / 256 + (tile >> 2); u.ko = ks * 256; return true; }
    __device__ __forceinline__ void a_ready(const pg8::Unit&) const {}
    __device__ __forceinline__ void done(const pg8::Unit&) const {}
};
struct EpiPart {
    static constexpr bool PERM = false, AFTER_DRAIN = false;
    float* part;
    __device__ __forceinline__ void operator()(const pg8::f32x4 (&acc)[2][2][4][2], const pg8::Unit& u, int wr, int wc, int fr, int fq) const {
        const int row0 = (u.pm - TP / 256) * 256 + wr * 64 + fr, col0 = u.pn * 256 + wc * 32 + 4 * fq;
        float* dst = part + (size_t)(u.ko >> 8) * TS * D;
#pragma unroll
        for (int ai = 0; ai < 2; ++ai)
#pragma unroll
            for (int m = 0; m < 4; ++m) { const size_t off = (size_t)(row0 + ai * 128 + m * 16) * D + col0;
#pragma unroll
                for (int bj = 0; bj < 2; ++bj)
#pragma unroll
                    for (int n = 0; n < 2; ++n) *(pg8::f32x4*)(dst + off + bj * 128 + n * 16) = acc[ai][bj][m][n]; }
    }
};
struct EpiGlu {
    static constexpr bool PERM = true, AFTER_DRAIN = false;
    const bf16* y5; const float* bias; bf16* mix;
    __device__ __forceinline__ void operator()(const pg8::f32x4 (&acc)[2][2][4][2], const pg8::Unit& u, int wr, int wc, int fr, int fq) const {
        const int row0 = u.pm * 256 + wr * 64 + fr, col0 = wc * 32 + 8 * fq;
#pragma unroll
        for (int bj = 0; bj < 2; ++bj) { const int c = col0 + bj * 128;
            const f32x4 b0 = *(const f32x4*)(bias + c), b1 = *(const f32x4*)(bias + c + 4);
#pragma unroll
            for (int ai = 0; ai < 2; ++ai)
#pragma unroll
                for (int m = 0; m < 4; ++m) { const size_t r = (size_t)(row0 + ai * 128 + m * 16);
                    const u32x4 yv = *(const u32x4*)(y5 + r * 256 + c);
                    const pg8::f32x4 v0 = acc[ai][bj][m][0], v1 = acc[ai][bj][m][1];
                    u32x4 w;
                    w.x = pk2(bflo(yv.x) * sigmoidf_(v0[0] + b0[0]), bfhi(yv.x) * sigmoidf_(v0[1] + b0[1]));
                    w.y = pk2(bflo(yv.y) * sigmoidf_(v0[2] + b0[2]), bfhi(yv.y) * sigmoidf_(v0[3] + b0[3]));
                    w.z = pk2(bflo(yv.z) * sigmoidf_(v1[0] + b1[0]), bfhi(yv.z) * sigmoidf_(v1[1] + b1[1]));
                    w.w = pk2(bflo(yv.w) * sigmoidf_(v1[2] + b1[2]), bfhi(yv.w) * sigmoidf_(v1[3] + b1[3]));
                    *(u32x4*)(mix + r * D + 384 + c) = w; asm volatile("" ::: "memory"); } }
    }
};
struct EpiUp {
    static constexpr bool PERM = true, AFTER_DRAIN = false;
    bf16* abuf; bf16* gate; float* convP; float* convS;
    __device__ __forceinline__ void operator()(const pg8::f32x4 (&acc)[2][2][4][2], const pg8::Unit& u, int wr, int wc, int fr, int fq) const {
        const bool isA = u.pn < DFF / 256;
        bf16* dst = isA ? abuf : gate;
        const int colt = (isA ? u.pn : u.pn - DFF / 256) * 256 + wc * 32 + 8 * fq;
        const int row0 = u.pm * 256 + wr * 64 + fr;
#pragma unroll
        for (int ai = 0; ai < 2; ++ai)
#pragma unroll
            for (int m = 0; m < 4; ++m) { const int r = row0 + ai * 128 + m * 16;
#pragma unroll
                for (int bj = 0; bj < 2; ++bj) { const pg8::f32x4 v0 = acc[ai][bj][m][0], v1 = acc[ai][bj][m][1];
                    u32x4 w; w.x = pg8::cvt_pk_bf16(v0[0], v0[1]); w.y = pg8::cvt_pk_bf16(v0[2], v0[3]); w.z = pg8::cvt_pk_bf16(v1[0], v1[1]); w.w = pg8::cvt_pk_bf16(v1[2], v1[3]);
                    *(u32x4*)(dst + (size_t)r * DFF + colt + bj * 128) = w;
                    if (isA) {
                        float* cd = nullptr;
                        if (r < TP) { const int t = r & (SEQ - 1); if (t >= SEQ - 2) cd = convP + ((size_t)(r >> 11) * 2 + (t - (SEQ - 2))) * DFF; }
                        else { const int rs = r - TP, t = rs & 3; if (t >= 2) cd = convS + ((size_t)(rs >> 2) * 2 + (t - 2)) * DFF; }
                        if (cd) { *(pg8::f32x4*)(cd + colt + bj * 128) = v0; *(pg8::f32x4*)(cd + colt + bj * 128 + 4) = v1; }
                    } } }
    }
};

__device__ __forceinline__ float dpp_ror1(float x) { return __int_as_float(__builtin_amdgcn_update_dpp(0, __float_as_int(x), 0x121, 0xf, 0xf, false)); }
__device__ __forceinline__ float dpp_ror2(float x) { return __int_as_float(__builtin_amdgcn_update_dpp(0, __float_as_int(x), 0x122, 0xf, 0xf, false)); }
struct EpiAct {
    static constexpr bool PERM = true, AFTER_DRAIN = false;
    bf16* act; float* convP; float* convS; const float* cw; const float* cb; const float* cstate; PG8_LAS float* halo;
    __device__ __forceinline__ void operator()(const pg8::f32x4 (&acc)[2][2][4][2], const pg8::Unit& u, int wr, int wc, int fr, int fq) const {
        const int jl = wc * 32 + 8 * fq, j0 = u.pn * 128 + jl;
        if (fr >= 14) {
#pragma unroll
            for (int ai = 0; ai < 2; ++ai) { PG8_LAS float* hp = halo + ((ai * 2 + wr) * 2 + (fr - 14)) * 128 + jl;
                *(PG8_LAS pg8::f32x4*)hp = acc[ai][0][3][0]; *(PG8_LAS pg8::f32x4*)(hp + 4) = acc[ai][0][3][1]; } }
        float w0[8], w1[8], w2[8], bb[8];
#pragma unroll
        for (int e = 0; e < 8; ++e) { w0[e] = cw[j0 + e]; w1[e] = cw[DFF + j0 + e]; w2[e] = cw[2 * DFF + j0 + e]; bb[e] = cb[j0 + e]; }
        asm volatile("s_waitcnt lgkmcnt(0)" ::: "memory"); __builtin_amdgcn_s_barrier(); asm volatile("" ::: "memory");
#pragma unroll
        for (int ai = 0; ai < 2; ++ai)
#pragma unroll
            for (int m = 0; m < 4; ++m) {
                const int rr = ai * 128 + wr * 64 + m * 16 + fr, r = u.pm * 254 - 2 + rr;
                float cur[8], p1[8], p2[8];
#pragma unroll
                for (int e = 0; e < 8; ++e) cur[e] = acc[ai][0][m][e >> 2][e & 3];
                if (m == 0) {
                    float h0[8], h1[8];
                    const int pb = ai * 2 + wr - 1;
                    if (pb >= 0) { const PG8_LAS float* hp = halo + (pb * 2) * 128 + jl;
                        const pg8::f32x4 a0 = *(const PG8_LAS pg8::f32x4*)hp, a1 = *(const PG8_LAS pg8::f32x4*)(hp + 4), b0 = *(const PG8_LAS pg8::f32x4*)(hp + 128), b1 = *(const PG8_LAS pg8::f32x4*)(hp + 132);
#pragma unroll
                        for (int e = 0; e < 4; ++e) { h0[e] = a0[e]; h0[4 + e] = a1[e]; h1[e] = b0[e]; h1[4 + e] = b1[e]; } }
                    else {
#pragma unroll
                        for (int e = 0; e < 8; ++e) { h0[e] = 0.f; h1[e] = 0.f; } }
#pragma unroll
                    for (int e = 0; e < 8; ++e) { const float s1 = dpp_ror1(cur[e]), s2 = dpp_ror2(cur[e]); p1[e] = fr >= 1 ? s1 : h1[e]; p2[e] = fr >= 2 ? s2 : (fr == 1 ? h1[e] : h0[e]); }
                } else {
#pragma unroll
                    for (int e = 0; e < 8; ++e) { const float pv = acc[ai][0][m - 1][e >> 2][e & 3];
                        const float s1 = dpp_ror1(cur[e]), s2 = dpp_ror2(cur[e]), q1 = dpp_ror1(pv), q2 = dpp_ror2(pv); p1[e] = fr >= 1 ? s1 : q1; p2[e] = fr >= 2 ? s2 : q2; }
                }
                const bool live = rr >= 2 && r < MR;
                const bool smp = r >= TP;
                const int t = smp ? ((r - TP) & 3) : (r & (SEQ - 1));
                if (live && t < 2) {
                    if (smp) { const float* cs = cstate + (size_t)((r - TP) >> 2) * 2 * DFF + j0;
#pragma unroll
                        for (int e = 0; e < 8; ++e) { if (t == 0) { p2[e] = cs[e]; p1[e] = cs[DFF + e]; } else { p2[e] = cs[DFF + e]; } } }
                    else {
#pragma unroll
                        for (int e = 0; e < 8; ++e) { p2[e] = 0.f; if (t == 0) p1[e] = 0.f; } }
                }
                if (live) {
                    float o[8];
                    typedef float f32x2 __attribute__((ext_vector_type(2)));
#pragma unroll
                    for (int e = 0; e < 8; e += 2) {
                        f32x2 cv = (f32x2){bb[e], bb[e + 1]} + (f32x2){w0[e], w0[e + 1]} * (f32x2){p2[e], p2[e + 1]};
                        cv += (f32x2){w1[e], w1[e + 1]} * (f32x2){p1[e], p1[e + 1]}; cv += (f32x2){w2[e], w2[e + 1]} * (f32x2){cur[e], cur[e + 1]};
                        const f32x2 vv = cv * (cv * cv * 0.044715f + 1.f) * (2.f * 0.7978845608028654f * 1.4426950408889634f);
                        const float r0 = __builtin_amdgcn_rcpf(__builtin_amdgcn_exp2f(vv.x) + 1.f), r1 = __builtin_amdgcn_rcpf(__builtin_amdgcn_exp2f(vv.y) + 1.f);
                        const f32x2 gl = cv - cv * (f32x2){r0, r1};
                        const f32x2 go = gl * (f32x2){acc[ai][1][m][e >> 2][e & 3], acc[ai][1][m][(e + 1) >> 2][(e + 1) & 3]};
                        o[e] = go.x; o[e + 1] = go.y; }
                    u32x4 wv; wv.x = pk2(o[0], o[1]); wv.y = pk2(o[2], o[3]); wv.z = pk2(o[4], o[5]); wv.w = pk2(o[6], o[7]);
                    *(u32x4*)(act + (size_t)r * DFF + j0) = wv;
                    float* cd = nullptr;
                    if (!smp) { if (t >= SEQ - 2) cd = convP + ((size_t)(r >> 11) * 2 + (t - (SEQ - 2))) * DFF; }
                    else if (t >= 2) cd = convS + ((size_t)((r - TP) >> 2) * 2 + (t - 2)) * DFF;
                    if (cd) { *(pg8::f32x4*)(cd + j0) = acc[ai][0][m][0]; *(pg8::f32x4*)(cd + j0 + 4) = acc[ai][0][m][1]; }
                }
            }
    }
};

typedef const __attribute__((address_space(4))) Args* KArgs;
struct Ctx {
    KArgs ap; int tid, lane, wave, gw, ngw, bx, G;
    __device__ __forceinline__ const float* in(int i) const { return ap->in[i]; }
    __device__ __forceinline__ float* out() const { return ap->out; }
    __device__ __forceinline__ bf16* W1T() const { return (bf16*)(ap->ws + WS_W1T); }
    __device__ __forceinline__ bf16* W2T() const { return (bf16*)(ap->ws + WS_W2T); }
    __device__ __forceinline__ bf16* W3T() const { return (bf16*)(ap->ws + WS_W3T); }
    __device__ __forceinline__ bf16* W4T() const { return (bf16*)(ap->ws + WS_W4T); }
    __device__ __forceinline__ bf16* GLUT() const { return (bf16*)(ap->ws + WS_GLUT); }
    __device__ __forceinline__ bf16* XN() const { return (bf16*)(ap->ws + WS_XN); }
    __device__ __forceinline__ bf16* PROJ() const { return (bf16*)(ap->ws + WS_BIG); }
    __device__ __forceinline__ bf16* ABUF() const { return (bf16*)(ap->ws + WS_ABUF); }
    __device__ __forceinline__ bf16* GATE() const { return (bf16*)(ap->ws + WS_GATE); }
    __device__ __forceinline__ bf16* Y5() const { return (bf16*)(ap->ws + WS_Y5); }
    __device__ __forceinline__ float* ROPE() const { return (float*)(ap->ws + WS_ROPE); }
    __device__ __forceinline__ float* SEG() const { return (float*)(ap->ws + WS_SEG); }
    __device__ __forceinline__ float* PART() const { return (float*)(ap->ws + WS_BIG); }
};
__device__ __forceinline__ Ctx mkctx() {
    Ctx c; KArgs p = (KArgs)__builtin_amdgcn_kernarg_segment_ptr(); asm volatile("" : "+s"(p)); c.ap = p;
    int t_ = threadIdx.x; asm volatile("" : "+v"(t_)); int b_ = blockIdx.x; asm volatile("" : "+s"(b_)); int g_ = gridDim.x; asm volatile("" : "+s"(g_));
    c.tid = t_; c.lane = c.tid & 63; c.wave = __builtin_amdgcn_readfirstlane(c.tid >> 6); c.bx = b_; c.G = g_;
    c.gw = b_ * 8 + c.wave; c.ngw = g_ * 8; return c;
}

__device__ __forceinline__ void transpose_item(const float* W, int K, int N, bf16* WT, float* scr, int item, int lane, bool ILV = false) {
    const int nblk = (N + 31) / 32, kb = item / nblk, nb = item % nblk, k0 = 64 * kb, n0 = 32 * nb;
    const int dst0 = !ILV ? n0 : (n0 < DFF ? 256 * (n0 >> 7) + (n0 & 127) : 256 * ((n0 - DFF) >> 7) + 128 + ((n0 - DFF) & 127));
    const int nn = n0 + (lane & 31);
    float tv[32];
#pragma unroll
    for (int i = 0; i < 32; ++i) { const int kk = 2 * i + (lane >> 5); tv[i] = (nn < N) ? W[(size_t)(k0 + kk) * N + nn] : 0.f; }
#pragma unroll
    for (int i = 0; i < 32; ++i) { const int kk = 2 * i + (lane >> 5); scr[kk * 33 + (lane & 31)] = tv[i]; }
    asm volatile("s_waitcnt lgkmcnt(0)" ::: "memory");
    const int c = lane & 7;
#pragma unroll
    for (int j = 0; j < 4; ++j) { const int n = (lane >> 3) + 8 * j; const float* s = scr + (8 * c) * 33 + n;
        u32x4 o; o.x = pk2(s[0 * 33], s[1 * 33]); o.y = pk2(s[2 * 33], s[3 * 33]); o.z = pk2(s[4 * 33], s[5 * 33]); o.w = pk2(s[6 * 33], s[7 * 33]);
        *(u32x4*)(WT + (size_t)(dst0 + n) * K + k0 + 8 * c) = o; }
    asm volatile("s_waitcnt lgkmcnt(0)" ::: "memory");
}
__device__ __forceinline__ void norm_row_bf16(const float* xrow, const float* g, bf16* orow, int lane, const float* part = nullptr, int nS = 0, float* xout = nullptr) {
    const f32x4* xr = (const f32x4*)xrow + lane; const f32x4* gr = (const f32x4*)g + lane;
    f32x4 v[4]; float s = 0.f;
#pragma unroll
    for (int j = 0; j < 4; ++j) v[j] = xr[64 * j];
    if (part) { for (int q = 0; q < nS; ++q) { const f32x4* pp = (const f32x4*)(part + (size_t)q * TS * D) + lane;
#pragma unroll
            for (int j = 0; j < 4; ++j) v[j] += pp[64 * j]; }
#pragma unroll
        for (int j = 0; j < 4; ++j) ((f32x4*)xout + lane)[64 * j] = v[j]; }
#pragma unroll
    for (int j = 0; j < 4; ++j) { s += (v[j].x * v[j].x + v[j].y * v[j].y) + (v[j].z * v[j].z + v[j].w * v[j].w); }
    const float rs = rsqrtf(wave_sum(s) * (1.f / D) + EPS);
    u32x2* o8 = (u32x2*)orow + lane;
#pragma unroll
    for (int j = 0; j < 4; ++j) { const f32x4 gg = gr[64 * j]; u32x2 w; w.x = pk2(v[j].x * rs * gg.x, v[j].y * rs * gg.y); w.y = pk2(v[j].z * rs * gg.z, v[j].w * rs * gg.w); o8[64 * j] = w; }
}
__device__ __forceinline__ void norm_row_f32(float* xrow, const float* g, int lane, const float* part = nullptr, int nS = 0) {
    f32x4* xr = (f32x4*)xrow + lane; const f32x4* gr = (const f32x4*)g + lane;
    f32x4 v[4]; float s = 0.f;
#pragma unroll
    for (int j = 0; j < 4; ++j) v[j] = xr[64 * j];
    if (part) { for (int q = 0; q < nS; ++q) { const f32x4* pp = (const f32x4*)(part + (size_t)q * TS * D) + lane;
#pragma unroll
            for (int j = 0; j < 4; ++j) v[j] += pp[64 * j]; } }
#pragma unroll
    for (int j = 0; j < 4; ++j) { s += (v[j].x * v[j].x + v[j].y * v[j].y) + (v[j].z * v[j].z + v[j].w * v[j].w); }
    const float rs = rsqrtf(wave_sum(s) * (1.f / D) + EPS);
#pragma unroll
    for (int j = 0; j < 4; ++j) { const f32x4 gg = gr[64 * j]; xr[64 * j] = v[j] * rs * gg; }
}

__device__ __forceinline__ void norm_rows2_bf16(const float* x0, const float* x1, const float* g, bf16* o0, bf16* o1, int lane) {
    const f32x4* xr0 = (const f32x4*)x0 + lane; const f32x4* xr1 = (const f32x4*)x1 + lane; const f32x4* gr = (const f32x4*)g + lane;
    f32x4 v0[4], v1[4]; float s0 = 0.f, s1 = 0.f;
#pragma unroll
    for (int j = 0; j < 4; ++j) { v0[j] = xr0[64 * j]; v1[j] = xr1[64 * j]; }
#pragma unroll
    for (int j = 0; j < 4; ++j) { s0 += (v0[j].x * v0[j].x + v0[j].y * v0[j].y) + (v0[j].z * v0[j].z + v0[j].w * v0[j].w); s1 += (v1[j].x * v1[j].x + v1[j].y * v1[j].y) + (v1[j].z * v1[j].z + v1[j].w * v1[j].w); }
#pragma unroll
    for (int o = 1; o < 64; o <<= 1) { s0 += __shfl_xor(s0, o); s1 += __shfl_xor(s1, o); }
    const float r0 = rsqrtf(s0 * (1.f / D) + EPS), r1 = rsqrtf(s1 * (1.f / D) + EPS);
    u32x2* p0 = (u32x2*)o0 + lane; u32x2* p1 = (u32x2*)o1 + lane;
#pragma unroll
    for (int j = 0; j < 4; ++j) { const f32x4 gg = gr[64 * j];
        u32x2 w; w.x = pk2(v0[j].x * r0 * gg.x, v0[j].y * r0 * gg.y); w.y = pk2(v0[j].z * r0 * gg.z, v0[j].w * r0 * gg.w); p0[64 * j] = w;
        u32x2 z; z.x = pk2(v1[j].x * r1 * gg.x, v1[j].y * r1 * gg.y); z.y = pk2(v1[j].z * r1 * gg.z, v1[j].w * r1 * gg.w); p1[64 * j] = z; }
}
__device__ __forceinline__ void norm_rows2_f32(float* x0, float* x1, const float* g, int lane) {
    f32x4* xr0 = (f32x4*)x0 + lane; f32x4* xr1 = (f32x4*)x1 + lane; const f32x4* gr = (const f32x4*)g + lane;
    f32x4 v0[4], v1[4]; float s0 = 0.f, s1 = 0.f;
#pragma unroll
    for (int j = 0; j < 4; ++j) { v0[j] = xr0[64 * j]; v1[j] = xr1[64 * j]; }
#pragma unroll
    for (int j = 0; j < 4; ++j) { s0 += (v0[j].x * v0[j].x + v0[j].y * v0[j].y) + (v0[j].z * v0[j].z + v0[j].w * v0[j].w); s1 += (v1[j].x * v1[j].x + v1[j].y * v1[j].y) + (v1[j].z * v1[j].z + v1[j].w * v1[j].w); }
#pragma unroll
    for (int o = 1; o < 64; o <<= 1) { s0 += __shfl_xor(s0, o); s1 += __shfl_xor(s1, o); }
    const float r0 = rsqrtf(s0 * (1.f / D) + EPS), r1 = rsqrtf(s1 * (1.f / D) + EPS);
#pragma unroll
    for (int j = 0; j < 4; ++j) { const f32x4 gg = gr[64 * j]; xr0[64 * j] = v0[j] * r0 * gg; xr1[64 * j] = v1[j] * r1 * gg; }
}

__device__ __forceinline__ void prep_phase(const Ctx& c, int l, float* L) {
    float* scr = L + c.wave * 4096;
    constexpr int I1 = 16 * 93, I2 = 16 * 32, I3 = 16 * 176, I4 = 44 * 32, I5 = 4 * 8;
    constexpr int NIT = I1 + I2 + I3 + I4 + I5;
    const float* w_in = c.in(I_WIN) + (size_t)l * D * INC;
    const float* w_out = c.in(I_WOUT) + (size_t)l * D * D;
    const float* f_in = c.in(I_FWIN) + (size_t)l * D * NUP;
    const float* f_out = c.in(I_FWOUT) + (size_t)l * DFF * D;
    const float* gluw = c.in(I_GLUW) + (size_t)l * 256 * 256;
    for (int it = c.gw; it < NIT; it += c.ngw) {
        int r = it;
        if (r < I1) { transpose_item(w_in, D, INC, c.W1T(), scr, r, c.lane); continue; } r -= I1;
        if (r < I2) { transpose_item(w_out, D, D, c.W2T(), scr, r, c.lane); continue; } r -= I2;
        if (r < I3) { transpose_item(f_in, D, NUP, c.W3T(), scr, r, c.lane, true); continue; } r -= I3;
        if (r < I4) { transpose_item(f_out, DFF, D, c.W4T(), scr, r, c.lane); continue; } r -= I4;
        transpose_item(gluw, 256, 256, c.GLUT(), scr, r, c.lane);
    }
    { const int gt = c.gw * 64 + c.lane, ngt = c.ngw * 64; u32x4 z = {0u, 0u, 0u, 0u};
      for (int i = gt; i < (NPROJ - 2976) * D / 8; i += ngt) *(u32x4*)(c.W1T() + (size_t)2976 * D + (size_t)i * 8) = z; }
    const float* g = c.in(I_NMG) + (size_t)l * D;
    { const float* xp = (l == 0) ? c.in(I_XP) : (const float*)c.out();
      for (int m = c.gw; m < TP; m += 2 * c.ngw) { const int m1 = m + c.ngw;
          if (m1 < TP) norm_rows2_bf16(xp + (size_t)m * D, xp + (size_t)m1 * D, g, c.XN() + (size_t)m * D, c.XN() + (size_t)m1 * D, c.lane);
          else norm_row_bf16(xp + (size_t)m * D, g, c.XN() + (size_t)m * D, c.lane); } }
    for (int m = TP + c.gw; m < MR; m += c.ngw) {
        const float* xr = (l == 0) ? c.in(I_XS) + (size_t)(m - TP) * D : c.out() + (size_t)m * D;
        if (l > 0) norm_row_bf16(xr, g, c.XN() + (size_t)m * D, c.lane, c.PART() + (size_t)(m - TP) * D, DFF / 256, c.out() + (size_t)m * D);
        else norm_row_bf16(xr, g, c.XN() + (size_t)m * D, c.lane);
    }
    if (l == 0) {
        const int gt = c.gw * 64 + c.lane, ngt = c.ngw * 64;
        for (int i = gt; i < 2052 * 32; i += ngt) { const int ps = i >> 5, f = i & 31; const int pos = ps < 2048 ? ps : 16384 + (ps - 2048);
            const float inv = exp2f(-(float)f * (13.287712379549449f / 32.f));
            double a = (double)pos * (double)inv; a -= 6.283185307179586 * rint(a * 0.15915494309189535);
            const float af = (float)a; c.ROPE()[i] = cosf(af); c.ROPE()[2052 * 32 + i] = sinf(af); }
    }
}

template <bool PASSA>
__device__ __forceinline__ void ret_task(const Ctx& c, int l, bool sample, int b, int h, int seg, float* L) {
    const int tid = c.tid, lane = c.lane, w = c.wave, vl = lane & 7, dg = lane >> 3;
    const int len = sample ? DSEQ : LSEG;
    const int row0 = sample ? TP + b * DSEQ : b * SEQ + seg * LSEG;
    const int ridx0 = sample ? 2048 : seg * LSEG;
    const float gamma = 1.f - exp2f(-5.f - (float)h);
    float S[8];
    if (sample) { const float* s0 = c.in(I_SRET) + ((size_t)((l * DB + b) * 6 + h) * 64 + 8 * dg) * 64 + 8 * w + vl;
#pragma unroll
        for (int i = 0; i < 8; ++i) S[i] = s0[i * 64]; }
    else {
#pragma unroll
        for (int i = 0; i < 8; ++i) S[i] = 0.f;
        const float lg = log2f(gamma);
        if (!PASSA) for (int m = 0; m < seg; ++m) { const float f = exp2f((float)(LSEG * (seg - 1 - m)) * lg);
            const float* E = c.SEG() + SEG_RET / 4 + (size_t)((b * 6 + h) * (NSEG - 1) + m) * 4096 + (8 * dg) * 64 + 8 * w + vl;
#pragma unroll
            for (int i = 0; i < 8; ++i) S[i] += f * E[i * 64]; }
    }
    float* Qs = L; float* Ks = L + 4096; float* Vs = L + 8192; float* Os = L + 12288;
    const float* rg_g = c.in(I_RNG) + l * 384 + h * 64; const float* rg_b = c.in(I_RNB) + l * 384 + h * 64;
    for (int c0 = 0; c0 < len; c0 += 64) {
        const int n = (len - c0) < 64 ? (len - c0) : 64;
        { const int t = tid >> 3, cc = tid & 7;
          if (t < n) { const bf16* pr = c.PROJ() + (size_t)(row0 + c0 + t) * NPROJ;
            const float* rc = c.ROPE() + (size_t)(ridx0 + c0 + t) * 32 + 4 * cc; const float* rsn = rc + 2052 * 32;
            const f32x4 cs = *(const f32x4*)rc, sn = *(const f32x4*)rsn;
            { const u32x2 lo = *(const u32x2*)(pr + C_RK + h * 64 + 4 * cc), hi = *(const u32x2*)(pr + C_RK + h * 64 + 32 + 4 * cc);
              const f32x4 x1 = {bflo(lo.x), bfhi(lo.x), bflo(lo.y), bfhi(lo.y)}, x2 = {bflo(hi.x), bfhi(hi.x), bflo(hi.y), bfhi(hi.y)};
              *(f32x4*)(Ks + t * 64 + 4 * cc) = (x1 * cs - x2 * sn) * 0.125f; *(f32x4*)(Ks + t * 64 + 32 + 4 * cc) = (x1 * sn + x2 * cs) * 0.125f; }
            if (!PASSA) { const u32x2 lo = *(const u32x2*)(pr + C_RQ + h * 64 + 4 * cc), hi = *(const u32x2*)(pr + C_RQ + h * 64 + 32 + 4 * cc);
              const f32x4 x1 = {bflo(lo.x), bfhi(lo.x), bflo(lo.y), bfhi(lo.y)}, x2 = {bflo(hi.x), bfhi(hi.x), bflo(hi.y), bfhi(hi.y)};
              *(f32x4*)(Qs + t * 64 + 4 * cc) = x1 * cs - x2 * sn; *(f32x4*)(Qs + t * 64 + 32 + 4 * cc) = x1 * sn + x2 * cs; }
            { const u32x4 vv = *(const u32x4*)(pr + C_RV + h * 64 + 8 * cc);
              *(f32x4*)(Vs + t * 64 + 8 * cc) = (f32x4){bflo(vv.x), bfhi(vv.x), bflo(vv.y), bfhi(vv.y)};
              *(f32x4*)(Vs + t * 64 + 8 * cc + 4) = (f32x4){bflo(vv.z), bfhi(vv.z), bflo(vv.w), bfhi(vv.w)}; } } }
        __syncthreads();
        for (int tl0 = 0; tl0 < n; tl0 += 4) {
            float po[4];
#pragma unroll
            for (int u = 0; u < 4; ++u) { const int tl = tl0 + u;
                const f32x4 k0 = *(const f32x4*)(Ks + tl * 64 + 8 * dg), k1 = *(const f32x4*)(Ks + tl * 64 + 8 * dg + 4);
                const float vv = Vs[tl * 64 + 8 * w + vl];
                const float kk[8] = {k0.x, k0.y, k0.z, k0.w, k1.x, k1.y, k1.z, k1.w};
#pragma unroll
                for (int i = 0; i < 8; ++i) S[i] = fmaf(gamma, S[i], kk[i] * vv);
                if (!PASSA) {
                    const f32x4 q0 = *(const f32x4*)(Qs + tl * 64 + 8 * dg), q1 = *(const f32x4*)(Qs + tl * 64 + 8 * dg + 4);
                    po[u] = q0.x * S[0] + q0.y * S[1] + q0.z * S[2] + q0.w * S[3] + q1.x * S[4] + q1.y * S[5] + q1.z * S[6] + q1.w * S[7]; } }
            if (!PASSA) {
#pragma unroll
                for (int u = 0; u < 4; ++u) po[u] += __shfl_xor(po[u], 8);
#pragma unroll
                for (int u = 0; u < 4; ++u) po[u] += __shfl_xor(po[u], 16);
#pragma unroll
                for (int u = 0; u < 4; ++u) po[u] += __shfl_xor(po[u], 32);
                if (dg == 0) {
#pragma unroll
                    for (int u = 0; u < 4; ++u) Os[(tl0 + u) * 64 + 8 * w + vl] = po[u]; } }
        }
        __syncthreads();
        if (!PASSA) { const int t = tid >> 3, cc = tid & 7;
          if (t < n) { const int row = row0 + c0 + t;
            const f32x4 o0 = *(const f32x4*)(Os + t * 64 + 8 * cc), o1 = *(const f32x4*)(Os + t * 64 + 8 * cc + 4);
            float o[8] = {o0.x, o0.y, o0.z, o0.w, o1.x, o1.y, o1.z, o1.w};
            float s = 0.f;
#pragma unroll
            for (int i = 0; i < 8; ++i) s += o[i];
            s += __shfl_xor(s, 1); s += __shfl_xor(s, 2); s += __shfl_xor(s, 4);
            const float mu = s * (1.f / 64.f); float q = 0.f;
#pragma unroll
            for (int i = 0; i < 8; ++i) { o[i] -= mu; q += o[i] * o[i]; }
            q += __shfl_xor(q, 1); q += __shfl_xor(q, 2); q += __shfl_xor(q, 4);
            const float rstd = rsqrtf(q * (1.f / 64.f) + EPS);
            const u32x4 gv = *(const u32x4*)(c.PROJ() + (size_t)row * NPROJ + C_RG + h * 64 + 8 * cc);
            const float gt[8] = {bflo(gv.x), bfhi(gv.x), bflo(gv.y), bfhi(gv.y), bflo(gv.z), bfhi(gv.z), bflo(gv.w), bfhi(gv.w)};
            float r[8];
#pragma unroll
            for (int i = 0; i < 8; ++i) r[i] = (o[i] * rstd * rg_g[8 * cc + i] + rg_b[8 * cc + i]) * silu(gt[i]);
            u32x4 wv; wv.x = pk2(r[0], r[1]); wv.y = pk2(r[2], r[3]); wv.z = pk2(r[4], r[5]); wv.w = pk2(r[6], r[7]);
            *(u32x4*)(c.XN() + (size_t)row * D + h * 64 + 8 * cc) = wv; } }
    }
    if (PASSA) { float* E = c.SEG() + SEG_RET / 4 + (size_t)((b * 6 + h) * (NSEG - 1) + seg) * 4096 + (8 * dg) * 64 + 8 * w + vl;
#pragma unroll
        for (int i = 0; i < 8; ++i) E[i * 64] = S[i]; }
    else if (sample || seg == NSEG - 1) {
        float* so = c.out() + (sample ? O_RETS + ((size_t)(l * DB + b) * 6 + h) * 4096 : O_RETP + ((size_t)(l * NB + b) * 6 + h) * 4096) + (8 * dg) * 64 + 8 * w + vl;
#pragma unroll
        for (int i = 0; i < 8; ++i) so[i * 64] = S[i]; }
}

template <bool PASSA>
__device__ __forceinline__ void gla_task(const Ctx& c, int l, bool sample, int b, int h, int seg, float* L) {
    const int tid = c.tid, lane = c.lane, w = c.wave;
    const int vl = lane % 12, dgr = lane / 12, dg = dgr > 3 ? 3 : dgr;
    const int len = sample ? DSEQ : LSEG;
    const int row0 = sample ? TP + b * DSEQ : b * SEQ + seg * LSEG;
    float* Qs = L; float* Ks = L + 3072; float* As = L + 6144; float* Vs = L + 9216; float* Os = L + 15360; float* GW = L + 21504; float* DS = L + 22272;
    for (int i = tid; i < 768; i += 512) { const int r = i / 48, d = i % 48; GW[i] = c.in(I_GGW)[(size_t)(l * 16 + r) * 192 + h * 48 + d]; }
    if (tid < 48) DS[tid] = 0.f;
    float S[12];
    const int vcol = 12 * w + vl;
    if (sample) { const float* s0 = c.in(I_SGLA) + ((size_t)((l * DB + b) * 4 + h) * 48 + 12 * dg) * 96 + vcol;
#pragma unroll
        for (int i = 0; i < 12; ++i) S[i] = s0[i * 96]; }
    else {
#pragma unroll
        for (int i = 0; i < 12; ++i) S[i] = 0.f;
        if (!PASSA) for (int m = 0; m < seg; ++m) { const float* E = c.SEG() + SEG_GLA / 4 + (size_t)((b * 4 + h) * (NSEG - 1) + m) * 4672;
#pragma unroll
            for (int i = 0; i < 12; ++i) S[i] = __expf(E[4608 + 12 * dg + i]) * S[i] + E[(12 * dg + i) * 96 + vcol]; }
    }
    const float* gb = c.in(I_GGB) + l * 192 + h * 48;
    const float* gng = c.in(I_GNG) + l * 96;
    __syncthreads();
    for (int c0 = 0; c0 < len; c0 += 64) {
        const int n = (len - c0) < 64 ? (len - c0) : 64;
        { const int t = tid >> 3, cc = tid & 7;
          if (t < n) { const bf16* pr = c.PROJ() + (size_t)(row0 + c0 + t) * NPROJ;
            const u32x4 g0 = *(const u32x4*)(pr + C_GLR), g1 = *(const u32x4*)(pr + C_GLR + 8);
            const float gl[16] = {bflo(g0.x), bfhi(g0.x), bflo(g0.y), bfhi(g0.y), bflo(g0.z), bfhi(g0.z), bflo(g0.w), bfhi(g0.w),
                                  bflo(g1.x), bfhi(g1.x), bflo(g1.y), bfhi(g1.y), bflo(g1.z), bfhi(g1.z), bflo(g1.w), bfhi(g1.w)};
#pragma unroll
            for (int j = 0; j < 6; ++j) { const int d = 6 * cc + j; float x = gb[d];
#pragma unroll
                for (int r = 0; r < 16; ++r) x = fmaf(gl[r], GW[r * 48 + d], x);
                const float lg = (fminf(x, 0.f) - __logf(1.f + __expf(-fabsf(x)))) * (1.f / 16.f);
                As[t * 48 + d] = __expf(lg);
                if (PASSA) atomicAdd(&DS[d], lg); }
            const unsigned* kq = (const unsigned*)(pr + C_GK + h * 48 + 6 * cc);
#pragma unroll
            for (int j = 0; j < 3; ++j) { const unsigned wv = kq[j]; Ks[t * 48 + 6 * cc + 2 * j] = bflo(wv); Ks[t * 48 + 6 * cc + 2 * j + 1] = bfhi(wv); }
            if (!PASSA) { const unsigned* qq = (const unsigned*)(pr + C_GQ + h * 48 + 6 * cc);
#pragma unroll
                for (int j = 0; j < 3; ++j) { const unsigned wv = qq[j]; Qs[t * 48 + 6 * cc + 2 * j] = bflo(wv) * 0.14433756729740643f; Qs[t * 48 + 6 * cc + 2 * j + 1] = bfhi(wv) * 0.14433756729740643f; } }
            const u32x2* vp = (const u32x2*)(pr + C_GV + h * 96 + 12 * cc);
#pragma unroll
            for (int j = 0; j < 3; ++j) { const u32x2 wv = vp[j]; *(f32x4*)(Vs + t * 96 + 12 * cc + 4 * j) = (f32x4){bflo(wv.x), bfhi(wv.x), bflo(wv.y), bfhi(wv.y)}; } } }
        __syncthreads();
        for (int tl0 = 0; tl0 < n; tl0 += 4) {
            float po[4];
#pragma unroll
            for (int u = 0; u < 4; ++u) { const int tl = tl0 + u;
                const f32x4* kp = (const f32x4*)(Ks + tl * 48 + 12 * dg); const f32x4* ap = (const f32x4*)(As + tl * 48 + 12 * dg);
                const f32x4 k0 = kp[0], k1 = kp[1], k2 = kp[2], a0 = ap[0], a1 = ap[1], a2 = ap[2];
                const float vv = Vs[tl * 96 + vcol];
                const float kk[12] = {k0.x, k0.y, k0.z, k0.w, k1.x, k1.y, k1.z, k1.w, k2.x, k2.y, k2.z, k2.w};
                const float aa[12] = {a0.x, a0.y, a0.z, a0.w, a1.x, a1.y, a1.z, a1.w, a2.x, a2.y, a2.z, a2.w};
#pragma unroll
                for (int i = 0; i < 12; ++i) S[i] = fmaf(aa[i], S[i], kk[i] * vv);
                if (!PASSA) {
                    const f32x4* qp = (const f32x4*)(Qs + tl * 48 + 12 * dg); const f32x4 q0 = qp[0], q1 = qp[1], q2 = qp[2];
                    po[u] = q0.x * S[0] + q0.y * S[1] + q0.z * S[2] + q0.w * S[3] + q1.x * S[4] + q1.y * S[5] + q1.z * S[6] + q1.w * S[7] + q2.x * S[8] + q2.y * S[9] + q2.z * S[10] + q2.w * S[11]; } }
            if (!PASSA) {
#pragma unroll
                for (int u = 0; u < 4; ++u) po[u] += __shfl(po[u], (lane + 24) & 63);
#pragma unroll
                for (int u = 0; u < 4; ++u) po[u] += __shfl(po[u], (lane + 12) & 63);
                if (lane < 12) {
#pragma unroll
                    for (int u = 0; u < 4; ++u) Os[(tl0 + u) * 96 + vcol] = po[u]; } }
        }
        __syncthreads();
        if (!PASSA) { const int t = tid >> 3, cc = tid & 7;
          if (t < n) { const int row = row0 + c0 + t;
            const f32x4* op = (const f32x4*)(Os + t * 96 + 12 * cc); const f32x4 o0 = op[0], o1 = op[1], o2 = op[2];
            const float o[12] = {o0.x, o0.y, o0.z, o0.w, o1.x, o1.y, o1.z, o1.w, o2.x, o2.y, o2.z, o2.w};
            float q = 0.f;
#pragma unroll
            for (int i = 0; i < 12; ++i) q += o[i] * o[i];
            q += __shfl_xor(q, 1); q += __shfl_xor(q, 2); q += __shfl_xor(q, 4);
            const float rs = rsqrtf(q * (1.f / 96.f) + EPS);
            const u32x2* gp = (const u32x2*)(c.PROJ() + (size_t)row * NPROJ + C_GG + h * 96 + 12 * cc);
            u32x2* dst = (u32x2*)(c.XN() + (size_t)row * D + 640 + h * 96 + 12 * cc);
#pragma unroll
            for (int j = 0; j < 3; ++j) { const u32x2 gv = gp[j];
                const float r0 = o[4 * j] * rs * gng[12 * cc + 4 * j] * silu(bflo(gv.x)), r1 = o[4 * j + 1] * rs * gng[12 * cc + 4 * j + 1] * silu(bfhi(gv.x));
                const float r2 = o[4 * j + 2] * rs * gng[12 * cc + 4 * j + 2] * silu(bflo(gv.y)), r3 = o[4 * j + 3] * rs * gng[12 * cc + 4 * j + 3] * silu(bfhi(gv.y));
                u32x2 wv; wv.x = pk2(r0, r1); wv.y = pk2(r2, r3); dst[j] = wv; } } }
    }
    if (PASSA) { float* E = c.SEG() + SEG_GLA / 4 + (size_t)((b * 4 + h) * (NSEG - 1) + seg) * 4672;
        if (lane < 48) {
#pragma unroll
            for (int i = 0; i < 12; ++i) E[(12 * dg + i) * 96 + vcol] = S[i]; }
        if (tid < 48) E[4608 + tid] = DS[tid]; }
    else if (sample || seg == NSEG - 1) {
        float* so = c.out() + (sample ? O_GLAS + ((size_t)(l * DB + b) * 4 + h) * 4608 : O_GLAP + ((size_t)(l * NB + b) * 4 + h) * 4608);
        if (lane < 48) {
#pragma unroll
            for (int i = 0; i < 12; ++i) so[(12 * dg + i) * 96 + vcol] = S[i]; } }
}

template <bool GLA, bool PASSA>
__device__ __forceinline__ void lin_task(const Ctx& c, int l, int b, int h, int seg, float* L) {
    typedef short bf16x8_t __attribute__((ext_vector_type(8)));
    constexpr int DK = GLA ? 48 : 64, DV = GLA ? 96 : 64, NVT = DV / 16, NT = GLA ? 3 : 2, RS = 72;
    const int tid = c.tid, lane = c.lane, w = c.wave, fr = lane & 15, fq = lane >> 4;
    const int row0 = b * SEQ + seg * LSEG;
    bf16* QT = (bf16*)L; bf16* KT = QT + 64 * RS; bf16* KH = KT + 64 * RS; bf16* VT = KH + 64 * RS; bf16* PP = VT + 96 * RS; bf16* ST = PP + 64 * RS;
    float* Os = (float*)(ST + 96 * RS); float* LG = Os + 64 * 96; float* SEGS = LG + 64 * 48; float* BEND = SEGS + 8 * 48; float* GW = BEND + 64;
    const float gamma = 1.f - exp2f(-5.f - (float)h), lg2 = log2f(gamma);
    if (GLA) {
        for (int i = tid; i < 16 * RS; i += 512) KH[48 * RS + i] = 0;
        if (tid < 16) BEND[48 + tid] = 0.f;
    }
    pg8::f32x4 accS[NT];
#pragma unroll
    for (int i = 0; i < NT; ++i) { const int id = w * NT + i, dt = id / NVT, vt = id % NVT, d0 = 16 * dt + 4 * fq, v = 16 * vt + fr;
        accS[i] = (pg8::f32x4){0.f, 0.f, 0.f, 0.f};
        if (!PASSA) {
            if (!GLA) {
#pragma unroll
                for (int m = 0; m < NSEG - 1; ++m) { const float f = m < seg ? exp2f((float)(LSEG * (seg - 1 - m)) * lg2) : 0.f;
                    const float* E = c.SEG() + SEG_RET / 4 + (size_t)((b * 6 + h) * (NSEG - 1) + m) * 4096;
#pragma unroll
                    for (int r = 0; r < 4; ++r) accS[i][r] += f * E[(d0 + r) * 64 + v]; } }
            else if (d0 < 48) {
#pragma unroll
                for (int m = 0; m < NSEG - 1; ++m) { const float* E = c.SEG() + SEG_GLA / 4 + (size_t)((b * 4 + h) * (NSEG - 1) + m) * 4672;
#pragma unroll
                    for (int r = 0; r < 4; ++r) { const float dl = E[4608 + d0 + r], ev = E[(d0 + r) * 96 + v]; accS[i][r] = m < seg ? __expf(dl) * accS[i][r] + ev : accS[i][r]; } } }
            u32x2 sv; sv.x = pk2(accS[i][0], accS[i][1]); sv.y = pk2(accS[i][2], accS[i][3]); *(u32x2*)(ST + v * RS + d0) = sv;
        } }
    float dlsum[6] = {0.f, 0.f, 0.f, 0.f, 0.f, 0.f};
    const float* gb = c.in(I_GGB) + l * 192 + h * 48;
    const int gt0 = w, gt1 = w + 8, gmt0 = gt0 / 3, gnt0 = gt0 % 3, gmt1 = (gt1 < 12 ? gt1 : 0) / 3, gnt1 = (gt1 < 12 ? gt1 : 0) % 3;
    bf16x8_t gwf0 = {0, 0, 0, 0, 0, 0, 0, 0}, gwf1 = {0, 0, 0, 0, 0, 0, 0, 0};
    if (GLA && fq < 2) { const float* gw = c.in(I_GGW) + (size_t)(l * 16 + 8 * fq) * 192 + h * 48 + fr;
        float t0[8], t1[8];
#pragma unroll
        for (int j = 0; j < 8; ++j) { t0[j] = gw[(size_t)j * 192 + 16 * gnt0]; t1[j] = gw[(size_t)j * 192 + 16 * gnt1]; }
        u32x4 a = {pk2(t0[0], t0[1]), pk2(t0[2], t0[3]), pk2(t0[4], t0[5]), pk2(t0[6], t0[7])}, bq = {pk2(t1[0], t1[1]), pk2(t1[2], t1[3]), pk2(t1[4], t1[5]), pk2(t1[6], t1[7])};
        gwf0 = __builtin_bit_cast(bf16x8_t, a); gwf1 = __builtin_bit_cast(bf16x8_t, bq); }
    __syncthreads();
    const int t = tid >> 3, cc = tid & 7;
    u32x2 r_klo, r_khi, r_qlo, r_qhi; u32x4 r_v4, r_g4; f32x4 r_cs, r_sn;
    u32x4 r_glr0 = {0u, 0u, 0u, 0u}, r_glr1 = {0u, 0u, 0u, 0u}; unsigned r_k[3], r_q[3]; u32x2 r_v2[3], r_g2[3];
#define LIN_LOAD(cn) do { const bf16* pr_ = c.PROJ() + (size_t)(row0 + (cn) + t) * NPROJ; \
        if (!GLA) { const float* rc_ = c.ROPE() + (size_t)(seg * LSEG + (cn) + t) * 32 + 4 * cc; r_cs = *(const f32x4*)rc_; r_sn = *(const f32x4*)(rc_ + 2052 * 32); \
            r_klo = *(const u32x2*)(pr_ + C_RK + h * 64 + 4 * cc); r_khi = *(const u32x2*)(pr_ + C_RK + h * 64 + 32 + 4 * cc); r_v4 = *(const u32x4*)(pr_ + C_RV + h * 64 + 8 * cc); \
            if (!PASSA) { r_qlo = *(const u32x2*)(pr_ + C_RQ + h * 64 + 4 * cc); r_qhi = *(const u32x2*)(pr_ + C_RQ + h * 64 + 32 + 4 * cc); r_g4 = *(const u32x4*)(pr_ + C_RG + h * 64 + 8 * cc); } } \
        else { if (fq < 2) { r_glr0 = *(const u32x4*)(c.PROJ() + (size_t)(row0 + (cn) + 16 * gmt0 + fr) * NPROJ + C_GLR + 8 * fq); if (gt1 < 12) r_glr1 = *(const u32x4*)(c.PROJ() + (size_t)(row0 + (cn) + 16 * gmt1 + fr) * NPROJ + C_GLR + 8 * fq); } \
            _Pragma("unroll") for (int j_ = 0; j_ < 3; ++j_) { r_k[j_] = ((const unsigned*)(pr_ + C_GK + h * 48 + 6 * cc))[j_]; r_v2[j_] = ((const u32x2*)(pr_ + C_GV + h * 96 + 12 * cc))[j_]; \
                if (!PASSA) { r_q[j_] = ((const unsigned*)(pr_ + C_GQ + h * 48 + 6 * cc))[j_]; r_g2[j_] = ((const u32x2*)(pr_ + C_GG + h * 96 + 12 * cc))[j_]; } } } } while (0)
    LIN_LOAD(0);
    for (int c0 = 0; c0 < LSEG; c0 += 64) {
        u32x4 g4c = {0u, 0u, 0u, 0u}; u32x2 g2c[3] = {{0u, 0u}, {0u, 0u}, {0u, 0u}};
        if (!PASSA) { if (!GLA) g4c = r_g4; else { g2c[0] = r_g2[0]; g2c[1] = r_g2[1]; g2c[2] = r_g2[2]; } }
        if (!GLA) {
            const f32x4 cs = r_cs, sn = r_sn;
            const float eq = __builtin_amdgcn_exp2f((float)(t + 1) * lg2), ek = __builtin_amdgcn_exp2f(-(float)(t + 1) * lg2) * 0.125f, eh = __builtin_amdgcn_exp2f((float)(63 - t) * lg2) * 0.125f;
            { const u32x2 lo = r_klo, hi = r_khi;
              const f32x4 x1 = {bflo(lo.x), bfhi(lo.x), bflo(lo.y), bfhi(lo.y)}, x2 = {bflo(hi.x), bfhi(hi.x), bflo(hi.y), bfhi(hi.y)};
              const f32x4 k1 = x1 * cs - x2 * sn, k2 = x1 * sn + x2 * cs;
              if (!PASSA) { u32x2 a; a.x = pk2(k1.x * ek, k1.y * ek); a.y = pk2(k1.z * ek, k1.w * ek); *(u32x2*)(KT + t * RS + 4 * cc) = a;
                            u32x2 bq; bq.x = pk2(k2.x * ek, k2.y * ek); bq.y = pk2(k2.z * ek, k2.w * ek); *(u32x2*)(KT + t * RS + 32 + 4 * cc) = bq; }
#pragma unroll
              for (int e = 0; e < 4; ++e) { KH[(4 * cc + e) * RS + t] = (bf16)f2bf(k1[e] * eh); KH[(32 + 4 * cc + e) * RS + t] = (bf16)f2bf(k2[e] * eh); } }
            if (!PASSA) { const u32x2 lo = r_qlo, hi = r_qhi;
              const f32x4 x1 = {bflo(lo.x), bfhi(lo.x), bflo(lo.y), bfhi(lo.y)}, x2 = {bflo(hi.x), bfhi(hi.x), bflo(hi.y), bfhi(hi.y)};
              const f32x4 q1 = (x1 * cs - x2 * sn) * eq, q2 = (x1 * sn + x2 * cs) * eq;
              u32x2 a; a.x = pk2(q1.x, q1.y); a.y = pk2(q1.z, q1.w); *(u32x2*)(QT + t * RS + 4 * cc) = a;
              u32x2 bq; bq.x = pk2(q2.x, q2.y); bq.y = pk2(q2.z, q2.w); *(u32x2*)(QT + t * RS + 32 + 4 * cc) = bq; }
            { const unsigned vw[4] = {r_v4.x, r_v4.y, r_v4.z, r_v4.w};
#pragma unroll
              for (int e = 0; e < 4; ++e) { VT[(8 * cc + 2 * e) * RS + t] = (bf16)(vw[e] & 0xffffu); VT[(8 * cc + 2 * e + 1) * RS + t] = (bf16)(vw[e] >> 16); } }
            if (c0 + 64 < LSEG) LIN_LOAD(c0 + 64);
        } else {
            float kf[6], qf[6]; unsigned vw[6];
            { { const pg8::f32x4 z4 = {0.f, 0.f, 0.f, 0.f};
                const pg8::f32x4 x0 = __builtin_amdgcn_mfma_f32_16x16x32_bf16(__builtin_bit_cast(bf16x8_t, r_glr0), gwf0, z4, 0, 0, 0);
                const float b0 = gb[16 * gnt0 + fr];
#pragma unroll
                for (int j = 0; j < 4; ++j) { const float x = x0[j] + b0; LG[(16 * gmt0 + 4 * fq + j) * 48 + 16 * gnt0 + fr] = (fminf(x, 0.f) - __logf(1.f + __expf(-fabsf(x)))) * (1.f / 16.f); }
                if (gt1 < 12) { const pg8::f32x4 x1 = __builtin_amdgcn_mfma_f32_16x16x32_bf16(__builtin_bit_cast(bf16x8_t, r_glr1), gwf1, z4, 0, 0, 0);
                    const float b1 = gb[16 * gnt1 + fr];
#pragma unroll
                    for (int j = 0; j < 4; ++j) { const float x = x1[j] + b1; LG[(16 * gmt1 + 4 * fq + j) * 48 + 16 * gnt1 + fr] = (fminf(x, 0.f) - __logf(1.f + __expf(-fabsf(x)))) * (1.f / 16.f); } } }
#pragma unroll
              for (int j = 0; j < 3; ++j) { const unsigned wv = r_k[j]; kf[2 * j] = bflo(wv); kf[2 * j + 1] = bfhi(wv); }
              if (!PASSA) {
#pragma unroll
                  for (int j = 0; j < 3; ++j) { const unsigned wv = r_q[j]; qf[2 * j] = bflo(wv) * 0.14433756729740643f; qf[2 * j + 1] = bfhi(wv) * 0.14433756729740643f; } }
#pragma unroll
              for (int j = 0; j < 3; ++j) { vw[2 * j] = r_v2[j].x; vw[2 * j + 1] = r_v2[j].y; } }
            if (c0 + 64 < LSEG) LIN_LOAD(c0 + 64);
            __syncthreads();
            if (tid < 384) { const int d = tid % 48, sg = tid / 48; float lv[8];
#pragma unroll
                for (int i = 0; i < 8; ++i) lv[i] = LG[(8 * sg + i) * 48 + d];
#pragma unroll
                for (int i = 1; i < 8; ++i) lv[i] += lv[i - 1];
#pragma unroll
                for (int i = 0; i < 8; ++i) LG[(8 * sg + i) * 48 + d] = lv[i];
                SEGS[sg * 48 + d] = lv[7]; }
            __syncthreads();
            { float qv[6], kv[6];
#pragma unroll
              for (int j = 0; j < 6; ++j) { const int d = 6 * cc + j; float pre = 0.f, tot = 0.f;
#pragma unroll
                for (int s = 0; s < 8; ++s) { const float sv = SEGS[s * 48 + d]; tot += sv; if (s < (t >> 3)) pre += sv; }
                pre += LG[t * 48 + d];
                if (!PASSA) { qv[j] = qf[j] * __expf(pre); kv[j] = kf[j] * __expf(-pre); }
                KH[d * RS + t] = (bf16)f2bf(kf[j] * __expf(tot - pre));
                if (t == 0) { BEND[d] = tot; dlsum[j] += tot; } }
              if (!PASSA) {
#pragma unroll
                for (int j = 0; j < 3; ++j) { *(unsigned*)(QT + t * RS + 6 * cc + 2 * j) = pk2(qv[2 * j], qv[2 * j + 1]); *(unsigned*)(KT + t * RS + 6 * cc + 2 * j) = pk2(kv[2 * j], kv[2 * j + 1]); } } }
            if (!PASSA) { *(unsigned*)(QT + t * RS + 48 + 2 * cc) = 0u; *(unsigned*)(KT + t * RS + 48 + 2 * cc) = 0u; }
#pragma unroll
            for (int e = 0; e < 6; ++e) { VT[(12 * cc + 2 * e) * RS + t] = (bf16)(vw[e] & 0xffffu); VT[(12 * cc + 2 * e + 1) * RS + t] = (bf16)(vw[e] >> 16); }
        }
        __syncthreads();
        if (!PASSA) {
#pragma unroll
            for (int i = 0; i < 2; ++i) { const int id = 2 * w + i, it = id >> 2, jt = id & 3;
                pg8::f32x4 acc = {0.f, 0.f, 0.f, 0.f};
                if (jt <= it) {
#pragma unroll
                    for (int ks = 0; ks < 2; ++ks) { const bf16x8_t a = *(const bf16x8_t*)(KT + (16 * jt + fr) * RS + 32 * ks + 8 * fq), bq = *(const bf16x8_t*)(QT + (16 * it + fr) * RS + 32 * ks + 8 * fq);
                        acc = __builtin_amdgcn_mfma_f32_16x16x32_bf16(a, bq, acc, 0, 0, 0); } }
                { const int ii = 16 * it + fr, j0 = 16 * jt + 4 * fq;
                  u32x2 pw; pw.x = pk2(j0 <= ii ? acc[0] : 0.f, j0 + 1 <= ii ? acc[1] : 0.f); pw.y = pk2(j0 + 2 <= ii ? acc[2] : 0.f, j0 + 3 <= ii ? acc[3] : 0.f);
                  *(u32x2*)(PP + ii * RS + j0) = pw; } } }
#pragma unroll
        for (int i = 0; i < NT; ++i) { const int id = w * NT + i, dt = id / NVT, vt = id % NVT;
            if (GLA) {
#pragma unroll
                for (int r = 0; r < 4; ++r) accS[i][r] *= __expf(BEND[16 * dt + 4 * fq + r]); }
            else { const float g64 = exp2f(64.f * lg2); accS[i] = accS[i] * g64; }
#pragma unroll
            for (int ks = 0; ks < 2; ++ks) { const bf16x8_t a = *(const bf16x8_t*)(KH + (16 * dt + fr) * RS + 32 * ks + 8 * fq), bv = *(const bf16x8_t*)(VT + (16 * vt + fr) * RS + 32 * ks + 8 * fq);
                accS[i] = __builtin_amdgcn_mfma_f32_16x16x32_bf16(a, bv, accS[i], 0, 0, 0); } }
        __syncthreads();
        if (!PASSA) {
#pragma unroll
            for (int i = 0; i < NT; ++i) { const int id = w * NT + i, it = id / NVT, vt = id % NVT;
                pg8::f32x4 acc = {0.f, 0.f, 0.f, 0.f};
#pragma unroll
                for (int ks = 0; ks < 2; ++ks) { const bf16x8_t a = *(const bf16x8_t*)(PP + (16 * it + fr) * RS + 32 * ks + 8 * fq), bv = *(const bf16x8_t*)(VT + (16 * vt + fr) * RS + 32 * ks + 8 * fq);
                    acc = __builtin_amdgcn_mfma_f32_16x16x32_bf16(a, bv, acc, 0, 0, 0); }
#pragma unroll
                for (int ks = 0; ks < 2; ++ks) { const bf16x8_t a = *(const bf16x8_t*)(QT + (16 * it + fr) * RS + 32 * ks + 8 * fq), bs = *(const bf16x8_t*)(ST + (16 * vt + fr) * RS + 32 * ks + 8 * fq);
                    acc = __builtin_amdgcn_mfma_f32_16x16x32_bf16(a, bs, acc, 0, 0, 0); }
#pragma unroll
                for (int r = 0; r < 4; ++r) Os[(16 * it + 4 * fq + r) * DV + 16 * vt + fr] = acc[r]; } }
        __syncthreads();
        if (!PASSA) {
#pragma unroll
            for (int i = 0; i < NT; ++i) { const int id = w * NT + i, dt = id / NVT, vt = id % NVT, d0 = 16 * dt + 4 * fq, v = 16 * vt + fr;
                u32x2 sv; sv.x = pk2(accS[i][0], accS[i][1]); sv.y = pk2(accS[i][2], accS[i][3]); *(u32x2*)(ST + v * RS + d0) = sv; }
            const int row = row0 + c0 + t;
            if (!GLA) {
                const f32x4 o0 = *(const f32x4*)(Os + t * 64 + 8 * cc), o1 = *(const f32x4*)(Os + t * 64 + 8 * cc + 4);
                float o[8] = {o0.x, o0.y, o0.z, o0.w, o1.x, o1.y, o1.z, o1.w};
                float s = 0.f;
#pragma unroll
                for (int i = 0; i < 8; ++i) s += o[i];
                s += __shfl_xor(s, 1); s += __shfl_xor(s, 2); s += __shfl_xor(s, 4);
                const float mu = s * (1.f / 64.f); float q = 0.f;
#pragma unroll
                for (int i = 0; i < 8; ++i) { o[i] -= mu; q += o[i] * o[i]; }
                q += __shfl_xor(q, 1); q += __shfl_xor(q, 2); q += __shfl_xor(q, 4);
                const float rstd = rsqrtf(q * (1.f / 64.f) + EPS);
                const float* rg_g = c.in(I_RNG) + l * 384 + h * 64; const float* rg_b = c.in(I_RNB) + l * 384 + h * 64;
                const u32x4 gv = g4c;
                const float gt[8] = {bflo(gv.x), bfhi(gv.x), bflo(gv.y), bfhi(gv.y), bflo(gv.z), bfhi(gv.z), bflo(gv.w), bfhi(gv.w)};
                float r[8];
#pragma unroll
                for (int i = 0; i < 8; ++i) r[i] = (o[i] * rstd * rg_g[8 * cc + i] + rg_b[8 * cc + i]) * silu(gt[i]);
                u32x4 wv; wv.x = pk2(r[0], r[1]); wv.y = pk2(r[2], r[3]); wv.z = pk2(r[4], r[5]); wv.w = pk2(r[6], r[7]);
                *(u32x4*)(c.XN() + (size_t)row * D + h * 64 + 8 * cc) = wv;
            } else {
                const float* gng = c.in(I_GNG) + l * 96;
                const f32x4* op = (const f32x4*)(Os + t * 96 + 12 * cc); const f32x4 o0 = op[0], o1 = op[1], o2 = op[2];
                const float o[12] = {o0.x, o0.y, o0.z, o0.w, o1.x, o1.y, o1.z, o1.w, o2.x, o2.y, o2.z, o2.w};
                float q = 0.f;
#pragma unroll
                for (int i = 0; i < 12; ++i) q += o[i] * o[i];
                q += __shfl_xor(q, 1); q += __shfl_xor(q, 2); q += __shfl_xor(q, 4);
                const float rs = rsqrtf(q * (1.f / 96.f) + EPS);
                u32x2* dst = (u32x2*)(c.XN() + (size_t)row * D + 640 + h * 96 + 12 * cc);
#pragma unroll
                for (int j = 0; j < 3; ++j) { const u32x2 gv = g2c[j];
                    const float r0 = o[4 * j] * rs * gng[12 * cc + 4 * j] * silu(bflo(gv.x)), r1 = o[4 * j + 1] * rs * gng[12 * cc + 4 * j + 1] * silu(bfhi(gv.x));
                    const float r2 = o[4 * j + 2] * rs * gng[12 * cc + 4 * j + 2] * silu(bflo(gv.y)), r3 = o[4 * j + 3] * rs * gng[12 * cc + 4 * j + 3] * silu(bfhi(gv.y));
                    u32x2 wv; wv.x = pk2(r0, r1); wv.y = pk2(r2, r3); dst[j] = wv; }
            }
        }
    }
    if (PASSA || seg == NSEG - 1) {
        float* E = PASSA ? c.SEG() + (GLA ? SEG_GLA / 4 + (size_t)((b * 4 + h) * (NSEG - 1) + seg) * 4672 : SEG_RET / 4 + (size_t)((b * 6 + h) * (NSEG - 1) + seg) * 4096)
                         : c.out() + (GLA ? O_GLAP + ((size_t)(l * NB + b) * 4 + h) * 4608 : O_RETP + ((size_t)(l * NB + b) * 6 + h) * 4096);
#pragma unroll
        for (int i = 0; i < NT; ++i) { const int id = w * NT + i, dt = id / NVT, vt = id % NVT, d0 = 16 * dt + 4 * fq, v = 16 * vt + fr;
            if (d0 < DK) {
#pragma unroll
                for (int r = 0; r < 4; ++r) E[(d0 + r) * DV + v] = accS[i][r]; } }
        if (GLA && PASSA && tid < 8) {
#pragma unroll
            for (int j = 0; j < 6; ++j) E[4608 + 6 * tid + j] = dlsum[j]; }
    }
}

template <bool PASSA>
__device__ __forceinline__ void s5_task(const Ctx& c, int l, bool sample, int b, int oct, int seg, float* L) {
    typedef short bf16x8_t __attribute__((ext_vector_type(8)));
    const int tid = c.tid, lane = c.lane, w = c.wave, fr = lane & 15, fq = lane >> 4;
    const int g = 8 * oct + w, p = lane;
    const int len = sample ? 64 : LSEG5;
    const int row0 = sample ? TP + b * 64 : b * SEQ + seg * LSEG5;
    constexpr int HS = 136;
    bf16* Ub = (bf16*)L;
    float* Xw = L + 4096 + w * 2048;
    bf16* Hw = (bf16*)(L + 20480) + w * (16 * HS);
    float ar, ai;
    bf16x8_t bx[8], cb[4];
    { const int gp = (l * 16 + g) * 64 + p;
      const float lr = fminf(c.in(I_LRE)[gp], -1e-4f), li = c.in(I_LIM)[gp], dt = expf(c.in(I_LDT)[l * 16 + g]);
      const float mag = expf(lr * dt), ang = li * dt; ar = mag * cosf(ang); ai = mag * sinf(ang);
      const float den = lr * lr + li * li, cr = ((ar - 1.f) * lr + ai * li) / den, ci = (ai * lr - (ar - 1.f) * li) / den;
#pragma unroll
      for (int n = 0; n < 8; ++n) { const int ps = 16 * (n & 3) + fr; const float crs = __shfl(cr, ps), cis = __shfl(ci, ps);
          u32x4 t4 = {0u, 0u, 0u, 0u};
          if (fq < 2) { const float* brp = c.in(I_BRE) + ((size_t)((l * 16 + g) * 64 + ps)) * 16 + 8 * fq; const float* bip = c.in(I_BIM) + ((size_t)((l * 16 + g) * 64 + ps)) * 16 + 8 * fq;
              const f32x4 r0 = *(const f32x4*)brp, r1 = *(const f32x4*)(brp + 4), i0 = *(const f32x4*)bip, i1 = *(const f32x4*)(bip + 4);
              float v[8];
#pragma unroll
              for (int e = 0; e < 4; ++e) { v[e] = n < 4 ? crs * r0[e] - cis * i0[e] : crs * i0[e] + cis * r0[e]; v[4 + e] = n < 4 ? crs * r1[e] - cis * i1[e] : crs * i1[e] + cis * r1[e]; }
              t4 = (u32x4){pk2(v[0], v[1]), pk2(v[2], v[3]), pk2(v[4], v[5]), pk2(v[6], v[7])}; }
          bx[n] = __builtin_bit_cast(bf16x8_t, t4); }
      if (!PASSA) {
#pragma unroll
          for (int s = 0; s < 4; ++s) { const float* src = (s < 2 ? c.in(I_CRE) : c.in(I_CIM)) + (size_t)((l * 16 + g) * 16 + fr) * 64 + 32 * (s & 1) + 8 * fq;
              const f32x4 v0 = *(const f32x4*)src, v1 = *(const f32x4*)(src + 4); const float sg = s < 2 ? 1.f : -1.f;
              u32x4 t4 = {pk2(sg * v0.x, sg * v0.y), pk2(sg * v0.z, sg * v0.w), pk2(sg * v1.x, sg * v1.y), pk2(sg * v1.z, sg * v1.w)}; cb[s] = __builtin_bit_cast(bf16x8_t, t4); } }
    }
    float hr = 0.f, hi = 0.f;
    float s0r[16], s0i[16];
    if (sample) {
#pragma unroll
        for (int j = 0; j < 16; ++j) { s0r[j] = c.in(I_S5R)[(size_t)(l * DB + 16 * b + j) * 1024 + g * 64 + p]; s0i[j] = c.in(I_S5I)[(size_t)(l * DB + 16 * b + j) * 1024 + g * 64 + p]; } }
    else {
        if (!PASSA && seg > 0) { float pr = ar, pi = ai;
#pragma unroll
            for (int k = 0; k < LOG2_LSEG5; ++k) { const float nr = pr * pr - pi * pi, ni = 2.f * pr * pi; pr = nr; pi = ni; }
            float er[NSEG5 - 1], ei[NSEG5 - 1];
#pragma unroll
            for (int m = 0; m < NSEG5 - 1; ++m) { const float* E = c.SEG() + SEG_S5 / 4 + (size_t)(b * (NSEG5 - 1) + m) * 2048 + g * 64 + p; er[m] = E[0]; ei[m] = E[1024]; }
#pragma unroll
            for (int m = 0; m < NSEG5 - 1; ++m) { if (m < seg) { const float nr = pr * hr - pi * hi + er[m], ni = pr * hi + pi * hr + ei[m]; hr = nr; hi = ni; } } }
    }
    static_assert(LSEG5 == (1 << LOG2_LSEG5), "A^LSEG5 squaring count");
    const float dval = c.in(I_S5D)[l * 256 + 128 * oct + 16 * w + fr];
    for (int c0 = 0; c0 < len; c0 += 64) {
        const int n = (len - c0) < 64 ? (len - c0) : 64;
        { const int t = tid >> 3, cc = tid & 7;
          if (t < n) { const bf16* pr = c.PROJ() + (size_t)(row0 + c0 + t) * NPROJ + C_SU + 128 * oct + 16 * cc;
            const u32x4 u0 = *(const u32x4*)pr, u1 = *(const u32x4*)(pr + 8);
            *(u32x4*)(Ub + t * 128 + 16 * cc) = u0; *(u32x4*)(Ub + t * 128 + 16 * cc + 8) = u1; } }
        __syncthreads();
#pragma unroll
        for (int tb = 0; tb < 64; tb += 16) { if (tb >= n) break;
            const int nb = (n - tb) < 16 ? (n - tb) : 16;
            { bf16x8_t a = {0, 0, 0, 0, 0, 0, 0, 0};
              if (fq < 2) a = *(const bf16x8_t*)(Ub + (tb + fr) * 128 + 16 * w + 8 * fq);
#pragma unroll
              for (int n8 = 0; n8 < 8; ++n8) { const pg8::f32x4 z4 = {0.f, 0.f, 0.f, 0.f};
                  const pg8::f32x4 xa = __builtin_amdgcn_mfma_f32_16x16x32_bf16(a, bx[n8], z4, 0, 0, 0);
#pragma unroll
                  for (int j = 0; j < 4; ++j) Xw[(4 * fq + j) * 128 + 16 * n8 + fr] = xa[j]; } }
            asm volatile("s_waitcnt lgkmcnt(0)" ::: "memory");
#pragma unroll
            for (int tt = 0; tt < 16; ++tt) { if (tt >= nb) break;
                if (sample && (tt & 3) == 0) { hr = s0r[(tb + tt) >> 2]; hi = s0i[(tb + tt) >> 2]; }
                typedef float f32x2 __attribute__((ext_vector_type(2)));
                f32x2 hn = (f32x2){Xw[tt * 128 + p], Xw[tt * 128 + 64 + p]} + (f32x2){hr, hi} * ar;
                hn += (f32x2){-hi, hr} * ai; hr = hn.x; hi = hn.y;
                if (!PASSA && sample && (tt & 3) == 3) { const size_t so = (size_t)(l * DB + 16 * b + ((tb + tt) >> 2)) * 1024 + g * 64 + p; c.out()[O_S5RS + so] = hr; c.out()[O_S5IS + so] = hi; }
                if (!PASSA) { const unsigned hh = pk2(hr, hi); Hw[tt * HS + p] = (bf16)(hh & 0xffffu); Hw[tt * HS + 64 + p] = (bf16)(hh >> 16); }
            }
            if (!PASSA) {
                asm volatile("s_waitcnt lgkmcnt(0)" ::: "memory");
                pg8::f32x4 acc = {0.f, 0.f, 0.f, 0.f};
#pragma unroll
                for (int s = 0; s < 4; ++s) { const bf16x8_t a = *(const bf16x8_t*)(Hw + fr * HS + 32 * s + 8 * fq);
                    acc = __builtin_amdgcn_mfma_f32_16x16x32_bf16(a, cb[s], acc, 0, 0, 0); }
#pragma unroll
                for (int j = 0; j < 4; ++j) { const int tq = 4 * fq + j;
                    if (tq < nb) { const int t = tb + tq; const float u = bflo((unsigned)Ub[t * 128 + 16 * w + fr]);
                        c.Y5()[(size_t)(row0 + c0 + t) * 256 + 128 * oct + 16 * w + fr] = (bf16)f2bf(gelu_tanh(acc[j] + dval * u)); } }
            }
            asm volatile("s_waitcnt lgkmcnt(0)" ::: "memory");
        }
        __syncthreads();
    }
    if (PASSA) { float* E = c.SEG() + SEG_S5 / 4 + (size_t)(b * (NSEG5 - 1) + seg) * 2048 + g * 64 + p; E[0] = hr; E[1024] = hi; }
    else if (sample) { }
    else if (seg == NSEG5 - 1) { c.out()[O_S5RP + (size_t)(l * NB + b) * 1024 + g * 64 + p] = hr; c.out()[O_S5IP + (size_t)(l * NB + b) * 1024 + g * 64 + p] = hi; }
}

__device__ __forceinline__ void ret_sample_wave(const Ctx& c, int l, int b, int h) {
    const int lane = c.lane, f = lane & 31;
    const float gamma = 1.f - exp2f(-5.f - (float)h);
    float S[64];
    const float* s0 = c.in(I_SRET) + ((size_t)((l * DB + b) * 6 + h) * 64) * 64 + lane;
#pragma unroll
    for (int d = 0; d < 64; ++d) { S[d] = s0[d * 64]; if ((d & 15) == 15) asm volatile("" ::: "memory"); }
    const float ng = c.in(I_RNG)[l * 384 + h * 64 + lane], nb = c.in(I_RNB)[l * 384 + h * 64 + lane];
#pragma unroll 1
    for (int t = 0; t < DSEQ; ++t) {
        const int row = TP + b * DSEQ + t;
        const bf16* pr = c.PROJ() + (size_t)row * NPROJ;
        const float cs = c.ROPE()[(2048 + t) * 32 + f], sn = c.ROPE()[2052 * 32 + (2048 + t) * 32 + f];
        const float ka = bflo((unsigned)pr[C_RK + h * 64 + f]), kb = bflo((unsigned)pr[C_RK + h * 64 + 32 + f]);
        const float qa = bflo((unsigned)pr[C_RQ + h * 64 + f]), qb = bflo((unsigned)pr[C_RQ + h * 64 + 32 + f]);
        const float kk = (lane < 32 ? ka * cs - kb * sn : ka * sn + kb * cs) * 0.125f;
        const float qq = lane < 32 ? qa * cs - qb * sn : qa * sn + qb * cs;
        const float vv = bflo((unsigned)pr[C_RV + h * 64 + lane]), gt = bflo((unsigned)pr[C_RG + h * 64 + lane]);
        float o = 0.f;
#pragma unroll
        for (int d = 0; d < 64; ++d) { const float kd = rdl(kk, d), qd = rdl(qq, d); S[d] = fmaf(gamma, S[d], kd * vv); o = fmaf(qd, S[d], o); }
        const float mu = wave_sum(o) * (1.f / 64.f), dv = o - mu, rstd = rsqrtf(wave_sum(dv * dv) * (1.f / 64.f) + EPS);
        c.XN()[(size_t)row * D + h * 64 + lane] = (bf16)f2bf((dv * rstd * ng + nb) * silu(gt));
    }
    float* so = c.out() + O_RETS + ((size_t)(l * DB + b) * 6 + h) * 4096 + lane;
#pragma unroll
    for (int d = 0; d < 64; ++d) { so[d * 64] = S[d]; if ((d & 15) == 15) asm volatile("" ::: "memory"); }
}
__device__ __forceinline__ void gla_sample_wave(const Ctx& c, int l, int b, int h) {
    const int lane = c.lane, l2 = 64 + (lane & 31), dl = lane < 48 ? lane : 47;
    float S1[48], S2[48];
    const float* s0 = c.in(I_SGLA) + ((size_t)((l * DB + b) * 4 + h) * 48) * 96;
#pragma unroll
    for (int d = 0; d < 48; ++d) { S1[d] = s0[d * 96 + lane]; S2[d] = s0[d * 96 + l2]; if ((d & 3) == 3) asm volatile("" ::: "memory"); }
    const float* gwp = c.in(I_GGW) + (size_t)(l * 16) * 192 + h * 48 + dl;
    const float gbd = c.in(I_GGB)[l * 192 + h * 48 + dl];
    const float n1 = c.in(I_GNG)[l * 96 + lane], n2 = c.in(I_GNG)[l * 96 + l2];
#pragma unroll 1
    for (int t = 0; t < DSEQ; ++t) {
        const int row = TP + b * DSEQ + t;
        const bf16* pr = c.PROJ() + (size_t)row * NPROJ;
        const u32x4 g0 = *(const u32x4*)(pr + C_GLR), g1 = *(const u32x4*)(pr + C_GLR + 8);
        const float gl[16] = {bflo(g0.x), bfhi(g0.x), bflo(g0.y), bfhi(g0.y), bflo(g0.z), bfhi(g0.z), bflo(g0.w), bfhi(g0.w),
                              bflo(g1.x), bfhi(g1.x), bflo(g1.y), bfhi(g1.y), bflo(g1.z), bfhi(g1.z), bflo(g1.w), bfhi(g1.w)};
        float x = gbd;
#pragma unroll
        for (int r = 0; r < 16; ++r) x = fmaf(gl[r], gwp[r * 192], x);
        const float al = __expf((fminf(x, 0.f) - __logf(1.f + __expf(-fabsf(x)))) * (1.f / 16.f));
        const float kk = lane < 48 ? bflo((unsigned)pr[C_GK + h * 48 + dl]) : 0.f;
        const float qq = lane < 48 ? bflo((unsigned)pr[C_GQ + h * 48 + dl]) * 0.14433756729740643f : 0.f;
        const float v1 = bflo((unsigned)pr[C_GV + h * 96 + lane]), v2 = bflo((unsigned)pr[C_GV + h * 96 + l2]);
        const float t1 = bflo((unsigned)pr[C_GG + h * 96 + lane]), t2 = bflo((unsigned)pr[C_GG + h * 96 + l2]);
        float o1 = 0.f, o2 = 0.f;
#pragma unroll
        for (int d = 0; d < 48; ++d) { const float ad = rdl(al, d), kd = rdl(kk, d), qd = rdl(qq, d);
            S1[d] = fmaf(ad, S1[d], kd * v1); o1 = fmaf(qd, S1[d], o1); S2[d] = fmaf(ad, S2[d], kd * v2); o2 = fmaf(qd, S2[d], o2); }
        const float rs = rsqrtf(wave_sum(o1 * o1 + (lane < 32 ? o2 * o2 : 0.f)) * (1.f / 96.f) + EPS);
        bf16* dst = c.XN() + (size_t)row * D + 640 + h * 96;
        dst[lane] = (bf16)f2bf(o1 * rs * n1 * silu(t1));
        if (lane < 32) dst[l2] = (bf16)f2bf(o2 * rs * n2 * silu(t2));
    }
    float* so = c.out() + O_GLAS + ((size_t)(l * DB + b) * 4 + h) * 4608;
#pragma unroll
    for (int d = 0; d < 48; ++d) { so[d * 96 + lane] = S1[d]; if (lane < 32) so[d * 96 + l2] = S2[d]; if ((d & 3) == 3) asm volatile("" ::: "memory"); }
}

struct OneUnit {
    int pm, pn;
    __device__ bool next(int i, pg8::Unit& u) const { if (i != 0) return false; u.pm = pm; u.pn = pn; u.ko = 0; return true; }
    __device__ __forceinline__ void a_ready(const pg8::Unit&) const {}
    __device__ __forceinline__ void done(const pg8::Unit&) const {}
};
#define MIX_QUEUE_BEGIN(NTASK, CTR) \
    volatile __attribute__((address_space(3))) unsigned* qw_ = (volatile __attribute__((address_space(3))) unsigned*)((PG8_LAS unsigned char*)L_las + 143360 + 64); \
    unsigned* ctr_ = (unsigned*)c0_.ap->ws + (CTR); \
    int qi_ = 0; \
    for (int task = c0_.bx; task < (NTASK); ) { \
        Ctx c = c0_; asm volatile("" : "+v"(c.tid)); c.lane = c.tid & 63; c.wave = __builtin_amdgcn_readfirstlane(c.tid >> 6); \
        unsigned nxt_ = 0u; if (c.tid == 0) nxt_ = __hip_atomic_fetch_add(ctr_, 1u, __ATOMIC_RELAXED, __HIP_MEMORY_SCOPE_AGENT); \
        int r = task;
#define MIX_QUEUE_END() \
        __syncthreads(); \
        if (c.tid == 0) qw_[qi_] = nxt_ + (unsigned)c0_.G; \
        __syncthreads(); \
        task = (int)qw_[qi_]; qi_ ^= 1; }

__device__ __forceinline__ void mixA_phase(const Ctx& c0_, int l, float* L, PG8_LAS unsigned char* L_las) {
    constexpr int NS = NSEG - 1, NS5 = NSEG5 - 1;
    constexpr int NQ = 24, NG = NB * NS * 4, N5 = NB * NS5 * 2, NR = NB * NS * 6;
    MIX_QUEUE_BEGIN(NQ + NG + N5 + NR, 8192 + 64 * (2 * l))
        if (r < NQ) {
            pg8::Gemm g{c.XN(), c.W1T(), MR, NPROJ, D, D, 256}; OneUnit S{TP / 256 + r / 12, r % 12};
            pg8::EpiBf16<0> E{c.PROJ(), NPROJ, nullptr, 0, 0, 1.f};
            pg8::gemm_phase<pg8::EpiBf16<0>, OneUnit, true, true>(L_las, g, S, E); }
        else if ((r -= NQ) < NG) { const int h = r % 4, seg = (r / 4) % NS, b = r / (4 * NS); lin_task<true, true>(c, l, b, h, seg, L); }
        else if ((r -= NG) < N5) { const int oct = r % 2, seg = (r / 2) % NS5, b = r / (2 * NS5); s5_task<true>(c, l, false, b, oct, seg, L); }
        else { r -= N5; const int h = r % 6, seg = (r / 6) % NS, b = r / (6 * NS); lin_task<false, true>(c, l, b, h, seg, L); }
    MIX_QUEUE_END()
}
__device__ __forceinline__ void mixC_phase(const Ctx& c0_, int l, float* L, PG8_LAS unsigned char* L_las) {
    constexpr int NG = NB * NSEG * 4, N5 = NB * NSEG5 * 2, NR = NB * NSEG * 6;
    constexpr int M5 = (TS / 64) * 2, MG = DB * 4 / 8, MRT = DB * 6 / 8;
    MIX_QUEUE_BEGIN(NG + N5 + NR + M5 + MG + MRT, 8192 + 64 * (2 * l + 1))
        if (r < NG) { const int h = r % 4, seg = (r / 4) % NSEG, b = r / (4 * NSEG); lin_task<true, false>(c, l, b, h, seg, L); }
        else if ((r -= NG) < N5) { const int oct = r % 2, seg = (r / 2) % NSEG5, b = r / (2 * NSEG5); s5_task<false>(c, l, false, b, oct, seg, L); }
        else if ((r -= N5) < NR) { const int h = r % 6, seg = (r / 6) % NSEG, b = r / (6 * NSEG); lin_task<false, false>(c, l, b, h, seg, L); }
        else if ((r -= NR) < M5) { s5_task<false>(c, l, true, r / 2, r % 2, 0, L); }
        else if ((r -= M5) < MG) { const int q = 8 * r + c.wave; gla_sample_wave(c, l, q / 4, q % 4); }
        else { r -= MG; const int q = 8 * r + c.wave; ret_sample_wave(c, l, q / 6, q % 6); }
    MIX_QUEUE_END()
}

__device__ __forceinline__ void act_phase(const Ctx& c, int l) {
    constexpr int JB = DFF / 8, RB = MR / 16;
    const int gt = c.bx * 512 + c.tid, ngt = c.G * 512;
    const float* cw = c.in(I_FCW) + (size_t)l * 3 * DFF; const float* cb = c.in(I_FCB) + (size_t)l * DFF;
    for (int it = gt; it < JB * RB; it += ngt) {
        const int jb = it % JB, rb = it / JB, j0 = 8 * jb, r0 = 16 * rb;
        float w0[8], w1[8], w2[8], bb[8];
#pragma unroll
        for (int e = 0; e < 8; ++e) { w0[e] = cw[j0 + e]; w1[e] = cw[DFF + j0 + e]; w2[e] = cw[2 * DFF + j0 + e]; bb[e] = cb[j0 + e]; }
        float x2[8], x1[8];
        const bool sample = r0 >= TP;
        for (int rr = 0; rr < 16; ++rr) {
            const int r = r0 + rr;
            const int t = sample ? ((r - TP) & 3) : (r & (SEQ - 1));
            if (rr == 0 || t == 0) {
                if (t >= 2) { const u32x4 a = *(const u32x4*)(c.ABUF() + (size_t)(r - 2) * DFF + j0), bq = *(const u32x4*)(c.ABUF() + (size_t)(r - 1) * DFF + j0);
                    x2[0] = bflo(a.x); x2[1] = bfhi(a.x); x2[2] = bflo(a.y); x2[3] = bfhi(a.y); x2[4] = bflo(a.z); x2[5] = bfhi(a.z); x2[6] = bflo(a.w); x2[7] = bfhi(a.w);
                    x1[0] = bflo(bq.x); x1[1] = bfhi(bq.x); x1[2] = bflo(bq.y); x1[3] = bfhi(bq.y); x1[4] = bflo(bq.z); x1[5] = bfhi(bq.z); x1[6] = bflo(bq.w); x1[7] = bfhi(bq.w); }
                else {
                    if (sample) { const float* cs = c.in(I_SCONV) + ((size_t)(l * DB + ((r - TP) >> 2)) * 2) * DFF + j0;
#pragma unroll
                        for (int e = 0; e < 8; ++e) { x2[e] = cs[e]; x1[e] = cs[DFF + e]; } }
                    else {
#pragma unroll
                        for (int e = 0; e < 8; ++e) { x2[e] = 0.f; x1[e] = 0.f; } } }
            }
            const u32x4 a = *(const u32x4*)(c.ABUF() + (size_t)r * DFF + j0);
            const u32x4 gq = *(const u32x4*)(c.GATE() + (size_t)r * DFF + j0);
            const float x0[8] = {bflo(a.x), bfhi(a.x), bflo(a.y), bfhi(a.y), bflo(a.z), bfhi(a.z), bflo(a.w), bfhi(a.w)};
            const float gv[8] = {bflo(gq.x), bfhi(gq.x), bflo(gq.y), bfhi(gq.y), bflo(gq.z), bfhi(gq.z), bflo(gq.w), bfhi(gq.w)};
            float o[8];
#pragma unroll
            for (int e = 0; e < 8; ++e) { const float cv = bb[e] + w0[e] * x2[e] + w1[e] * x1[e] + w2[e] * x0[e]; o[e] = gelu_tanh(cv) * gv[e]; x2[e] = x1[e]; x1[e] = x0[e]; }
            u32x4 wv; wv.x = pk2(o[0], o[1]); wv.y = pk2(o[2], o[3]); wv.z = pk2(o[4], o[5]); wv.w = pk2(o[6], o[7]);
            *(u32x4*)(c.GATE() + (size_t)r * DFF + j0) = wv;
        }
    }
}

#define XB_TMO      128
#define XB_XCNT(j)  (256  + 64 * (j))
#define XB_XSUB(j)  (1280 + 64 * (j))
#define XB_XGEN(j)  (2304 + 64 * (j))
#define XB_TOP      3328
#define XB_TOPGEN   3392
#define XCD_BAR_WORDS 3456
#define XB_SPIN_CAP (1u << 18)

__device__ __forceinline__ unsigned xb_ld(unsigned* p)              { return __hip_atomic_load(p, __ATOMIC_RELAXED, __HIP_MEMORY_SCOPE_AGENT); }
__device__ __forceinline__ unsigned xb_add(unsigned* p, unsigned v) { return __hip_atomic_fetch_add(p, v, __ATOMIC_RELAXED, __HIP_MEMORY_SCOPE_AGENT); }
__device__ __forceinline__ unsigned xb_xcc_id() { return (unsigned)__builtin_amdgcn_s_getreg((3 << 11) | 20) & 0xFu; }
#define XB_SPIN(cond, bar) do { unsigned _sp = 0; while (cond) { __builtin_amdgcn_s_sleep(1); \
    if ((++_sp & 255u) == 0u) { if (xb_ld(&(bar)[XB_TMO])) break; if (_sp > XB_SPIN_CAP) { atomicAdd(&(bar)[XB_TMO], 1u); break; } } } } while (0)

struct XcdBarrier {
    unsigned* bar; unsigned x;
    volatile __attribute__((address_space(3))) unsigned* st;
};

__device__ __forceinline__ XcdBarrier xcd_barrier_post(unsigned* bar, volatile __attribute__((address_space(3))) unsigned* st) {
    XcdBarrier b; b.bar = bar; b.x = xb_xcc_id(); b.st = st;
    if (threadIdx.x == 0) (void)xb_add(&bar[XB_XCNT(b.x)], 1u);
    return b;
}
__device__ __forceinline__ void xcd_barrier_complete(unsigned* bar, unsigned x, unsigned& nloc, unsigned& nx) {
    const unsigned G = gridDim.x * gridDim.y * gridDim.z;
    unsigned sum, cnt, mine, sp = 0u;
    for (;;) {
        sum = 0u; cnt = 0u; mine = 0u;
#pragma unroll
        for (unsigned j = 0; j < 16; ++j) { const unsigned c = xb_ld(&bar[XB_XCNT(j)]); sum += c; cnt += (c > 0u) ? 1u : 0u; mine = (j == x) ? c : mine; }
        if (sum == G) break;
        __builtin_amdgcn_s_sleep(1);
        if ((++sp & 255u) == 0u) { if (xb_ld(&bar[XB_TMO])) break; if (sp > XB_SPIN_CAP) { atomicAdd(&bar[XB_TMO], 1u); break; } }
    }
    nloc = mine > 0u ? mine : 1u; nx = cnt > 0u ? cnt : 1u;
}

__device__ __forceinline__ void xcd_barrier(const XcdBarrier& b) {
    asm volatile("s_waitcnt vmcnt(0)" ::: "memory");
    __syncthreads();
    if (threadIdx.x == 0) {
        unsigned* bar = b.bar;
        __builtin_amdgcn_s_waitcnt(0);
        unsigned nloc = b.st[0], nx = b.st[1];
        if (nloc == 0u) { xcd_barrier_complete(bar, b.x, nloc, nx); b.st[0] = nloc; b.st[1] = nx; }
        const unsigned old = xb_add(&bar[XB_XSUB(b.x)], 1u);
        const unsigned gen = old / nloc;
        if (old + 1u == (gen + 1u) * nloc) {
            __builtin_amdgcn_fence(__ATOMIC_RELEASE, "agent");
            asm volatile("s_waitcnt vmcnt(0)" ::: "memory");
            const unsigned og = xb_add(&bar[XB_TOP], 1u);
            const unsigned tg = og / nx;
            if (og + 1u == (tg + 1u) * nx) xb_add(&bar[XB_TOPGEN], 1u);
            else XB_SPIN(xb_ld(&bar[XB_TOPGEN]) == tg, bar);
            __builtin_amdgcn_fence(__ATOMIC_ACQUIRE, "agent");
            xb_add(&bar[XB_XGEN(b.x)], 1u);
            asm volatile("s_waitcnt vmcnt(0)" ::: "memory");
        } else {
            XB_SPIN(xb_ld(&bar[XB_XGEN(b.x)]) == gen, bar);
            __builtin_amdgcn_fence(__ATOMIC_ACQUIRE, "agent");
            asm volatile("s_waitcnt vmcnt(0)" ::: "memory");
        }
    }
    __syncthreads();
}

#define gsync(B) xcd_barrier(B)
template <int l>
__device__ __forceinline__ void layer_body(float* L, PG8_LAS unsigned char* ring, const XcdBarrier& grid) {

        { const Ctx c = mkctx(); prep_phase(c, l, L); }
        if (l == 0) {
            asm volatile("s_waitcnt vmcnt(0)" ::: "memory"); __syncthreads();
            if (threadIdx.x == 0) { __builtin_amdgcn_fence(__ATOMIC_RELEASE, "agent"); asm volatile("s_waitcnt vmcnt(0)" ::: "memory"); }
            __syncthreads();
            cg::this_grid().sync();
            if (threadIdx.x == 0) { __builtin_amdgcn_fence(__ATOMIC_ACQUIRE, "agent"); asm volatile("s_waitcnt vmcnt(0)" ::: "memory"); }
            __syncthreads();
        } else gsync(grid);
        {
            const Ctx c = mkctx();
            pg8::Gemm g{c.XN(), c.W1T(), TP, NPROJ, D, D, 256}; pg8::StaticOrder S; S.init(TP, NPROJ, c.G, c.bx);
            pg8::EpiBf16<0> E{c.PROJ(), NPROJ, nullptr, 0, 0, 1.f};
            pg8::gemm_phase<pg8::EpiBf16<0>, pg8::StaticOrder, true, true>(ring, g, S, E);
        }
        gsync(grid);
        if (NSEG > 1) { { const Ctx c = mkctx(); mixA_phase(c, l, L, ring); } gsync(grid); }
        { const Ctx c = mkctx(); mixC_phase(c, l, L, ring); }
        gsync(grid);
        {
            const Ctx c = mkctx();
            int kglu = 256; asm volatile("" : "+s"(kglu)); pg8::Gemm g{c.Y5(), c.GLUT(), MR, 256, 256, kglu, 256}; pg8::StaticOrder S; S.init(MR, 256, c.G, c.bx);
            EpiGlu E{c.Y5(), c.in(I_GLUB) + l * 256, c.XN()};
            pg8::gemm_phase<EpiGlu, pg8::StaticOrder, true, true>(ring, g, S, E);
        }
        gsync(grid);
        {
            const Ctx c = mkctx();
            pg8::Gemm g{c.XN(), c.W2T(), TP, D, D, D, 256}; pg8::StaticOrder S; S.init(TP, D, c.G, c.bx);
            EpiRes E{l == 0 ? c.in(I_XP) : (const float*)c.out(), l == 0 ? c.in(I_XS) : (const float*)(c.out() + (size_t)TP * D), c.out()};
            pg8::gemm_phase<EpiRes, pg8::StaticOrder, true, true>(ring, g, S, E);
            int ks_ = 256; asm volatile("" : "+s"(ks_));
            pg8::Gemm gt{c.XN(), c.W2T(), MR, D, D, ks_, 256}; TailOrder ST_; ST_.init(D / 256, c.G, c.bx);
            EpiPart EP{c.PART()};
            pg8::gemm_phase<EpiPart, TailOrder, true, true>(ring, gt, ST_, EP);
        }
        gsync(grid);
        { const Ctx c = mkctx(); const float* gg = c.in(I_NFG) + (size_t)l * D; float* xo = c.out(); bf16* xn = c.XN();
          for (int m = c.gw; m < TP; m += 2 * c.ngw) { const int m1 = m + c.ngw;
              if (m1 < TP) norm_rows2_bf16(xo + (size_t)m * D, xo + (size_t)m1 * D, gg, xn + (size_t)m * D, xn + (size_t)m1 * D, c.lane);
              else norm_row_bf16(xo + (size_t)m * D, gg, xn + (size_t)m * D, c.lane); }
          for (int m = TP + c.gw; m < MR; m += c.ngw)
              norm_row_bf16(l == 0 ? c.in(I_XS) + (size_t)(m - TP) * D : (const float*)(xo + (size_t)m * D), gg, xn + (size_t)m * D, c.lane, c.PART() + (size_t)(m - TP) * D, D / 256, xo + (size_t)m * D); }
        gsync(grid);
        {
            const Ctx c = mkctx();
            pg8::Gemm g{c.XN() - 2 * D, c.W3T(), 67 * 256, NUP, D, D, 254}; pg8::StaticOrder S; S.init(67 * 256, NUP, c.G, c.bx);
            EpiAct E{c.GATE(), c.out() + O_CONVP + (size_t)l * NB * 2 * DFF, c.out() + O_CONVS + (size_t)l * DB * 2 * DFF,
                     c.in(I_FCW) + (size_t)l * 3 * DFF, c.in(I_FCB) + (size_t)l * DFF, c.in(I_SCONV) + (size_t)l * DB * 2 * DFF, (PG8_LAS float*)(ring + 131072)};
            pg8::gemm_phase<EpiAct, pg8::StaticOrder, true, true>(ring, g, S, E);
        }
        gsync(grid);
        {
            const Ctx c = mkctx();
            pg8::Gemm g{c.GATE(), c.W4T(), TP, D, DFF, DFF, 256}; pg8::StaticOrder S; S.init(TP, D, c.G, c.bx);
            EpiRes E{c.out(), c.out() + (size_t)TP * D, c.out()};
            pg8::gemm_phase<EpiRes, pg8::StaticOrder, true, true>(ring, g, S, E);
            int ks_ = 256; asm volatile("" : "+s"(ks_));
            pg8::Gemm gt{c.GATE(), c.W4T(), MR, D, DFF, ks_, 256}; TailOrder ST_; ST_.init(DFF / 256, c.G, c.bx);
            EpiPart EP{c.PART()};
            pg8::gemm_phase<EpiPart, TailOrder, true, true>(ring, gt, ST_, EP);
        }
        gsync(grid);
    }

__global__ void __launch_bounds__(512, 2) fwd(Args args) {
    extern __shared__ __attribute__((aligned(16))) unsigned char lds[];
    float* L = (float*)lds;
    PG8_LAS unsigned char* ring = (PG8_LAS unsigned char*)lds;

    volatile __attribute__((address_space(3))) unsigned* bst = (volatile __attribute__((address_space(3))) unsigned*)((PG8_LAS unsigned char*)lds + 143360);
    if (threadIdx.x < 2) bst[threadIdx.x] = 0u;
    __syncthreads();
    unsigned* barw; { KArgs kp = (KArgs)__builtin_amdgcn_kernarg_segment_ptr(); barw = (unsigned*)kp->ws; }
    const XcdBarrier grid = xcd_barrier_post(barw, bst);
    layer_body<0>(L, ring, grid);
    layer_body<1>(L, ring, grid);
    { const Ctx c = mkctx(); const float* gg = c.in(I_NFIN); float* xo = c.out();
      for (int m = c.gw; m < TP; m += 2 * c.ngw) { const int m1 = m + c.ngw;
          if (m1 < TP) norm_rows2_f32(xo + (size_t)m * D, xo + (size_t)m1 * D, gg, c.lane); else norm_row_f32(xo + (size_t)m * D, gg, c.lane); }
      for (int m = TP + c.gw; m < MR; m += c.ngw) norm_row_f32(xo + (size_t)m * D, gg, c.lane, c.PART() + (size_t)(m - TP) * D, DFF / 256); }
}
}

extern "C" void kernel_launch(void* const* d_in, const int* in_sizes, int n_in, void* d_out, int out_size, void* d_ws, size_t ws_size, hipStream_t stream) {
    static int grid = 0;
    if (grid == 0) {
        if (n_in != mk::N_IN || out_size != (int)mk::O_END || ws_size < mk::WS_END) { fprintf(stderr, "kernel_launch: unexpected sizes n_in %d out %d ws %zu (need %zu)\n", n_in, out_size, ws_size, (size_t)mk::WS_END); }
        int dev = 0, cus = 0, per_cu = 0;
        hipGetDevice(&dev); hipDeviceGetAttribute(&cus, hipDeviceAttributeMultiprocessorCount, dev);
        hipFuncSetAttribute((const void*)mk::fwd, hipFuncAttributeMaxDynamicSharedMemorySize, mk::LDS_BYTES);
        hipOccupancyMaxActiveBlocksPerMultiprocessor(&per_cu, (const void*)mk::fwd, 512, mk::LDS_BYTES);
        if (per_cu < 1) { fprintf(stderr, "kernel_launch: occupancy query says %d blocks per CU\n", per_cu); per_cu = 1; }
        grid = cus * 1;
        (void)hipGetLastError();
    }
    (void)hipMemsetAsync(d_ws, 0, 65536, stream);
    mk::Args a{};
    for (int i = 0; i < mk::N_IN; ++i) a.in[i] = (const float*)d_in[i];
    a.out = (float*)d_out; a.ws = (unsigned char*)d_ws;
    void* kargs[] = {&a};
    hipError_t e = hipLaunchCooperativeKernel((const void*)mk::fwd, dim3(grid), dim3(512), kargs, mk::LDS_BYTES, stream);
    if (e != hipSuccess) fprintf(stderr, "cooperative launch failed: %s (grid %d)\n", hipGetErrorString(e), grid);
}
```

```cpp
#include <hip/hip_runtime.h>
#include <hip/hip_cooperative_groups.h>
#include <cstdio>
#include <cstdint>
namespace cg = cooperative_groups;
namespace pg8 {
#define PG8_LAS __attribute__((address_space(3)))
typedef unsigned short bf16_t;
typedef short bf16x8 __attribute__((ext_vector_type(8)));
typedef float f32x4 __attribute__((ext_vector_type(4)));
typedef unsigned u32x4 __attribute__((ext_vector_type(4)));
constexpr int BM = 256, BK = 64, HALF = 128, HTB = HALF * BK * 2  , STAGE_BYTES = 8 * HTB, NXCD = 8, WGM = 8;

__host__ __device__ __forceinline__ int lds_byte(int r, int c) { const int st = (r >> 4) * 2 + (c >> 5), rr = r & 15, cc = c & 31, ob = rr * 64 + cc * 2; return st * 1024 + (ob ^ (((ob >> 9) & 1) << 5)); }
__host__ __device__ __forceinline__ void stage_rc(int b, int& R, int& C) { const int st = b / 1024, sb = b % 1024, swz = sb ^ (((sb >> 9) & 1) << 5); R = (st >> 1) * 16 + swz / 64; C = (st & 1) * 32 + (swz % 64) / 2; }
__host__ __device__ __forceinline__ int perm32(int rho) { const int n = rho >> 4, i = rho & 15; return 8 * (i >> 2) + 4 * n + (i & 3); }

struct Unit { int pm, pn, ko; };
struct Gemm { const bf16_t* A; const bf16_t* Bt; int M, N, K, KL, MS; };

struct StaticOrder {
    int nM, nN, nwg, G, c;
    __host__ __device__ void init(int M, int N, int G_, int c_) { nM = M / BM; nN = N / BM; nwg = nM * nN; G = G_; c = c_; }
    __host__ __device__ bool next(int i, Unit& u) const {
        const long L = (long)i * G + c; if (L >= nwg) return false;
        int wgid = (int)L; { const int q = nwg / NXCD, r = nwg % NXCD, xcd = wgid % NXCD, off = wgid / NXCD; wgid = (xcd < r ? xcd * (q + 1) : r * (q + 1) + (xcd - r) * q) + off; }
        const int nig = WGM * nN, gid = wgid / nig, fm = gid * WGM, gsz = (nM - fm) < WGM ? (nM - fm) : WGM;
        u.pm = fm + ((wgid % nig) % gsz); u.pn = (wgid % nig) / gsz; u.ko = 0; return true;
    }
    __device__ __forceinline__ void a_ready(const Unit&) const {}
    __device__ __forceinline__ void done(const Unit&) const {}
};

__device__ __forceinline__ unsigned cvt_pk_bf16(float lo, float hi) { unsigned r; asm volatile("v_cvt_pk_bf16_f32 %0, %1, %2" : "=v"(r) : "v"(lo), "v"(hi)); return r; }
typedef float f32x2 __attribute__((ext_vector_type(2)));
__device__ __forceinline__ f32x2 gelu_pk(f32x2 v) {
    const f32x2 av = __builtin_elementwise_abs(v), d = av * 0.2316418882f + 1.0f;
    f32x2 t; t.x = __builtin_amdgcn_rcpf(d.x); t.y = __builtin_amdgcn_rcpf(d.y);
    f32x2 q = t * 0.5307027145f + (-0.7265760135f); q = q * t + 0.7107068705f; q = q * t + (-0.142248368f); q = q * t + 0.127414796f; q = q * t;
    const f32x2 s = (v * v) * (-0.72134752044f);
    f32x2 e; e.x = __builtin_amdgcn_exp2f(s.x); e.y = __builtin_amdgcn_exp2f(s.y);
    const f32x2 m = v * (q * e), r = v - m;
    f32x2 o; o.x = v.x < 0.f ? m.x : r.x; o.y = v.y < 0.f ? m.y : r.y; return o;
}

template <int ACT  > struct EpiBf16 {
    static constexpr bool PERM = true, AFTER_DRAIN = false; static_assert(ACT == 0 || ACT == 1, "EpiBf16: ACT is 0 (none) or 1 (gelu_pk)");
    bf16_t* O; int ldc; const float* bias; int split_cols; size_t split_stride; float scale0;
    __device__ __forceinline__ void operator()(const f32x4 (&acc)[2][2][4][2], const Unit& u, int wr, int wc, int fr, int fq) const {
        const int row0 = u.pm * BM + wr * 64 + fr; int colt = u.pn * BM; bf16_t* base = O;
        float sc = 1.f; if (split_cols) { const int t = colt / split_cols; base += (size_t)t * split_stride; colt -= t * split_cols; if (t == 0) sc = scale0; }
        const int col0 = colt + wc * 32 + 8 * fq, bcol0 = u.pn * BM + wc * 32 + 8 * fq;
        f32x4 bv[2][2];
#pragma unroll
        for (int bj = 0; bj < 2; ++bj)
#pragma unroll
            for (int n = 0; n < 2; ++n) bv[bj][n] = bias ? *(const f32x4*)(bias + bcol0 + bj * HALF + 4 * n) : (f32x4){0.f, 0.f, 0.f, 0.f};
#pragma unroll
        for (int ai = 0; ai < 2; ++ai)
#pragma unroll
            for (int m = 0; m < 4; ++m) { bf16_t* rowp = base + (size_t)(row0 + ai * HALF + m * 16) * ldc + col0;
#pragma unroll
                for (int bj = 0; bj < 2; ++bj) { f32x4 v0 = acc[ai][bj][m][0] + bv[bj][0], v1 = acc[ai][bj][m][1] + bv[bj][1];
                    if (ACT == 1) { f32x2 a = gelu_pk((f32x2){v0[0], v0[1]}), b = gelu_pk((f32x2){v0[2], v0[3]}), c = gelu_pk((f32x2){v1[0], v1[1]}), d = gelu_pk((f32x2){v1[2], v1[3]});
                        v0 = (f32x4){a.x, a.y, b.x, b.y}; v1 = (f32x4){c.x, c.y, d.x, d.y}; }
                    v0 = v0 * sc; v1 = v1 * sc; u32x4 w; w.x = cvt_pk_bf16(v0[0], v0[1]); w.y = cvt_pk_bf16(v0[2], v0[3]); w.z = cvt_pk_bf16(v1[0], v1[1]); w.w = cvt_pk_bf16(v1[2], v1[3]);
                    *(u32x4*)(rowp + bj * HALF) = w; } }
    }
};
template <class Epi, class Sched, bool ALIGN_EPI = false, bool SP2 = false>
__device__ __forceinline__ void gemm_phase(PG8_LAS unsigned char* lds, const Gemm g, const Sched& S, const Epi& E) {
    int tid_ = threadIdx.x; asm volatile("" : "+v"(tid_)); const int tid = tid_, wid = __builtin_amdgcn_readfirstlane(tid >> 6), lane = tid & 63, wr = wid >> 2, wc = wid & 3, fr = lane & 15, fq = lane >> 4;
    const int K = g.K, nt = g.KL / BK;
    unsigned voffA[2], voffB[2];
#pragma unroll
    for (int i = 0; i < 2; ++i) { int R, C; stage_rc(tid * 16 + i * 8192, R, C); const int Rb = Epi::PERM ? ((R & ~31) + perm32(R & 31)) : R;
        voffA[i] = (unsigned)(R * K + C) * 2u; voffB[i] = (unsigned)(Rb * K + C) * 2u; }
    const size_t kstep = (size_t)(BK * 2);
    const size_t hstep = (size_t)HALF * K * 2;
    const size_t tstep = 2 * hstep;
    const size_t tstepA = (size_t)g.MS * K * 2;
    const unsigned ldsw = (unsigned)wid * 1024u;
    const int aoff = lds_byte(wr * 64 + fr, fq * 8), boff = lds_byte(wc * 32 + fr, fq * 8);
#define PG8_SA(b, h) (((b) * 2 + (h)) * HTB)
#define PG8_SB(b, h) ((4 + (b) * 2 + (h)) * HTB)
#define PG8_STAGE(bufoff, gbase, voff) do { _Pragma("unroll") for (int _i = 0; _i < 2; ++_i) \
        __builtin_amdgcn_global_load_lds((const unsigned*)((const char*)(gbase) + (voff)[_i]), (PG8_LAS unsigned*)(lds + (bufoff) + ldsw + _i * 8192), 16, 0, 0); } while (0)
#define PG8_LDA(dst, b, h) do { _Pragma("unroll") for (int m = 0; m < 4; ++m) _Pragma("unroll") for (int k = 0; k < 2; ++k) dst[m][k] = *(const PG8_LAS bf16x8*)(lds + PG8_SA(b, h) + aoff + m * 2048 + k * 1024); } while (0)
#define PG8_LDB(dst, b, h) do { _Pragma("unroll") for (int n = 0; n < 2; ++n) _Pragma("unroll") for (int k = 0; k < 2; ++k) dst[n][k] = *(const PG8_LAS bf16x8*)(lds + PG8_SB(b, h) + boff + n * 2048 + k * 1024); } while (0)
#define PG8_MMA(ai, bj, At, Bt) do { __builtin_amdgcn_s_setprio(1); _Pragma("unroll") for (int m = 0; m < 4; ++m) _Pragma("unroll") for (int n = 0; n < 2; ++n) _Pragma("unroll") for (int k = 0; k < 2; ++k) \
        acc[ai][bj][m][n] = __builtin_amdgcn_mfma_f32_16x16x32_bf16(Bt[n][k], At[m][k], acc[ai][bj][m][n], 0, 0, 0); __builtin_amdgcn_s_setprio(0); } while (0)
#define PG8_WAIT_V(n) asm volatile("s_waitcnt vmcnt(" #n ")" ::: "memory")
#define PG8_WAIT_L(n) asm volatile("s_waitcnt lgkmcnt(" #n ")" ::: "memory")
#define PG8_BAR __builtin_amdgcn_s_barrier()
#define PG8_SCHED __builtin_amdgcn_sched_barrier(0)
    Unit cur, nxt; int ui = 0;
    if (!S.next(0, cur)) return;
    f32x4 acc[2][2][4][2];
#pragma unroll
    for (int a = 0; a < 2; ++a)
#pragma unroll
        for (int b = 0; b < 2; ++b)
#pragma unroll
            for (int m = 0; m < 4; ++m)
#pragma unroll
                for (int n = 0; n < 2; ++n) acc[a][b][m][n] = (f32x4){0.f, 0.f, 0.f, 0.f};
    bf16x8 At[4][2], B0[2][2], B1[2][2];
    const char* cA = (const char*)g.A + (size_t)cur.pm * tstepA + (size_t)cur.ko * 2; const char* cB = (const char*)g.Bt + (size_t)cur.pn * tstep + (size_t)cur.ko * 2;
    S.a_ready(cur);
    if constexpr (SP2) {
        PG8_STAGE(PG8_SB(0, 0), cB, voffB); PG8_STAGE(PG8_SB(0, 1), cB + hstep, voffB); PG8_STAGE(PG8_SA(0, 0), cA, voffA); PG8_STAGE(PG8_SA(0, 1), cA + hstep, voffA);
        if (wr == 1) PG8_BAR;
        PG8_WAIT_V(2); PG8_BAR;
        PG8_STAGE(PG8_SB(1, 0), cB + kstep, voffB); PG8_STAGE(PG8_SA(1, 0), cA + kstep, voffA); PG8_STAGE(PG8_SB(1, 1), cB + hstep + kstep, voffB);
        PG8_WAIT_V(6); PG8_BAR;
    } else {
        PG8_STAGE(PG8_SB(0, 0), cB, voffB); PG8_STAGE(PG8_SA(0, 0), cA, voffA); PG8_STAGE(PG8_SB(0, 1), cB + hstep, voffB); PG8_STAGE(PG8_SA(0, 1), cA + hstep, voffA);
        if (wr == 1) PG8_BAR;
        PG8_WAIT_V(4); PG8_BAR;
        PG8_STAGE(PG8_SB(1, 0), cB + kstep, voffB); PG8_STAGE(PG8_SA(1, 0), cA + kstep, voffA); PG8_STAGE(PG8_SB(1, 1), cB + hstep + kstep, voffB);
        PG8_WAIT_V(6); PG8_BAR;
    }
    for (;;) {
        const bool has_next = S.next(ui + 1, nxt);
        const char* nA = has_next ? (const char*)g.A + (size_t)nxt.pm * tstepA + (size_t)nxt.ko * 2 : cA; const char* nB = has_next ? (const char*)g.Bt + (size_t)nxt.pn * tstep + (size_t)nxt.ko * 2 : cB;
        for (int t = 0; t < nt; t += 2) {
            const bool last = (t == nt - 2);
            const char* a1 = cA + (size_t)(t + 1) * kstep;
            const char* a2 = last ? nA : cA + (size_t)(t + 2) * kstep; const char* b2 = last ? nB : cB + (size_t)(t + 2) * kstep;
            const char* a3 = a2 + kstep; const char* b3 = b2 + kstep;
            if (last && has_next) S.a_ready(nxt);
            if constexpr (SP2) {
            PG8_LDB(B0, 0, 0); PG8_LDB(B1, 0, 1); PG8_SCHED; PG8_LDA(At, 0, 0); PG8_STAGE(PG8_SA(1, 1), a1 + hstep, voffA);
            PG8_WAIT_V(8); PG8_WAIT_L(0); PG8_BAR; PG8_MMA(0, 0, At, B0); PG8_MMA(0, 1, At, B1); PG8_BAR; PG8_SCHED;
            PG8_LDA(At, 0, 1); PG8_STAGE(PG8_SB(0, 0), b2, voffB); PG8_STAGE(PG8_SB(0, 1), b2 + hstep, voffB); PG8_STAGE(PG8_SA(0, 0), a2, voffA);
            PG8_WAIT_V(8); PG8_WAIT_L(0); PG8_BAR; PG8_MMA(1, 0, At, B0); PG8_MMA(1, 1, At, B1); PG8_BAR; PG8_SCHED;
            PG8_LDB(B0, 1, 0); PG8_LDB(B1, 1, 1); PG8_SCHED; PG8_LDA(At, 1, 0); PG8_STAGE(PG8_SA(0, 1), a2 + hstep, voffA);
            PG8_WAIT_V(8); PG8_WAIT_L(0); PG8_BAR; PG8_MMA(0, 0, At, B0); PG8_MMA(0, 1, At, B1); PG8_BAR; PG8_SCHED;
            PG8_LDA(At, 1, 1); PG8_STAGE(PG8_SB(1, 0), b3, voffB); PG8_STAGE(PG8_SB(1, 1), b3 + hstep, voffB); PG8_STAGE(PG8_SA(1, 0), a3, voffA);
            PG8_WAIT_V(8); PG8_WAIT_L(0); PG8_BAR; PG8_MMA(1, 0, At, B0); PG8_MMA(1, 1, At, B1); PG8_BAR; PG8_SCHED;
            } else {
            PG8_LDB(B0, 0, 0); PG8_SCHED; PG8_LDA(At, 0, 0); PG8_STAGE(PG8_SA(1, 1), a1 + hstep, voffA);
            PG8_WAIT_L(8); PG8_BAR; PG8_WAIT_L(0); PG8_MMA(0, 0, At, B0); PG8_BAR; PG8_SCHED;
            PG8_LDB(B1, 0, 1); PG8_STAGE(PG8_SB(0, 0), b2, voffB);
            PG8_BAR; PG8_WAIT_L(0); PG8_MMA(0, 1, At, B1); PG8_BAR;
            PG8_LDA(At, 0, 1); PG8_STAGE(PG8_SA(0, 0), a2, voffA);
            PG8_BAR; PG8_WAIT_L(0); PG8_MMA(1, 0, At, B0); PG8_BAR; PG8_SCHED;
            PG8_STAGE(PG8_SB(0, 1), b2 + hstep, voffB);
            PG8_WAIT_V(6); PG8_BAR; PG8_MMA(1, 1, At, B1); PG8_BAR;
            PG8_LDB(B0, 1, 0); PG8_SCHED; PG8_LDA(At, 1, 0); PG8_STAGE(PG8_SA(0, 1), a2 + hstep, voffA);
            PG8_WAIT_L(8); PG8_BAR; PG8_WAIT_L(0); PG8_MMA(0, 0, At, B0); PG8_BAR; PG8_SCHED;
            PG8_LDB(B1, 1, 1); PG8_STAGE(PG8_SB(1, 0), b3, voffB);
            PG8_BAR; PG8_WAIT_L(0); PG8_MMA(0, 1, At, B1); PG8_BAR;
            PG8_LDA(At, 1, 1); PG8_STAGE(PG8_SA(1, 0), a3, voffA);
            PG8_BAR; PG8_WAIT_L(0); PG8_MMA(1, 0, At, B0); PG8_BAR; PG8_SCHED;
            PG8_STAGE(PG8_SB(1, 1), b3 + hstep, voffB);
            PG8_WAIT_V(6); PG8_BAR; PG8_MMA(1, 1, At, B1); PG8_BAR;
            }
        }
        if constexpr (ALIGN_EPI) { if (wr == 0) PG8_BAR; }
        if constexpr (!Epi::AFTER_DRAIN) { E(acc, cur, wr, wc, fr, fq); S.done(cur); }
        if (!has_next) break;
#pragma unroll
        for (int a = 0; a < 2; ++a)
#pragma unroll
            for (int b = 0; b < 2; ++b)
#pragma unroll
                for (int m = 0; m < 4; ++m)
#pragma unroll
                    for (int n = 0; n < 2; ++n) acc[a][b][m][n] = (f32x4){0.f, 0.f, 0.f, 0.f};
        cur = nxt; cA = nA; cB = nB; ++ui;
        if constexpr (ALIGN_EPI) { if (wr == 1) PG8_BAR; }
    }
    PG8_WAIT_V(0);
    if constexpr (!ALIGN_EPI) { if (wr == 0) PG8_BAR; }
    PG8_BAR;
    if constexpr (Epi::AFTER_DRAIN) { E.fused(acc, cur, wr, wc, fr, fq, lds, wid, lane); S.done(cur); }
#undef PG8_SA
#undef PG8_SB
#undef PG8_STAGE
#undef PG8_LDA
#undef PG8_LDB
#undef PG8_MMA
#undef PG8_WAIT_V
#undef PG8_WAIT_L
#undef PG8_BAR
#undef PG8_SCHED
}
}

namespace mk {
typedef unsigned short bf16;
typedef float f32x4 __attribute__((ext_vector_type(4)));
typedef unsigned u32x4 __attribute__((ext_vector_type(4)));
typedef unsigned u32x2 __attribute__((ext_vector_type(2)));

constexpr int D = 1024, TP = 16384, TS = 512, MR = TP + TS;
constexpr int SEQ = 2048, NB = 8, DB = 128, DSEQ = 4;
constexpr int INC = 2960, NPROJ = 3072, DFF = 2816, NUP = 5632;
constexpr int NSEG = 8, LSEG = SEQ / NSEG;
constexpr int NSEG5 = 8, LSEG5 = SEQ / NSEG5, LOG2_LSEG5 = 8;
constexpr int C_RQ = 0, C_RK = 384, C_RV = 768, C_RG = 1152, C_SU = 1536, C_GQ = 1792, C_GK = 1984, C_GV = 2176, C_GG = 2560, C_GLR = 2944;
constexpr float EPS = 1e-6f;

constexpr size_t MiB = 1u << 20;
constexpr size_t WS_W1T = 1 * MiB, WS_W2T = 7 * MiB, WS_W3T = 9 * MiB, WS_W4T = 20 * MiB;
constexpr size_t WS_GLUT = 25 * MiB + 512 * 1024, WS_ROPE = 25 * MiB + 768 * 1024;
constexpr size_t WS_XN = 27 * MiB;
constexpr size_t WS_BIG = 60 * MiB;
constexpr size_t WS_ABUF = WS_BIG, WS_GATE = WS_BIG + (size_t)MR * DFF * 2;
constexpr size_t WS_SEG = 160 * MiB;
constexpr size_t WS_Y5 = 172 * MiB;
constexpr size_t WS_END = WS_GATE + (size_t)MR * DFF * 2;
static_assert(WS_END <= 256 * MiB, "workspace");
static_assert(WS_BIG + (size_t)MR * NPROJ * 2 <= WS_SEG, "proj vs seg");
constexpr size_t SEG_RET = 0;
constexpr size_t SEG_GLA = SEG_RET + (size_t)8 * 6 * (NSEG - 1) * 4096 * 4;
constexpr size_t SEG_S5 = SEG_GLA + (size_t)8 * 4 * (NSEG - 1) * 4672 * 4;
static_assert(WS_SEG + SEG_S5 + (size_t)8 * (NSEG5 - 1) * 2048 * 4 <= WS_Y5, "seg");

constexpr size_t O_Y = 0;
constexpr size_t O_RETP = (size_t)MR * D;
constexpr size_t O_RETS = O_RETP + (size_t)2 * NB * 6 * 4096;
constexpr size_t O_S5RP = O_RETS + (size_t)2 * DB * 6 * 4096;
constexpr size_t O_S5RS = O_S5RP + (size_t)2 * NB * 1024;
constexpr size_t O_S5IP = O_S5RS + (size_t)2 * DB * 1024;
constexpr size_t O_S5IS = O_S5IP + (size_t)2 * NB * 1024;
constexpr size_t O_GLAP = O_S5IS + (size_t)2 * DB * 1024;
constexpr size_t O_GLAS = O_GLAP + (size_t)2 * NB * 4 * 4608;
constexpr size_t O_CONVP = O_GLAS + (size_t)2 * DB * 4 * 4608;
constexpr size_t O_CONVS = O_CONVP + (size_t)2 * NB * 2 * DFF;
constexpr size_t O_END = O_CONVS + (size_t)2 * DB * 2 * DFF;
static_assert(O_END == 31088640, "out size");

constexpr int LDS_BYTES = 147456;

enum { I_XP = 0, I_XS, I_SRET, I_S5R, I_S5I, I_SGLA, I_SCONV, I_NMG, I_WIN, I_RNG, I_RNB, I_LRE, I_LIM, I_LDT, I_BRE, I_BIM, I_CRE, I_CIM, I_S5D,
       I_GLUW, I_GLUB, I_GGW, I_GGB, I_GNG, I_WOUT, I_NFG, I_FWIN, I_FCW, I_FCB, I_FWOUT, I_NFIN, N_IN };

struct Args { const float* in[N_IN]; float* out; unsigned char* ws; };

__device__ __forceinline__ float bflo(unsigned w) { return __uint_as_float(w << 16); }
__device__ __forceinline__ float bfhi(unsigned w) { return __uint_as_float(w & 0xffff0000u); }
__device__ __forceinline__ unsigned pk2(float lo, float hi) { unsigned r; asm("v_cvt_pk_bf16_f32 %0, %1, %2" : "=v"(r) : "v"(lo), "v"(hi)); return r; }
__device__ __forceinline__ unsigned f2bf(float f) { return pk2(f, 0.f) & 0xffffu; }
__device__ __forceinline__ float silu(float x) { return x * __builtin_amdgcn_rcpf(1.f + __builtin_amdgcn_exp2f(-1.4426950408889634f * x)); }
__device__ __forceinline__ float sigmoidf_(float x) { return __builtin_amdgcn_rcpf(1.f + __builtin_amdgcn_exp2f(-1.4426950408889634f * x)); }
__device__ __forceinline__ float gelu_tanh(float x) {
    const float v = x * fmaf(x * x, 0.044715f, 1.f);
    const float e = __builtin_amdgcn_exp2f(v * (2.f * 0.7978845608028654f * 1.4426950408889634f));
    return fmaf(-x, __builtin_amdgcn_rcpf(e + 1.f), x);
}
__device__ __forceinline__ float rdl(float x, int l) { return __int_as_float(__builtin_amdgcn_readlane(__float_as_int(x), l)); }
__device__ __forceinline__ float wave_sum(float v) {
#pragma unroll
    for (int o = 1; o < 64; o <<= 1) v += __shfl_xor(v, o);
    return v;
}

struct EpiRes {
    static constexpr bool PERM = false, AFTER_DRAIN = false;
    const float* baseP; const float* baseS; float* out;
    __device__ __forceinline__ void operator()(const pg8::f32x4 (&acc)[2][2][4][2], const pg8::Unit& u, int wr, int wc, int fr, int fq) const {
        const int row0 = u.pm * 256 + wr * 64 + fr, col0 = u.pn * 256 + wc * 32 + 4 * fq;
        const float* base = (u.pm < TP / 256) ? baseP : (baseS - (size_t)TP * D);
#pragma unroll
        for (int ai = 0; ai < 2; ++ai)
#pragma unroll
            for (int m = 0; m < 4; ++m) { const size_t off = (size_t)(row0 + ai * 128 + m * 16) * D + col0;
#pragma unroll
                for (int bj = 0; bj < 2; ++bj)
#pragma unroll
                    for (int n = 0; n < 2; ++n) { const pg8::f32x4 bs = *(const pg8::f32x4*)(base + off + bj * 128 + n * 16);
                        *(pg8::f32x4*)(out + off + bj * 128 + n * 16) = bs + acc[ai][bj][m][n]; }
                if (m & 1) asm volatile("" ::: "memory"); }
    }
};
struct TailOrder {
    int S, G, c;
    __device__ void init(int S_, int G_, int c_) { S = S_; G = G_; c = c_; }
    __device__ bool next(int i, pg8::Unit& u) const { const int Lq = i * G + c; if (Lq >= 8 * S) return false; const int ks = Lq % S, tile = Lq / S; u.pn = tile & 3; u.pm = TP / 256 + (tile >> 2); u.ko = ks * 256; return true; }
    __device__ __forceinline__ void a_ready(const pg8::Unit&) const {}
    __device__ __forceinline__ void done(const pg8::Unit&) const {}
};
struct EpiPart {
    static constexpr bool PERM = false, AFTER_DRAIN = false;
    float* part;
    __device__ __forceinline__ void operator()(const pg8::f32x4 (&acc)[2][2][4][2], const pg8::Unit& u, int wr, int wc, int fr, int fq) const {
        const int row0 = (u.pm - TP / 256) * 256 + wr * 64 + fr, col0 = u.pn * 256 + wc * 32 + 4 * fq;
        float* dst = part + (size_t)(u.ko >> 8) * TS * D;
#pragma unroll
        for (int ai = 0; ai < 2; ++ai)
#pragma unroll
            for (int m = 0; m < 4; ++m) { const size_t off = (size_t)(row0 + ai * 128 + m * 16) * D + col0;
#pragma unroll
                for (int bj = 0; bj < 2; ++bj)
#pragma unroll
                    for (int n = 0; n < 2; ++n) *(pg8::f32x4*)(dst + off + bj * 128 + n * 16) = acc[ai][bj][m][n]; }
    }
};
struct EpiGlu {
    static constexpr bool PERM = true, AFTER_DRAIN = false;
    const bf16* y5; const float* bias; bf16* mix;
    __device__ __forceinline__ void operator()(const pg8::f32x4 (&acc)[2][2][4][2], const pg8::Unit& u, int wr, int wc, int fr, int fq) const {
        const int row0 = u.pm * 256 + wr * 64 + fr, col0 = wc * 32 + 8 * fq;
#pragma unroll
        for (int bj = 0; bj < 2; ++bj) { const int c = col0 + bj * 128;
            const f32x4 b0 = *(const f32x4*)(bias + c), b1 = *(const f32x4*)(bias + c + 4);
#pragma unroll
            for (int ai = 0; ai < 2; ++ai)
#pragma unroll
                for (int m = 0; m < 4; ++m) { const size_t r = (size_t)(row0 + ai * 128 + m * 16);
                    const u32x4 yv = *(const u32x4*)(y5 + r * 256 + c);
                    const pg8::f32x4 v0 = acc[ai][bj][m][0], v1 = acc[ai][bj][m][1];
                    u32x4 w;
                    w.x = pk2(bflo(yv.x) * sigmoidf_(v0[0] + b0[0]), bfhi(yv.x) * sigmoidf_(v0[1] + b0[1]));
                    w.y = pk2(bflo(yv.y) * sigmoidf_(v0[2] + b0[2]), bfhi(yv.y) * sigmoidf_(v0[3] + b0[3]));
                    w.z = pk2(bflo(yv.z) * sigmoidf_(v1[0] + b1[0]), bfhi(yv.z) * sigmoidf_(v1[1] + b1[1]));
                    w.w = pk2(bflo(yv.w) * sigmoidf_(v1[2] + b1[2]), bfhi(yv.w) * sigmoidf_(v1[3] + b1[3]));
                    *(u32x4*)(mix + r * D + 384 + c) = w; asm volatile("" ::: "memory"); } }
    }
};
struct EpiUp {
    static constexpr bool PERM = true, AFTER_DRAIN = false;
    bf16* abuf; bf16* gate; float* convP; float* convS;
    __device__ __forceinline__ void operator()(const pg8::f32x4 (&acc)[2][2][4][2], const pg8::Unit& u, int wr, int wc, int fr, int fq) const {
        const bool isA = u.pn < DFF / 256;
        bf16* dst = isA ? abuf : gate;
        const int colt = (isA ? u.pn : u.pn - DFF / 256) * 256 + wc * 32 + 8 * fq;
        const int row0 = u.pm * 256 + wr * 64 + fr;
#pragma unroll
        for (int ai = 0; ai < 2; ++ai)
#pragma unroll
            for (int m = 0; m < 4; ++m) { const int r = row0 + ai * 128 + m * 16;
#pragma unroll
                for (int bj = 0; bj < 2; ++bj) { const pg8::f32x4 v0 = acc[ai][bj][m][0], v1 = acc[ai][bj][m][1];
                    u32x4 w; w.x = pg8::cvt_pk_bf16(v0[0], v0[1]); w.y = pg8::cvt_pk_bf16(v0[2], v0[3]); w.z = pg8::cvt_pk_bf16(v1[0], v1[1]); w.w = pg8::cvt_pk_bf16(v1[2], v1[3]);
                    *(u32x4*)(dst + (size_t)r * DFF + colt + bj * 128) = w;
                    if (isA) {
                        float* cd = nullptr;
                        if (r < TP) { const int t = r & (SEQ - 1); if (t >= SEQ - 2) cd = convP + ((size_t)(r >> 11) * 2 + (t - (SEQ - 2))) * DFF; }
                        else { const int rs = r - TP, t = rs & 3; if (t >= 2) cd = convS + ((size_t)(rs >> 2) * 2 + (t - 2)) * DFF; }
                        if (cd) { *(pg8::f32x4*)(cd + colt + bj * 128) = v0; *(pg8::f32x4*)(cd + colt + bj * 128 + 4) = v1; }
                    } } }
    }
};

__device__ __forceinline__ float dpp_ror1(float x) { return __int_as_float(__builtin_amdgcn_update_dpp(0, __float_as_int(x), 0x121, 0xf, 0xf, false)); }
__device__ __forceinline__ float dpp_ror2(float x) { return __int_as_float(__builtin_amdgcn_update_dpp(0, __float_as_int(x), 0x122, 0xf, 0xf, false)); }
struct EpiAct {
    static constexpr bool PERM = true, AFTER_DRAIN = false;
    bf16* act; float* convP; float* convS; const float* cw; const float* cb; const float* cstate; PG8_LAS float* halo;
    __device__ __forceinline__ void operator()(const pg8::f32x4 (&acc)[2][2][4][2], const pg8::Unit& u, int wr, int wc, int fr, int fq) const {
        const int jl = wc * 32 + 8 * fq, j0 = u.pn * 128 + jl;
        if (fr >= 14) {
#pragma unroll
            for (int ai = 0; ai < 2; ++ai) { PG8_LAS float* hp = halo + ((ai * 2 + wr) * 2 + (fr - 14)) * 128 + jl;
                *(PG8_LAS pg8::f32x4*)hp = acc[ai][0][3][0]; *(PG8_LAS pg8::f32x4*)(hp + 4) = acc[ai][0][3][1]; } }
        float w0[8], w1[8], w2[8], bb[8];
#pragma unroll
        for (int e = 0; e < 8; ++e) { w0[e] = cw[j0 + e]; w1[e] = cw[DFF + j0 + e]; w2[e] = cw[2 * DFF + j0 + e]; bb[e] = cb[j0 + e]; }
        asm volatile("s_waitcnt lgkmcnt(0)" ::: "memory"); __builtin_amdgcn_s_barrier(); asm volatile("" ::: "memory");
#pragma unroll
        for (int ai = 0; ai < 2; ++ai)
#pragma unroll
            for (int m = 0; m < 4; ++m) {
                const int rr = ai * 128 + wr * 64 + m * 16 + fr, r = u.pm * 254 - 2 + rr;
                float cur[8], p1[8], p2[8];
#pragma unroll
                for (int e = 0; e < 8; ++e) cur[e] = acc[ai][0][m][e >> 2][e & 3];
                if (m == 0) {
                    float h0[8], h1[8];
                    const int pb = ai * 2 + wr - 1;
                    if (pb >= 0) { const PG8_LAS float* hp = halo + (pb * 2) * 128 + jl;
                        const pg8::f32x4 a0 = *(const PG8_LAS pg8::f32x4*)hp, a1 = *(const PG8_LAS pg8::f32x4*)(hp + 4), b0 = *(const PG8_LAS pg8::f32x4*)(hp + 128), b1 = *(const PG8_LAS pg8::f32x4*)(hp + 132);
#pragma unroll
                        for (int e = 0; e < 4; ++e) { h0[e] = a0[e]; h0[4 + e] = a1[e]; h1[e] = b0[e]; h1[4 + e] = b1[e]; } }
                    else {
#pragma unroll
                        for (int e = 0; e < 8; ++e) { h0[e] = 0.f; h1[e] = 0.f; } }
#pragma unroll
                    for (int e = 0; e < 8; ++e) { const float s1 = dpp_ror1(cur[e]), s2 = dpp_ror2(cur[e]); p1[e] = fr >= 1 ? s1 : h1[e]; p2[e] = fr >= 2 ? s2 : (fr == 1 ? h1[e] : h0[e]); }
                } else {
#pragma unroll
                    for (int e = 0; e < 8; ++e) { const float pv = acc[ai][0][m - 1][e >> 2][e & 3];
                        const float s1 = dpp_ror1(cur[e]), s2 = dpp_ror2(cur[e]), q1 = dpp_ror1(pv), q2 = dpp_ror2(pv); p1[e] = fr >= 1 ? s1 : q1; p2[e] = fr >= 2 ? s2 : q2; }
                }
                const bool live = rr >= 2 && r < MR;
                const bool smp = r >= TP;
                const int t = smp ? ((r - TP) & 3) : (r & (SEQ - 1));
                if (live && t < 2) {
                    if (smp) { const float* cs = cstate + (size_t)((r - TP) >> 2) * 2 * DFF + j0;
#pragma unroll
                        for (int e = 0; e < 8; ++e) { if (t == 0) { p2[e] = cs[e]; p1[e] = cs[DFF + e]; } else { p2[e] = cs[DFF + e]; } } }
                    else {
#pragma unroll
                        for (int e = 0; e < 8; ++e) { p2[e] = 0.f; if (t == 0) p1[e] = 0.f; } }
                }
                if (live) {
                    float o[8];
                    typedef float f32x2 __attribute__((ext_vector_type(2)));
#pragma unroll
                    for (int e = 0; e < 8; e += 2) {
                        f32x2 cv = (f32x2){bb[e], bb[e + 1]} + (f32x2){w0[e], w0[e + 1]} * (f32x2){p2[e], p2[e + 1]};
                        cv += (f32x2){w1[e], w1[e + 1]} * (f32x2){p1[e], p1[e + 1]}; cv += (f32x2){w2[e], w2[e + 1]} * (f32x2){cur[e], cur[e + 1]};
                        const f32x2 vv = cv * (cv * cv * 0.044715f + 1.f) * (2.f * 0.7978845608028654f * 1.4426950408889634f);
                        const float r0 = __builtin_amdgcn_rcpf(__builtin_amdgcn_exp2f(vv.x) + 1.f), r1 = __builtin_amdgcn_rcpf(__builtin_amdgcn_exp2f(vv.y) + 1.f);
                        const f32x2 gl = cv - cv * (f32x2){r0, r1};
                        const f32x2 go = gl * (f32x2){acc[ai][1][m][e >> 2][e & 3], acc[ai][1][m][(e + 1) >> 2][(e + 1) & 3]};
                        o[e] = go.x; o[e + 1] = go.y; }
                    u32x4 wv; wv.x = pk2(o[0], o[1]); wv.y = pk2(o[2], o[3]); wv.z = pk2(o[4], o[5]); wv.w = pk2(o[6], o[7]);
                    *(u32x4*)(act + (size_t)r * DFF + j0) = wv;
                    float* cd = nullptr;
                    if (!smp) { if (t >= SEQ - 2) cd = convP + ((size_t)(r >> 11) * 2 + (t - (SEQ - 2))) * DFF; }
                    else if (t >= 2) cd = convS + ((size_t)((r - TP) >> 2) * 2 + (t - 2)) * DFF;
                    if (cd) { *(pg8::f32x4*)(cd + j0) = acc[ai][0][m][0]; *(pg8::f32x4*)(cd + j0 + 4) = acc[ai][0][m][1]; }
                }
            }
    }
};

typedef const __attribute__((address_space(4))) Args* KArgs;
struct Ctx {
    KArgs ap; int tid, lane, wave, gw, ngw, bx, G;
    __device__ __forceinline__ const float* in(int i) const { return ap->in[i]; }
    __device__ __forceinline__ float* out() const { return ap->out; }
    __device__ __forceinline__ bf16* W1T() const { return (bf16*)(ap->ws + WS_W1T); }
    __device__ __forceinline__ bf16* W2T() const { return (bf16*)(ap->ws + WS_W2T); }
    __device__ __forceinline__ bf16* W3T() const { return (bf16*)(ap->ws + WS_W3T); }
    __device__ __forceinline__ bf16* W4T() const { return (bf16*)(ap->ws + WS_W4T); }
    __device__ __forceinline__ bf16* GLUT() const { return (bf16*)(ap->ws + WS_GLUT); }
    __device__ __forceinline__ bf16* XN() const { return (bf16*)(ap->ws + WS_XN); }
    __device__ __forceinline__ bf16* PROJ() const { return (bf16*)(ap->ws + WS_BIG); }
    __device__ __forceinline__ bf16* ABUF() const { return (bf16*)(ap->ws + WS_ABUF); }
    __device__ __forceinline__ bf16* GATE() const { return (bf16*)(ap->ws + WS_GATE); }
    __device__ __forceinline__ bf16* Y5() const { return (bf16*)(ap->ws + WS_Y5); }
    __device__ __forceinline__ float* ROPE() const { return (float*)(ap->ws + WS_ROPE); }
    __device__ __forceinline__ float* SEG() const { return (float*)(ap->ws + WS_SEG); }
    __device__ __forceinline__ float* PART() const { return (float*)(ap->ws + WS_BIG); }
};
__device__ __forceinline__ Ctx mkctx() {
    Ctx c; KArgs p = (KArgs)__builtin_amdgcn_kernarg_segment_ptr(); asm volatile("" : "+s"(p)); c.ap = p;
    int t_ = threadIdx.x; asm volatile("" : "+v"(t_)); int b_ = blockIdx.x; asm volatile("" : "+s"(b_)); int g_ = gridDim.x; asm volatile("" : "+s"(g_));
    c.tid = t_; c.lane = c.tid & 63; c.wave = __builtin_amdgcn_readfirstlane(c.tid >> 6); c.bx = b_; c.G = g_;
    c.gw = b_ * 8 + c.wave; c.ngw = g_ * 8; return c;
}

__device__ __forceinline__ void transpose_item(const float* W, int K, int N, bf16* WT, float* scr, int item, int lane, bool ILV = false) {
    const int nblk = (N + 31) / 32, kb = item / nblk, nb = item % nblk, k0 = 64 * kb, n0 = 32 * nb;
    const int dst0 = !ILV ? n0 : (n0 < DFF ? 256 * (n0 >> 7) + (n0 & 127) : 256 * ((n0 - DFF) >> 7) + 128 + ((n0 - DFF) & 127));
    const int nn = n0 + (lane & 31);
    float tv[32];
#pragma unroll
    for (int i = 0; i < 32; ++i) { const int kk = 2 * i + (lane >> 5); tv[i] = (nn < N) ? W[(size_t)(k0 + kk) * N + nn] : 0.f; }
#pragma unroll
    for (int i = 0; i < 32; ++i) { const int kk = 2 * i + (lane >> 5); scr[kk * 33 + (lane & 31)] = tv[i]; }
    asm volatile("s_waitcnt lgkmcnt(0)" ::: "memory");
    const int c = lane & 7;
#pragma unroll
    for (int j = 0; j < 4; ++j) { const int n = (lane >> 3) + 8 * j; const float* s = scr + (8 * c) * 33 + n;
        u32x4 o; o.x = pk2(s[0 * 33], s[1 * 33]); o.y = pk2(s[2 * 33], s[3 * 33]); o.z = pk2(s[4 * 33], s[5 * 33]); o.w = pk2(s[6 * 33], s[7 * 33]);
        *(u32x4*)(WT + (size_t)(dst0 + n) * K + k0 + 8 * c) = o; }
    asm volatile("s_waitcnt lgkmcnt(0)" ::: "memory");
}
__device__ __forceinline__ void norm_row_bf16(const float* xrow, const float* g, bf16* orow, int lane, const float* part = nullptr, int nS = 0, float* xout = nullptr) {
    const f32x4* xr = (const f32x4*)xrow + lane; const f32x4* gr = (const f32x4*)g + lane;
    f32x4 v[4]; float s = 0.f;
#pragma unroll
    for (int j = 0; j < 4; ++j) v[j] = xr[64 * j];
    if (part) { for (int q = 0; q < nS; ++q) { const f32x4* pp = (const f32x4*)(part + (size_t)q * TS * D) + lane;
#pragma unroll
            for (int j = 0; j < 4; ++j) v[j] += pp[64 * j]; }
#pragma unroll
        for (int j = 0; j < 4; ++j) ((f32x4*)xout + lane)[64 * j] = v[j]; }
#pragma unroll
    for (int j = 0; j < 4; ++j) { s += (v[j].x * v[j].x + v[j].y * v[j].y) + (v[j].z * v[j].z + v[j].w * v[j].w); }
    const float rs = rsqrtf(wave_sum(s) * (1.f / D) + EPS);
    u32x2* o8 = (u32x2*)orow + lane;
#pragma unroll
    for (int j = 0; j < 4; ++j) { const f32x4 gg = gr[64 * j]; u32x2 w; w.x = pk2(v[j].x * rs * gg.x, v[j].y * rs * gg.y); w.y = pk2(v[j].z * rs * gg.z, v[j].w * rs * gg.w); o8[64 * j] = w; }
}
__device__ __forceinline__ void norm_row_f32(float* xrow, const float* g, int lane, const float* part = nullptr, int nS = 0) {
    f32x4* xr = (f32x4*)xrow + lane; const f32x4* gr = (const f32x4*)g + lane;
    f32x4 v[4]; float s = 0.f;
#pragma unroll
    for (int j = 0; j < 4; ++j) v[j] = xr[64 * j];
    if (part) { for (int q = 0; q < nS; ++q) { const f32x4* pp = (const f32x4*)(part + (size_t)q * TS * D) + lane;
#pragma unroll
            for (int j = 0; j < 4; ++j) v[j] += pp[64 * j]; } }
#pragma unroll
    for (int j = 0; j < 4; ++j) { s += (v[j].x * v[j].x + v[j].y * v[j].y) + (v[j].z * v[j].z + v[j].w * v[j].w); }
    const float rs = rsqrtf(wave_sum(s) * (1.f / D) + EPS);
#pragma unroll
    for (int j = 0; j < 4; ++j) { const f32x4 gg = gr[64 * j]; xr[64 * j] = v[j] * rs * gg; }
}

__device__ __forceinline__ void norm_rows2_bf16(const float* x0, const float* x1, const float* g, bf16* o0, bf16* o1, int lane) {
    const f32x4* xr0 = (const f32x4*)x0 + lane; const f32x4* xr1 = (const f32x4*)x1 + lane; const f32x4* gr = (const f32x4*)g + lane;
    f32x4 v0[4], v1[4]; float s0 = 0.f, s1 = 0.f;
#pragma unroll
    for (int j = 0; j < 4; ++j) { v0[j] = xr0[64 * j]; v1[j] = xr1[64 * j]; }
#pragma unroll
    for (int j = 0; j < 4; ++j) { s0 += (v0[j].x * v0[j].x + v0[j].y * v0[j].y) + (v0[j].z * v0[j].z + v0[j].w * v0[j].w); s1 += (v1[j].x * v1[j].x + v1[j].y * v1[j].y) + (v1[j].z * v1[j].z + v1[j].w * v1[j].w); }
#pragma unroll
    for (int o = 1; o < 64; o <<= 1) { s0 += __shfl_xor(s0, o); s1 += __shfl_xor(s1, o); }
    const float r0 = rsqrtf(s0 * (1.f / D) + EPS), r1 = rsqrtf(s1 * (1.f / D) + EPS);
    u32x2* p0 = (u32x2*)o0 + lane; u32x2* p1 = (u32x2*)o1 + lane;
#pragma unroll
    for (int j = 0; j < 4; ++j) { const f32x4 gg = gr[64 * j];
        u32x2 w; w.x = pk2(v0[j].x * r0 * gg.x, v0[j].y * r0 * gg.y); w.y = pk2(v0[j].z * r0 * gg.z, v0[j].w * r0 * gg.w); p0[64 * j] = w;
        u32x2 z; z.x = pk2(v1[j].x * r1 * gg.x, v1[j].y * r1 * gg.y); z.y = pk2(v1[j].z * r1 * gg.z, v1[j].w * r1 * gg.w); p1[64 * j] = z; }
}
__device__ __forceinline__ void norm_rows2_f32(float* x0, float* x1, const float* g, int lane) {
    f32x4* xr0 = (f32x4*)x0 + lane; f32x4* xr1 = (f32x4*)x1 + lane; const f32x4* gr = (const f32x4*)g + lane;
    f32x4 v0[4], v1[4]; float s0 = 0.f, s1 = 0.f;
#pragma unroll
    for (int j = 0; j < 4; ++j) { v0[j] = xr0[64 * j]; v1[j] = xr1[64 * j]; }
#pragma unroll
    for (int j = 0; j < 4; ++j) { s0 += (v0[j].x * v0[j].x + v0[j].y * v0[j].y) + (v0[j].z * v0[j].z + v0[j].w * v0[j].w); s1 += (v1[j].x * v1[j].x + v1[j].y * v1[j].y) + (v1[j].z * v1[j].z + v1[j].w * v1[j].w); }
#pragma unroll
    for (int o = 1; o < 64; o <<= 1) { s0 += __shfl_xor(s0, o); s1 += __shfl_xor(s1, o); }
    const float r0 = rsqrtf(s0 * (1.f / D) + EPS), r1 = rsqrtf(s1 * (1.f / D) + EPS);
#pragma unroll
    for (int j = 0; j < 4; ++j) { const f32x4 gg = gr[64 * j]; xr0[64 * j] = v0[j] * r0 * gg; xr1[64 * j] = v1[j] * r1 * gg; }
}

__device__ __forceinline__ void prep_phase(const Ctx& c, int l, float* L) {
    float* scr = L + c.wave * 4096;
    constexpr int I1 = 16 * 93, I2 = 16 * 32, I3 = 16 * 176, I4 = 44 * 32, I5 = 4 * 8;
    constexpr int NIT = I1 + I2 + I3 + I4 + I5;
    const float* w_in = c.in(I_WIN) + (size_t)l * D * INC;
    const float* w_out = c.in(I_WOUT) + (size_t)l * D * D;
    const float* f_in = c.in(I_FWIN) + (size_t)l * D * NUP;
    const float* f_out = c.in(I_FWOUT) + (size_t)l * DFF * D;
    const float* gluw = c.in(I_GLUW) + (size_t)l * 256 * 256;
    for (int it = c.gw; it < NIT; it += c.ngw) {
        int r = it;
        if (r < I1) { transpose_item(w_in, D, INC, c.W1T(), scr, r, c.lane); continue; } r -= I1;
        if (r < I2) { transpose_item(w_out, D, D, c.W2T(), scr, r, c.lane); continue; } r -= I2;
        if (r < I3) { transpose_item(f_in, D, NUP, c.W3T(), scr, r, c.lane, true); continue; } r -= I3;
        if (r < I4) { transpose_item(f_out, DFF, D, c.W4T(), scr, r, c.lane); continue; } r -= I4;
        transpose_item(gluw, 256, 256, c.GLUT(), scr, r, c.lane);
    }
    { const int gt = c.gw * 64 + c.lane, ngt = c.ngw * 64; u32x4 z = {0u, 0u, 0u, 0u};
      for (int i = gt; i < (NPROJ - 2976) * D / 8; i += ngt) *(u32x4*)(c.W1T() + (size_t)2976 * D + (size_t)i * 8) = z; }
    const float* g = c.in(I_NMG) + (size_t)l * D;
    { const float* xp = (l == 0) ? c.in(I_XP) : (const float*)c.out();
      for (int m = c.gw; m < TP; m += 2 * c.ngw) { const int m1 = m + c.ngw;
          if (m1 < TP) norm_rows2_bf16(xp + (size_t)m * D, xp + (size_t)m1 * D, g, c.XN() + (size_t)m * D, c.XN() + (size_t)m1 * D, c.lane);
          else norm_row_bf16(xp + (size_t)m * D, g, c.XN() + (size_t)m * D, c.lane); } }
    for (int m = TP + c.gw; m < MR; m += c.ngw) {
        const float* xr = (l == 0) ? c.in(I_XS) + (size_t)(m - TP) * D : c.out() + (size_t)m * D;
        if (l > 0) norm_row_bf16(xr, g, c.XN() + (size_t)m * D, c.lane, c.PART() + (size_t)(m - TP) * D, DFF / 256, c.out() + (size_t)m * D);
        else norm_row_bf16(xr, g, c.XN() + (size_t)m * D, c.lane);
    }
    if (l == 0) {
        const int gt = c.gw * 64 + c.lane, ngt = c.ngw * 64;
        for (int i = gt; i < 2052 * 32; i += ngt) { const int ps = i >> 5, f = i & 31; const int pos = ps < 2048 ? ps : 16384 + (ps - 2048);
            const float inv = exp2f(-(float)f * (13.287712379549449f / 32.f));
            double a = (double)pos * (double)inv; a -= 6.283185307179586 * rint(a * 0.15915494309189535);
            const float af = (float)a; c.ROPE()[i] = cosf(af); c.ROPE()[2052 * 32 + i] = sinf(af); }
    }
}

template <bool PASSA>
__device__ __forceinline__ void ret_task(const Ctx& c, int l, bool sample, int b, int h, int seg, float* L) {
    const int tid = c.tid, lane = c.lane, w = c.wave, vl = lane & 7, dg = lane >> 3;
    const int len = sample ? DSEQ : LSEG;
    const int row0 = sample ? TP + b * DSEQ : b * SEQ + seg * LSEG;
    const int ridx0 = sample ? 2048 : seg * LSEG;
    const float gamma = 1.f - exp2f(-5.f - (float)h);
    float S[8];
    if (sample) { const float* s0 = c.in(I_SRET) + ((size_t)((l * DB + b) * 6 + h) * 64 + 8 * dg) * 64 + 8 * w + vl;
#pragma unroll
        for (int i = 0; i < 8; ++i) S[i] = s0[i * 64]; }
    else {
#pragma unroll
        for (int i = 0; i < 8; ++i) S[i] = 0.f;
        const float lg = log2f(gamma);
        if (!PASSA) for (int m = 0; m < seg; ++m) { const float f = exp2f((float)(LSEG * (seg - 1 - m)) * lg);
            const float* E = c.SEG() + SEG_RET / 4 + (size_t)((b * 6 + h) * (NSEG - 1) + m) * 4096 + (8 * dg) * 64 + 8 * w + vl;
#pragma unroll
            for (int i = 0; i < 8; ++i) S[i] += f * E[i * 64]; }
    }
    float* Qs = L; float* Ks = L + 4096; float* Vs = L + 8192; float* Os = L + 12288;
    const float* rg_g = c.in(I_RNG) + l * 384 + h * 64; const float* rg_b = c.in(I_RNB) + l * 384 + h * 64;
    for (int c0 = 0; c0 < len; c0 += 64) {
        const int n = (len - c0) < 64 ? (len - c0) : 64;
        { const int t = tid >> 3, cc = tid & 7;
          if (t < n) { const bf16* pr = c.PROJ() + (size_t)(row0 + c0 + t) * NPROJ;
            const float* rc = c.ROPE() + (size_t)(ridx0 + c0 + t) * 32 + 4 * cc; const float* rsn = rc + 2052 * 32;
            const f32x4 cs = *(const f32x4*)rc, sn = *(const f32x4*)rsn;
            { const u32x2 lo = *(const u32x2*)(pr + C_RK + h * 64 + 4 * cc), hi = *(const u32x2*)(pr + C_RK + h * 64 + 32 + 4 * cc);
              const f32x4 x1 = {bflo(lo.x), bfhi(lo.x), bflo(lo.y), bfhi(lo.y)}, x2 = {bflo(hi.x), bfhi(hi.x), bflo(hi.y), bfhi(hi.y)};
              *(f32x4*)(Ks + t * 64 + 4 * cc) = (x1 * cs - x2 * sn) * 0.125f; *(f32x4*)(Ks + t * 64 + 32 + 4 * cc) = (x1 * sn + x2 * cs) * 0.125f; }
            if (!PASSA) { const u32x2 lo = *(const u32x2*)(pr + C_RQ + h * 64 + 4 * cc), hi = *(const u32x2*)(pr + C_RQ + h * 64 + 32 + 4 * cc);
              const f32x4 x1 = {bflo(lo.x), bfhi(lo.x), bflo(lo.y), bfhi(lo.y)}, x2 = {bflo(hi.x), bfhi(hi.x), bflo(hi.y), bfhi(hi.y)};
              *(f32x4*)(Qs + t * 64 + 4 * cc) = x1 * cs - x2 * sn; *(f32x4*)(Qs + t * 64 + 32 + 4 * cc) = x1 * sn + x2 * cs; }
            { const u32x4 vv = *(const u32x4*)(pr + C_RV + h * 64 + 8 * cc);
              *(f32x4*)(Vs + t * 64 + 8 * cc) = (f32x4){bflo(vv.x), bfhi(vv.x), bflo(vv.y), bfhi(vv.y)};
              *(f32x4*)(Vs + t * 64 + 8 * cc + 4) = (f32x4){bflo(vv.z), bfhi(vv.z), bflo(vv.w), bfhi(vv.w)}; } } }
        __syncthreads();
        for (int tl0 = 0; tl0 < n; tl0 += 4) {
            float po[4];
#pragma unroll
            for (int u = 0; u < 4; ++u) { const int tl = tl0 + u;
                const f32x4 k0 = *(const f32x4*)(Ks + tl * 64 + 8 * dg), k1 = *(const f32x4*)(Ks + tl * 64 + 8 * dg + 4);
                const float vv = Vs[tl * 64 + 8 * w + vl];
                const float kk[8] = {k0.x, k0.y, k0.z, k0.w, k1.x, k1.y, k1.z, k1.w};
#pragma unroll
                for (int i = 0; i < 8; ++i) S[i] = fmaf(gamma, S[i], kk[i] * vv);
                if (!PASSA) {
                    const f32x4 q0 = *(const f32x4*)(Qs + tl * 64 + 8 * dg), q1 = *(const f32x4*)(Qs + tl * 64 + 8 * dg + 4);
                    po[u] = q0.x * S[0] + q0.y * S[1] + q0.z * S[2] + q0.w * S[3] + q1.x * S[4] + q1.y * S[5] + q1.z * S[6] + q1.w * S[7]; } }
            if (!PASSA) {
#pragma unroll
                for (int u = 0; u < 4; ++u) po[u] += __shfl_xor(po[u], 8);
#pragma unroll
                for (int u = 0; u < 4; ++u) po[u] += __shfl_xor(po[u], 16);
#pragma unroll
                for (int u = 0; u < 4; ++u) po[u] += __shfl_xor(po[u], 32);
                if (dg == 0) {
#pragma unroll
                    for (int u = 0; u < 4; ++u) Os[(tl0 + u) * 64 + 8 * w + vl] = po[u]; } }
        }
        __syncthreads();
        if (!PASSA) { const int t = tid >> 3, cc = tid & 7;
          if (t < n) { const int row = row0 + c0 + t;
            const f32x4 o0 = *(const f32x4*)(Os + t * 64 + 8 * cc), o1 = *(const f32x4*)(Os + t * 64 + 8 * cc + 4);
            float o[8] = {o0.x, o0.y, o0.z, o0.w, o1.x, o1.y, o1.z, o1.w};
            float s = 0.f;
#pragma unroll
            for (int i = 0; i < 8; ++i) s += o[i];
            s += __shfl_xor(s, 1); s += __shfl_xor(s, 2); s += __shfl_xor(s, 4);
            const float mu = s * (1.f / 64.f); float q = 0.f;
#pragma unroll
            for (int i = 0; i < 8; ++i) { o[i] -= mu; q += o[i] * o[i]; }
            q += __shfl_xor(q, 1); q += __shfl_xor(q, 2); q += __shfl_xor(q, 4);
            const float rstd = rsqrtf(q * (1.f / 64.f) + EPS);
            const u32x4 gv = *(const u32x4*)(c.PROJ() + (size_t)row * NPROJ + C_RG + h * 64 + 8 * cc);
            const float gt[8] = {bflo(gv.x), bfhi(gv.x), bflo(gv.y), bfhi(gv.y), bflo(gv.z), bfhi(gv.z), bflo(gv.w), bfhi(gv.w)};
            float r[8];
#pragma unroll
            for (int i = 0; i < 8; ++i) r[i] = (o[i] * rstd * rg_g[8 * cc + i] + rg_b[8 * cc + i]) * silu(gt[i]);
            u32x4 wv; wv.x = pk2(r[0], r[1]); wv.y = pk2(r[2], r[3]); wv.z = pk2(r[4], r[5]); wv.w = pk2(r[6], r[7]);
            *(u32x4*)(c.XN() + (size_t)row * D + h * 64 + 8 * cc) = wv; } }
    }
    if (PASSA) { float* E = c.SEG() + SEG_RET / 4 + (size_t)((b * 6 + h) * (NSEG - 1) + seg) * 4096 + (8 * dg) * 64 + 8 * w + vl;
#pragma unroll
        for (int i = 0; i < 8; ++i) E[i * 64] = S[i]; }
    else if (sample || seg == NSEG - 1) {
        float* so = c.out() + (sample ? O_RETS + ((size_t)(l * DB + b) * 6 + h) * 4096 : O_RETP + ((size_t)(l * NB + b) * 6 + h) * 4096) + (8 * dg) * 64 + 8 * w + vl;
#pragma unroll
        for (int i = 0; i < 8; ++i) so[i * 64] = S[i]; }
}

template <bool PASSA>
__device__ __forceinline__ void gla_task(const Ctx& c, int l, bool sample, int b, int h, int seg, float* L) {
    const int tid = c.tid, lane = c.lane, w = c.wave;
    const int vl = lane % 12, dgr = lane / 12, dg = dgr > 3 ? 3 : dgr;
    const int len = sample ? DSEQ : LSEG;
    const int row0 = sample ? TP + b * DSEQ : b * SEQ + seg * LSEG;
    float* Qs = L; float* Ks = L + 3072; float* As = L + 6144; float* Vs = L + 9216; float* Os = L + 15360; float* GW = L + 21504; float* DS = L + 22272;
    for (int i = tid; i < 768; i += 512) { const int r = i / 48, d = i % 48; GW[i] = c.in(I_GGW)[(size_t)(l * 16 + r) * 192 + h * 48 + d]; }
    if (tid < 48) DS[tid] = 0.f;
    float S[12];
    const int vcol = 12 * w + vl;
    if (sample) { const float* s0 = c.in(I_SGLA) + ((size_t)((l * DB + b) * 4 + h) * 48 + 12 * dg) * 96 + vcol;
#pragma unroll
        for (int i = 0; i < 12; ++i) S[i] = s0[i * 96]; }
    else {
#pragma unroll
        for (int i = 0; i < 12; ++i) S[i] = 0.f;
        if (!PASSA) for (int m = 0; m < seg; ++m) { const float* E = c.SEG() + SEG_GLA / 4 + (size_t)((b * 4 + h) * (NSEG - 1) + m) * 4672;
#pragma unroll
            for (int i = 0; i < 12; ++i) S[i] = __expf(E[4608 + 12 * dg + i]) * S[i] + E[(12 * dg + i) * 96 + vcol]; }
    }
    const float* gb = c.in(I_GGB) + l * 192 + h * 48;
    const float* gng = c.in(I_GNG) + l * 96;
    __syncthreads();
    for (int c0 = 0; c0 < len; c0 += 64) {
        const int n = (len - c0) < 64 ? (len - c0) : 64;
        { const int t = tid >> 3, cc = tid & 7;
          if (t < n) { const bf16* pr = c.PROJ() + (size_t)(row0 + c0 + t) * NPROJ;
            const u32x4 g0 = *(const u32x4*)(pr + C_GLR), g1 = *(const u32x4*)(pr + C_GLR + 8);
            const float gl[16] = {bflo(g0.x), bfhi(g0.x), bflo(g0.y), bfhi(g0.y), bflo(g0.z), bfhi(g0.z), bflo(g0.w), bfhi(g0.w),
                                  bflo(g1.x), bfhi(g1.x), bflo(g1.y), bfhi(g1.y), bflo(g1.z), bfhi(g1.z), bflo(g1.w), bfhi(g1.w)};
#pragma unroll
            for (int j = 0; j < 6; ++j) { const int d = 6 * cc + j; float x = gb[d];
#pragma unroll
                for (int r = 0; r < 16; ++r) x = fmaf(gl[r], GW[r * 48 + d], x);
                const float lg = (fminf(x, 0.f) - __logf(1.f + __expf(-fabsf(x)))) * (1.f / 16.f);
                As[t * 48 + d] = __expf(lg);
                if (PASSA) atomicAdd(&DS[d], lg); }
            const unsigned* kq = (const unsigned*)(pr + C_GK + h * 48 + 6 * cc);
#pragma unroll
            for (int j = 0; j < 3; ++j) { const unsigned wv = kq[j]; Ks[t * 48 + 6 * cc + 2 * j] = bflo(wv); Ks[t * 48 + 6 * cc + 2 * j + 1] = bfhi(wv); }
            if (!PASSA) { const unsigned* qq = (const unsigned*)(pr + C_GQ + h * 48 + 6 * cc);
#pragma unroll
                for (int j = 0; j < 3; ++j) { const unsigned wv = qq[j]; Qs[t * 48 + 6 * cc + 2 * j] = bflo(wv) * 0.14433756729740643f; Qs[t * 48 + 6 * cc + 2 * j + 1] = bfhi(wv) * 0.14433756729740643f; } }
            const u32x2* vp = (const u32x2*)(pr + C_GV + h * 96 + 12 * cc);
#pragma unroll
            for (int j = 0; j < 3; ++j) { const u32x2 wv = vp[j]; *(f32x4*)(Vs + t * 96 + 12 * cc + 4 * j) = (f32x4){bflo(wv.x), bfhi(wv.x), bflo(wv.y), bfhi(wv.y)}; } } }
        __syncthreads();
        for (int tl0 = 0; tl0 < n; tl0 += 4) {
            float po[4];
#pragma unroll
            for (int u = 0; u < 4; ++u) { const int tl = tl0 + u;
                const f32x4* kp = (const f32x4*)(Ks + tl * 48 + 12 * dg); const f32x4* ap = (const f32x4*)(As + tl * 48 + 12 * dg);
                const f32x4 k0 = kp[0], k1 = kp[1], k2 = kp[2], a0 = ap[0], a1 = ap[1], a2 = ap[2];
                const float vv = Vs[tl * 96 + vcol];
                const float kk[12] = {k0.x, k0.y, k0.z, k0.w, k1.x, k1.y, k1.z, k1.w, k2.x, k2.y, k2.z, k2.w};
                const float aa[12] = {a0.x, a0.y, a0.z, a0.w, a1.x, a1.y, a1.z, a1.w, a2.x, a2.y, a2.z, a2.w};
#pragma unroll
                for (int i = 0; i < 12; ++i) S[i] = fmaf(aa[i], S[i], kk[i] * vv);
                if (!PASSA) {
                    const f32x4* qp = (const f32x4*)(Qs + tl * 48 + 12 * dg); const f32x4 q0 = qp[0], q1 = qp[1], q2 = qp[2];
                    po[u] = q0.x * S[0] + q0.y * S[1] + q0.z * S[2] + q0.w * S[3] + q1.x * S[4] + q1.y * S[5] + q1.z * S[6] + q1.w * S[7] + q2.x * S[8] + q2.y * S[9] + q2.z * S[10] + q2.w * S[11]; } }
            if (!PASSA) {
#pragma unroll
                for (int u = 0; u < 4; ++u) po[u] += __shfl(po[u], (lane + 24) & 63);
#pragma unroll
                for (int u = 0; u < 4; ++u) po[u] += __shfl(po[u], (lane + 12) & 63);
                if (lane < 12) {
#pragma unroll
                    for (int u = 0; u < 4; ++u) Os[(tl0 + u) * 96 + vcol] = po[u]; } }
        }
        __syncthreads();
        if (!PASSA) { const int t = tid >> 3, cc = tid & 7;
          if (t < n) { const int row = row0 + c0 + t;
            const f32x4* op = (const f32x4*)(Os + t * 96 + 12 * cc); const f32x4 o0 = op[0], o1 = op[1], o2 = op[2];
            const float o[12] = {o0.x, o0.y, o0.z, o0.w, o1.x, o1.y, o1.z, o1.w, o2.x, o2.y, o2.z, o2.w};
            float q = 0.f;
#pragma unroll
            for (int i = 0; i < 12; ++i) q += o[i] * o[i];
            q += __shfl_xor(q, 1); q += __shfl_xor(q, 2); q += __shfl_xor(q, 4);
            const float rs = rsqrtf(q * (1.f / 96.f) + EPS);
            const u32x2* gp = (const u32x2*)(c.PROJ() + (size_t)row * NPROJ + C_GG + h * 96 + 12 * cc);
            u32x2* dst = (u32x2*)(c.XN() + (size_t)row * D + 640 + h * 96 + 12 * cc);
#pragma unroll
            for (int j = 0; j < 3; ++j) { const u32x2 gv = gp[j];
                const float r0 = o[4 * j] * rs * gng[12 * cc + 4 * j] * silu(bflo(gv.x)), r1 = o[4 * j + 1] * rs * gng[12 * cc + 4 * j + 1] * silu(bfhi(gv.x));
                const float r2 = o[4 * j + 2] * rs * gng[12 * cc + 4 * j + 2] * silu(bflo(gv.y)), r3 = o[4 * j + 3] * rs * gng[12 * cc + 4 * j + 3] * silu(bfhi(gv.y));
                u32x2 wv; wv.x = pk2(r0, r1); wv.y = pk2(r2, r3); dst[j] = wv; } } }
    }
    if (PASSA) { float* E = c.SEG() + SEG_GLA / 4 + (size_t)((b * 4 + h) * (NSEG - 1) + seg) * 4672;
        if (lane < 48) {
#pragma unroll
            for (int i = 0; i < 12; ++i) E[(12 * dg + i) * 96 + vcol] = S[i]; }
        if (tid < 48) E[4608 + tid] = DS[tid]; }
    else if (sample || seg == NSEG - 1) {
        float* so = c.out() + (sample ? O_GLAS + ((size_t)(l * DB + b) * 4 + h) * 4608 : O_GLAP + ((size_t)(l * NB + b) * 4 + h) * 4608);
        if (lane < 48) {
#pragma unroll
            for (int i = 0; i < 12; ++i) so[(12 * dg + i) * 96 + vcol] = S[i]; } }
}

template <bool GLA, bool PASSA>
__device__ __forceinline__ void lin_task(const Ctx& c, int l, int b, int h, int seg, float* L) {
    typedef short bf16x8_t __attribute__((ext_vector_type(8)));
    constexpr int DK = GLA ? 48 : 64, DV = GLA ? 96 : 64, NVT = DV / 16, NT = GLA ? 3 : 2, RS = 72;
    const int tid = c.tid, lane = c.lane, w = c.wave, fr = lane & 15, fq = lane >> 4;
    const int row0 = b * SEQ + seg * LSEG;
    bf16* QT = (bf16*)L; bf16* KT = QT + 64 * RS; bf16* KH = KT + 64 * RS; bf16* VT = KH + 64 * RS; bf16* PP = VT + 96 * RS; bf16* ST = PP + 64 * RS;
    float* Os = (float*)(ST + 96 * RS); float* LG = Os + 64 * 96; float* SEGS = LG + 64 * 48; float* BEND = SEGS + 8 * 48; float* GW = BEND + 64;
    const float gamma = 1.f - exp2f(-5.f - (float)h), lg2 = log2f(gamma);
    if (GLA) {
        for (int i = tid; i < 16 * RS; i += 512) KH[48 * RS + i] = 0;
        if (tid < 16) BEND[48 + tid] = 0.f;
    }
    pg8::f32x4 accS[NT];
#pragma unroll
    for (int i = 0; i < NT; ++i) { const int id = w * NT + i, dt = id / NVT, vt = id % NVT, d0 = 16 * dt + 4 * fq, v = 16 * vt + fr;
        accS[i] = (pg8::f32x4){0.f, 0.f, 0.f, 0.f};
        if (!PASSA) {
            if (!GLA) {
#pragma unroll
                for (int m = 0; m < NSEG - 1; ++m) { const float f = m < seg ? exp2f((float)(LSEG * (seg - 1 - m)) * lg2) : 0.f;
                    const float* E = c.SEG() + SEG_RET / 4 + (size_t)((b * 6 + h) * (NSEG - 1) + m) * 4096;
#pragma unroll
                    for (int r = 0; r < 4; ++r) accS[i][r] += f * E[(d0 + r) * 64 + v]; } }
            else if (d0 < 48) {
#pragma unroll
                for (int m = 0; m < NSEG - 1; ++m) { const float* E = c.SEG() + SEG_GLA / 4 + (size_t)((b * 4 + h) * (NSEG - 1) + m) * 4672;
#pragma unroll
                    for (int r = 0; r < 4; ++r) { const float dl = E[4608 + d0 + r], ev = E[(d0 + r) * 96 + v]; accS[i][r] = m < seg ? __expf(dl) * accS[i][r] + ev : accS[i][r]; } } }
            u32x2 sv; sv.x = pk2(accS[i][0], accS[i][1]); sv.y = pk2(accS[i][2], accS[i][3]); *(u32x2*)(ST + v * RS + d0) = sv;
        } }
    float dlsum[6] = {0.f, 0.f, 0.f, 0.f, 0.f, 0.f};
    const float* gb = c.in(I_GGB) + l * 192 + h * 48;
    const int gt0 = w, gt1 = w + 8, gmt0 = gt0 / 3, gnt0 = gt0 % 3, gmt1 = (gt1 < 12 ? gt1 : 0) / 3, gnt1 = (gt1 < 12 ? gt1 : 0) % 3;
    bf16x8_t gwf0 = {0, 0, 0, 0, 0, 0, 0, 0}, gwf1 = {0, 0, 0, 0, 0, 0, 0, 0};
    if (GLA && fq < 2) { const float* gw = c.in(I_GGW) + (size_t)(l * 16 + 8 * fq) * 192 + h * 48 + fr;
        float t0[8], t1[8];
#pragma unroll
        for (int j = 0; j < 8; ++j) { t0[j] = gw[(size_t)j * 192 + 16 * gnt0]; t1[j] = gw[(size_t)j * 192 + 16 * gnt1]; }
        u32x4 a = {pk2(t0[0], t0[1]), pk2(t0[2], t0[3]), pk2(t0[4], t0[5]), pk2(t0[6], t0[7])}, bq = {pk2(t1[0], t1[1]), pk2(t1[2], t1[3]), pk2(t1[4], t1[5]), pk2(t1[6], t1[7])};
        gwf0 = __builtin_bit_cast(bf16x8_t, a); gwf1 = __builtin_bit_cast(bf16x8_t, bq); }
    __syncthreads();
    const int t = tid >> 3, cc = tid & 7;
    u32x2 r_klo, r_khi, r_qlo, r_qhi; u32x4 r_v4, r_g4; f32x4 r_cs, r_sn;
    u32x4 r_glr0 = {0u, 0u, 0u, 0u}, r_glr1 = {0u, 0u, 0u, 0u}; unsigned r_k[3], r_q[3]; u32x2 r_v2[3], r_g2[3];
#define LIN_LOAD(cn) do { const bf16* pr_ = c.PROJ() + (size_t)(row0 + (cn) + t) * NPROJ; \
        if (!GLA) { const float* rc_ = c.ROPE() + (size_t)(seg * LSEG + (cn) + t) * 32 + 4 * cc; r_cs = *(const f32x4*)rc_; r_sn = *(const f32x4*)(rc_ + 2052 * 32); \
            r_klo = *(const u32x2*)(pr_ + C_RK + h * 64 + 4 * cc); r_khi = *(const u32x2*)(pr_ + C_RK + h * 64 + 32 + 4 * cc); r_v4 = *(const u32x4*)(pr_ + C_RV + h * 64 + 8 * cc); \
            if (!PASSA) { r_qlo = *(const u32x2*)(pr_ + C_RQ + h * 64 + 4 * cc); r_qhi = *(const u32x2*)(pr_ + C_RQ + h * 64 + 32 + 4 * cc); r_g4 = *(const u32x4*)(pr_ + C_RG + h * 64 + 8 * cc); } } \
        else { if (fq < 2) { r_glr0 = *(const u32x4*)(c.PROJ() + (size_t)(row0 + (cn) + 16 * gmt0 + fr) * NPROJ + C_GLR + 8 * fq); if (gt1 < 12) r_glr1 = *(const u32x4*)(c.PROJ() + (size_t)(row0 + (cn) + 16 * gmt1 + fr) * NPROJ + C_GLR + 8 * fq); } \
            _Pragma("unroll") for (int j_ = 0; j_ < 3; ++j_) { r_k[j_] = ((const unsigned*)(pr_ + C_GK + h * 48 + 6 * cc))[j_]; r_v2[j_] = ((const u32x2*)(pr_ + C_GV + h * 96 + 12 * cc))[j_]; \
                if (!PASSA) { r_q[j_] = ((const unsigned*)(pr_ + C_GQ + h * 48 + 6 * cc))[j_]; r_g2[j_] = ((const u32x2*)(pr_ + C_GG + h * 96 + 12 * cc))[j_]; } } } } while (0)
    LIN_LOAD(0);
    for (int c0 = 0; c0 < LSEG; c0 += 64) {
        u32x4 g4c = {0u, 0u, 0u, 0u}; u32x2 g2c[3] = {{0u, 0u}, {0u, 0u}, {0u, 0u}};
        if (!PASSA) { if (!GLA) g4c = r_g4; else { g2c[0] = r_g2[0]; g2c[1] = r_g2[1]; g2c[2] = r_g2[2]; } }
        if (!GLA) {
            const f32x4 cs = r_cs, sn = r_sn;
            const float eq = __builtin_amdgcn_exp2f((float)(t + 1) * lg2), ek = __builtin_amdgcn_exp2f(-(float)(t + 1) * lg2) * 0.125f, eh = __builtin_amdgcn_exp2f((float)(63 - t) * lg2) * 0.125f;
            { const u32x2 lo = r_klo, hi = r_khi;
              const f32x4 x1 = {bflo(lo.x), bfhi(lo.x), bflo(lo.y), bfhi(lo.y)}, x2 = {bflo(hi.x), bfhi(hi.x), bflo(hi.y), bfhi(hi.y)};
              const f32x4 k1 = x1 * cs - x2 * sn, k2 = x1 * sn + x2 * cs;
              if (!PASSA) { u32x2 a; a.x = pk2(k1.x * ek, k1.y * ek); a.y = pk2(k1.z * ek, k1.w * ek); *(u32x2*)(KT + t * RS + 4 * cc) = a;
                            u32x2 bq; bq.x = pk2(k2.x * ek, k2.y * ek); bq.y = pk2(k2.z * ek, k2.w * ek); *(u32x2*)(KT + t * RS + 32 + 4 * cc) = bq; }
#pragma unroll
              for (int e = 0; e < 4; ++e) { KH[(4 * cc + e) * RS + t] = (bf16)f2bf(k1[e] * eh); KH[(32 + 4 * cc + e) * RS + t] = (bf16)f2bf(k2[e] * eh); } }
            if (!PASSA) { const u32x2 lo = r_qlo, hi = r_qhi;
              const f32x4 x1 = {bflo(lo.x), bfhi(lo.x), bflo(lo.y), bfhi(lo.y)}, x2 = {bflo(hi.x), bfhi(hi.x), bflo(hi.y), bfhi(hi.y)};
              const f32x4 q1 = (x1 * cs - x2 * sn) * eq, q2 = (x1 * sn + x2 * cs) * eq;
              u32x2 a; a.x = pk2(q1.x, q1.y); a.y = pk2(q1.z, q1.w); *(u32x2*)(QT + t * RS + 4 * cc) = a;
              u32x2 bq; bq.x = pk2(q2.x, q2.y); bq.y = pk2(q2.z, q2.w); *(u32x2*)(QT + t * RS + 32 + 4 * cc) = bq; }
            { const unsigned vw[4] = {r_v4.x, r_v4.y, r_v4.z, r_v4.w};
#pragma unroll
              for (int e = 0; e < 4; ++e) { VT[(8 * cc + 2 * e) * RS + t] = (bf16)(vw[e] & 0xffffu); VT[(8 * cc + 2 * e + 1) * RS + t] = (bf16)(vw[e] >> 16); } }
            if (c0 + 64 < LSEG) LIN_LOAD(c0 + 64);
        } else {
            float kf[6], qf[6]; unsigned vw[6];
            { { const pg8::f32x4 z4 = {0.f, 0.f, 0.f, 0.f};
                const pg8::f32x4 x0 = __builtin_amdgcn_mfma_f32_16x16x32_bf16(__builtin_bit_cast(bf16x8_t, r_glr0), gwf0, z4, 0, 0, 0);
                const float b0 = gb[16 * gnt0 + fr];
#pragma unroll
                for (int j = 0; j < 4; ++j) { const float x = x0[j] + b0; LG[(16 * gmt0 + 4 * fq + j) * 48 + 16 * gnt0 + fr] = (fminf(x, 0.f) - __logf(1.f + __expf(-fabsf(x)))) * (1.f / 16.f); }
                if (gt1 < 12) { const pg8::f32x4 x1 = __builtin_amdgcn_mfma_f32_16x16x32_bf16(__builtin_bit_cast(bf16x8_t, r_glr1), gwf1, z4, 0, 0, 0);
                    const float b1 = gb[16 * gnt1 + fr];
#pragma unroll
                    for (int j = 0; j < 4; ++j) { const float x = x1[j] + b1; LG[(16 * gmt1 + 4 * fq + j) * 48 + 16 * gnt1 + fr] = (fminf(x, 0.f) - __logf(1.f + __expf(-fabsf(x)))) * (1.f / 16.f); } } }
#pragma unroll
              for (int j = 0; j < 3; ++j) { const unsigned wv = r_k[j]; kf[2 * j] = bflo(wv); kf[2 * j + 1] = bfhi(wv); }
              if (!PASSA) {
#pragma unroll
                  for (int j = 0; j < 3; ++j) { const unsigned wv = r_q[j]; qf[2 * j] = bflo(wv) * 0.14433756729740643f; qf[2 * j + 1] = bfhi(wv) * 0.14433756729740643f; } }
#pragma unroll
              for (int j = 0; j < 3; ++j) { vw[2 * j] = r_v2[j].x; vw[2 * j + 1] = r_v2[j].y; } }
            if (c0 + 64 < LSEG) LIN_LOAD(c0 + 64);
            __syncthreads();
            if (tid < 384) { const int d = tid % 48, sg = tid / 48; float lv[8];
#pragma unroll
                for (int i = 0; i < 8; ++i) lv[i] = LG[(8 * sg + i) * 48 + d];
#pragma unroll
                for (int i = 1; i < 8; ++i) lv[i] += lv[i - 1];
#pragma unroll
                for (int i = 0; i < 8; ++i) LG[(8 * sg + i) * 48 + d] = lv[i];
                SEGS[sg * 48 + d] = lv[7]; }
            __syncthreads();
            { float qv[6], kv[6];
#pragma unroll
              for (int j = 0; j < 6; ++j) { const int d = 6 * cc + j; float pre = 0.f, tot = 0.f;
#pragma unroll
                for (int s = 0; s < 8; ++s) { const float sv = SEGS[s * 48 + d]; tot += sv; if (s < (t >> 3)) pre += sv; }
                pre += LG[t * 48 + d];
                if (!PASSA) { qv[j] = qf[j] * __expf(pre); kv[j] = kf[j] * __expf(-pre); }
                KH[d * RS + t] = (bf16)f2bf(kf[j] * __expf(tot - pre));
                if (t == 0) { BEND[d] = tot; dlsum[j] += tot; } }
              if (!PASSA) {
#pragma unroll
                for (int j = 0; j < 3; ++j) { *(unsigned*)(QT + t * RS + 6 * cc + 2 * j) = pk2(qv[2 * j], qv[2 * j + 1]); *(unsigned*)(KT + t * RS + 6 * cc + 2 * j) = pk2(kv[2 * j], kv[2 * j + 1]); } } }
            if (!PASSA) { *(unsigned*)(QT + t * RS + 48 + 2 * cc) = 0u; *(unsigned*)(KT + t * RS + 48 + 2 * cc) = 0u; }
#pragma unroll
            for (int e = 0; e < 6; ++e) { VT[(12 * cc + 2 * e) * RS + t] = (bf16)(vw[e] & 0xffffu); VT[(12 * cc + 2 * e + 1) * RS + t] = (bf16)(vw[e] >> 16); }
        }
        __syncthreads();
        __builtin_amdgcn_s_setprio(1);
        if (!PASSA) {
#pragma unroll
            for (int i = 0; i < 2; ++i) { const int id = 2 * w + i, it = id >> 2, jt = id & 3;
                pg8::f32x4 acc = {0.f, 0.f, 0.f, 0.f};
                if (jt <= it) {
#pragma unroll
                    for (int ks = 0; ks < 2; ++ks) { const bf16x8_t a = *(const bf16x8_t*)(KT + (16 * jt + fr) * RS + 32 * ks + 8 * fq), bq = *(const bf16x8_t*)(QT + (16 * it + fr) * RS + 32 * ks + 8 * fq);
                        acc = __builtin_amdgcn_mfma_f32_16x16x32_bf16(a, bq, acc, 0, 0, 0); } }
                { const int ii = 16 * it + fr, j0 = 16 * jt + 4 * fq;
                  u32x2 pw; pw.x = pk2(j0 <= ii ? acc[0] : 0.f, j0 + 1 <= ii ? acc[1] : 0.f); pw.y = pk2(j0 + 2 <= ii ? acc[2] : 0.f, j0 + 3 <= ii ? acc[3] : 0.f);
                  *(u32x2*)(PP + ii * RS + j0) = pw; } } }
#pragma unroll
        for (int i = 0; i < NT; ++i) { const int id = w * NT + i, dt = id / NVT, vt = id % NVT;
            if (GLA) {
#pragma unroll
                for (int r = 0; r < 4; ++r) accS[i][r] *= __expf(BEND[16 * dt + 4 * fq + r]); }
            else { const float g64 = exp2f(64.f * lg2); accS[i] = accS[i] * g64; }
#pragma unroll
            for (int ks = 0; ks < 2; ++ks) { const bf16x8_t a = *(const bf16x8_t*)(KH + (16 * dt + fr) * RS + 32 * ks + 8 * fq), bv = *(const bf16x8_t*)(VT + (16 * vt + fr) * RS + 32 * ks + 8 * fq);
                accS[i] = __builtin_amdgcn_mfma_f32_16x16x32_bf16(a, bv, accS[i], 0, 0, 0); } }
        __builtin_amdgcn_s_setprio(0);
        __syncthreads();
        __builtin_amdgcn_s_setprio(1);
        if (!PASSA) {
#pragma unroll
            for (int i = 0; i < NT; ++i) { const int id = w * NT + i, it = id / NVT, vt = id % NVT;
                pg8::f32x4 acc = {0.f, 0.f, 0.f, 0.f};
#pragma unroll
                for (int ks = 0; ks < 2; ++ks) { const bf16x8_t a = *(const bf16x8_t*)(PP + (16 * it + fr) * RS + 32 * ks + 8 * fq), bv = *(const bf16x8_t*)(VT + (16 * vt + fr) * RS + 32 * ks + 8 * fq);
                    acc = __builtin_amdgcn_mfma_f32_16x16x32_bf16(a, bv, acc, 0, 0, 0); }
#pragma unroll
                for (int ks = 0; ks < 2; ++ks) { const bf16x8_t a = *(const bf16x8_t*)(QT + (16 * it + fr) * RS + 32 * ks + 8 * fq), bs = *(const bf16x8_t*)(ST + (16 * vt + fr) * RS + 32 * ks + 8 * fq);
                    acc = __builtin_amdgcn_mfma_f32_16x16x32_bf16(a, bs, acc, 0, 0, 0); }
#pragma unroll
                for (int r = 0; r < 4; ++r) Os[(16 * it + 4 * fq + r) * DV + 16 * vt + fr] = acc[r]; } }
        __builtin_amdgcn_s_setprio(0);
        __syncthreads();
        if (!PASSA) {
#pragma unroll
            for (int i = 0; i < NT; ++i) { const int id = w * NT + i, dt = id / NVT, vt = id % NVT, d0 = 16 * dt + 4 * fq, v = 16 * vt + fr;
                u32x2 sv; sv.x = pk2(accS[i][0], accS[i][1]); sv.y = pk2(accS[i][2], accS[i][3]); *(u32x2*)(ST + v * RS + d0) = sv; }
            const int row = row0 + c0 + t;
            if (!GLA) {
                const f32x4 o0 = *(const f32x4*)(Os + t * 64 + 8 * cc), o1 = *(const f32x4*)(Os + t * 64 + 8 * cc + 4);
                float o[8] = {o0.x, o0.y, o0.z, o0.w, o1.x, o1.y, o1.z, o1.w};
                float s = 0.f;
#pragma unroll
                for (int i = 0; i < 8; ++i) s += o[i];
                s += __shfl_xor(s, 1); s += __shfl_xor(s, 2); s += __shfl_xor(s, 4);
                const float mu = s * (1.f / 64.f); float q = 0.f;
#pragma unroll
                for (int i = 0; i < 8; ++i) { o[i] -= mu; q += o[i] * o[i]; }
                q += __shfl_xor(q, 1); q += __shfl_xor(q, 2); q += __shfl_xor(q, 4);
                const float rstd = rsqrtf(q * (1.f / 64.f) + EPS);
                const float* rg_g = c.in(I_RNG) + l * 384 + h * 64; const float* rg_b = c.in(I_RNB) + l * 384 + h * 64;
                const u32x4 gv = g4c;
                const float gt[8] = {bflo(gv.x), bfhi(gv.x), bflo(gv.y), bfhi(gv.y), bflo(gv.z), bfhi(gv.z), bflo(gv.w), bfhi(gv.w)};
                float r[8];
#pragma unroll
                for (int i = 0; i < 8; ++i) r[i] = (o[i] * rstd * rg_g[8 * cc + i] + rg_b[8 * cc + i]) * silu(gt[i]);
                u32x4 wv; wv.x = pk2(r[0], r[1]); wv.y = pk2(r[2], r[3]); wv.z = pk2(r[4], r[5]); wv.w = pk2(r[6], r[7]);
                *(u32x4*)(c.XN() + (size_t)row * D + h * 64 + 8 * cc) = wv;
            } else {
                const float* gng = c.in(I_GNG) + l * 96;
                const f32x4* op = (const f32x4*)(Os + t * 96 + 12 * cc); const f32x4 o0 = op[0], o1 = op[1], o2 = op[2];
                const float o[12] = {o0.x, o0.y, o0.z, o0.w, o1.x, o1.y, o1.z, o1.w, o2.x, o2.y, o2.z, o2.w};
                float q = 0.f;
#pragma unroll
                for (int i = 0; i < 12; ++i) q += o[i] * o[i];
                q += __shfl_xor(q, 1); q += __shfl_xor(q, 2); q += __shfl_xor(q, 4);
                const float rs = rsqrtf(q * (1.f / 96.f) + EPS);
                u32x2* dst = (u32x2*)(c.XN() + (size_t)row * D + 640 + h * 96 + 12 * cc);
#pragma unroll
                for (int j = 0; j < 3; ++j) { const u32x2 gv = g2c[j];
                    const float r0 = o[4 * j] * rs * gng[12 * cc + 4 * j] * silu(bflo(gv.x)), r1 = o[4 * j + 1] * rs * gng[12 * cc + 4 * j + 1] * silu(bfhi(gv.x));
                    const float r2 = o[4 * j + 2] * rs * gng[12 * cc + 4 * j + 2] * silu(bflo(gv.y)), r3 = o[4 * j + 3] * rs * gng[12 * cc + 4 * j + 3] * silu(bfhi(gv.y));
                    u32x2 wv; wv.x = pk2(r0, r1); wv.y = pk2(r2, r3); dst[j] = wv; }
            }
        }
    }
    if (PASSA || seg == NSEG - 1) {
        float* E = PASSA ? c.SEG() + (GLA ? SEG_GLA / 4 + (size_t)((b * 4 + h) * (NSEG - 1) + seg) * 4672 : SEG_RET / 4 + (size_t)((b * 6 + h) * (NSEG - 1) + seg) * 4096)
                         : c.out() + (GLA ? O_GLAP + ((size_t)(l * NB + b) * 4 + h) * 4608 : O_RETP + ((size_t)(l * NB + b) * 6 + h) * 4096);
#pragma unroll
        for (int i = 0; i < NT; ++i) { const int id = w * NT + i, dt = id / NVT, vt = id % NVT, d0 = 16 * dt + 4 * fq, v = 16 * vt + fr;
            if (d0 < DK) {
#pragma unroll
                for (int r = 0; r < 4; ++r) E[(d0 + r) * DV + v] = accS[i][r]; } }
        if (GLA && PASSA && tid < 8) {
#pragma unroll
            for (int j = 0; j < 6; ++j) E[4608 + 6 * tid + j] = dlsum[j]; }
    }
}

template <bool PASSA>
__device__ __forceinline__ void s5_task(const Ctx& c, int l, bool sample, int b, int oct, int seg, float* L) {
    typedef short bf16x8_t __attribute__((ext_vector_type(8)));
    const int tid = c.tid, lane = c.lane, w = c.wave, fr = lane & 15, fq = lane >> 4;
    const int g = 8 * oct + w, p = lane;
    const int len = sample ? 64 : LSEG5;
    const int row0 = sample ? TP + b * 64 : b * SEQ + seg * LSEG5;
    constexpr int HS = 136;
    bf16* Ub = (bf16*)L;
    float* Xw = L + 4096 + w * 2048;
    bf16* Hw = (bf16*)(L + 20480) + w * (16 * HS);
    float ar, ai;
    bf16x8_t bx[8], cb[4];
    { const int gp = (l * 16 + g) * 64 + p;
      const float lr = fminf(c.in(I_LRE)[gp], -1e-4f), li = c.in(I_LIM)[gp], dt = expf(c.in(I_LDT)[l * 16 + g]);
      const float mag = expf(lr * dt), ang = li * dt; ar = mag * cosf(ang); ai = mag * sinf(ang);
      const float den = lr * lr + li * li, cr = ((ar - 1.f) * lr + ai * li) / den, ci = (ai * lr - (ar - 1.f) * li) / den;
#pragma unroll
      for (int n = 0; n < 8; ++n) { const int ps = 16 * (n & 3) + fr; const float crs = __shfl(cr, ps), cis = __shfl(ci, ps);
          u32x4 t4 = {0u, 0u, 0u, 0u};
          if (fq < 2) { const float* brp = c.in(I_BRE) + ((size_t)((l * 16 + g) * 64 + ps)) * 16 + 8 * fq; const float* bip = c.in(I_BIM) + ((size_t)((l * 16 + g) * 64 + ps)) * 16 + 8 * fq;
              const f32x4 r0 = *(const f32x4*)brp, r1 = *(const f32x4*)(brp + 4), i0 = *(const f32x4*)bip, i1 = *(const f32x4*)(bip + 4);
              float v[8];
#pragma unroll
              for (int e = 0; e < 4; ++e) { v[e] = n < 4 ? crs * r0[e] - cis * i0[e] : crs * i0[e] + cis * r0[e]; v[4 + e] = n < 4 ? crs * r1[e] - cis * i1[e] : crs * i1[e] + cis * r1[e]; }
              t4 = (u32x4){pk2(v[0], v[1]), pk2(v[2], v[3]), pk2(v[4], v[5]), pk2(v[6], v[7])}; }
          bx[n] = __builtin_bit_cast(bf16x8_t, t4); }
      if (!PASSA) {
#pragma unroll
          for (int s = 0; s < 4; ++s) { const float* src = (s < 2 ? c.in(I_CRE) : c.in(I_CIM)) + (size_t)((l * 16 + g) * 16 + fr) * 64 + 32 * (s & 1) + 8 * fq;
              const f32x4 v0 = *(const f32x4*)src, v1 = *(const f32x4*)(src + 4); const float sg = s < 2 ? 1.f : -1.f;
              u32x4 t4 = {pk2(sg * v0.x, sg * v0.y), pk2(sg * v0.z, sg * v0.w), pk2(sg * v1.x, sg * v1.y), pk2(sg * v1.z, sg * v1.w)}; cb[s] = __builtin_bit_cast(bf16x8_t, t4); } }
    }
    float hr = 0.f, hi = 0.f;
    float s0r[16], s0i[16];
    if (sample) {
#pragma unroll
        for (int j = 0; j < 16; ++j) { s0r[j] = c.in(I_S5R)[(size_t)(l * DB + 16 * b + j) * 1024 + g * 64 + p]; s0i[j] = c.in(I_S5I)[(size_t)(l * DB + 16 * b + j) * 1024 + g * 64 + p]; } }
    else {
        if (!PASSA && seg > 0) { float pr = ar, pi = ai;
#pragma unroll
            for (int k = 0; k < LOG2_LSEG5; ++k) { const float nr = pr * pr - pi * pi, ni = 2.f * pr * pi; pr = nr; pi = ni; }
            float er[NSEG5 - 1], ei[NSEG5 - 1];
#pragma unroll
            for (int m = 0; m < NSEG5 - 1; ++m) { const float* E = c.SEG() + SEG_S5 / 4 + (size_t)(b * (NSEG5 - 1) + m) * 2048 + g * 64 + p; er[m] = E[0]; ei[m] = E[1024]; }
#pragma unroll
            for (int m = 0; m < NSEG5 - 1; ++m) { if (m < seg) { const float nr = pr * hr - pi * hi + er[m], ni = pr * hi + pi * hr + ei[m]; hr = nr; hi = ni; } } }
    }
    static_assert(LSEG5 == (1 << LOG2_LSEG5), "A^LSEG5 squaring count");
    const float dval = c.in(I_S5D)[l * 256 + 128 * oct + 16 * w + fr];
    for (int c0 = 0; c0 < len; c0 += 64) {
        const int n = (len - c0) < 64 ? (len - c0) : 64;
        { const int t = tid >> 3, cc = tid & 7;
          if (t < n) { const bf16* pr = c.PROJ() + (size_t)(row0 + c0 + t) * NPROJ + C_SU + 128 * oct + 16 * cc;
            const u32x4 u0 = *(const u32x4*)pr, u1 = *(const u32x4*)(pr + 8);
            *(u32x4*)(Ub + t * 128 + 16 * cc) = u0; *(u32x4*)(Ub + t * 128 + 16 * cc + 8) = u1; } }
        __syncthreads();
#pragma unroll
        for (int tb = 0; tb < 64; tb += 16) { if (tb >= n) break;
            const int nb = (n - tb) < 16 ? (n - tb) : 16;
            { bf16x8_t a = {0, 0, 0, 0, 0, 0, 0, 0};
              if (fq < 2) a = *(const bf16x8_t*)(Ub + (tb + fr) * 128 + 16 * w + 8 * fq);
              __builtin_amdgcn_s_setprio(1);
#pragma unroll
              for (int n8 = 0; n8 < 8; ++n8) { const pg8::f32x4 z4 = {0.f, 0.f, 0.f, 0.f};
                  const pg8::f32x4 xa = __builtin_amdgcn_mfma_f32_16x16x32_bf16(a, bx[n8], z4, 0, 0, 0);
#pragma unroll
                  for (int j = 0; j < 4; ++j) Xw[(4 * fq + j) * 128 + 16 * n8 + fr] = xa[j]; } }
            __builtin_amdgcn_s_setprio(0);
            asm volatile("s_waitcnt lgkmcnt(0)" ::: "memory");
#pragma unroll
            for (int tt = 0; tt < 16; ++tt) { if (tt >= nb) break;
                if (sample && (tt & 3) == 0) { hr = s0r[(tb + tt) >> 2]; hi = s0i[(tb + tt) >> 2]; }
                typedef float f32x2 __attribute__((ext_vector_type(2)));
                f32x2 hn = (f32x2){Xw[tt * 128 + p], Xw[tt * 128 + 64 + p]} + (f32x2){hr, hi} * ar;
                hn += (f32x2){-hi, hr} * ai; hr = hn.x; hi = hn.y;
                if (!PASSA && sample && (tt & 3) == 3) { const size_t so = (size_t)(l * DB + 16 * b + ((tb + tt) >> 2)) * 1024 + g * 64 + p; c.out()[O_S5RS + so] = hr; c.out()[O_S5IS + so] = hi; }
                if (!PASSA) { const unsigned hh = pk2(hr, hi); Hw[tt * HS + p] = (bf16)(hh & 0xffffu); Hw[tt * HS + 64 + p] = (bf16)(hh >> 16); }
            }
            if (!PASSA) {
                asm volatile("s_waitcnt lgkmcnt(0)" ::: "memory");
                pg8::f32x4 acc = {0.f, 0.f, 0.f, 0.f};
#pragma unroll
                for (int s = 0; s < 4; ++s) { const bf16x8_t a = *(const bf16x8_t*)(Hw + fr * HS + 32 * s + 8 * fq);
                    acc = __builtin_amdgcn_mfma_f32_16x16x32_bf16(a, cb[s], acc, 0, 0, 0); }
#pragma unroll
                for (int j = 0; j < 4; ++j) { const int tq = 4 * fq + j;
                    if (tq < nb) { const int t = tb + tq; const float u = bflo((unsigned)Ub[t * 128 + 16 * w + fr]);
                        c.Y5()[(size_t)(row0 + c0 + t) * 256 + 128 * oct + 16 * w + fr] = (bf16)f2bf(gelu_tanh(acc[j] + dval * u)); } }
            }
            asm volatile("s_waitcnt lgkmcnt(0)" ::: "memory");
        }
        __syncthreads();
    }
    if (PASSA) { float* E = c.SEG() + SEG_S5 / 4 + (size_t)(b * (NSEG5 - 1) + seg) * 2048 + g * 64 + p; E[0] = hr; E[1024] = hi; }
    else if (sample) { }
    else if (seg == NSEG5 - 1) { c.out()[O_S5RP + (size_t)(l * NB + b) * 1024 + g * 64 + p] = hr; c.out()[O_S5IP + (size_t)(l * NB + b) * 1024 + g * 64 + p] = hi; }
}

__device__ __forceinline__ void ret_sample_wave(const Ctx& c, int l, int b, int h) {
    const int lane = c.lane, f = lane & 31;
    const float gamma = 1.f - exp2f(-5.f - (float)h);
    float S[64];
    const float* s0 = c.in(I_SRET) + ((size_t)((l * DB + b) * 6 + h) * 64) * 64 + lane;
#pragma unroll
    for (int d = 0; d < 64; ++d) { S[d] = s0[d * 64]; if ((d & 15) == 15) asm volatile("" ::: "memory"); }
    const float ng = c.in(I_RNG)[l * 384 + h * 64 + lane], nb = c.in(I_RNB)[l * 384 + h * 64 + lane];
#pragma unroll 1
    for (int t = 0; t < DSEQ; ++t) {
        const int row = TP + b * DSEQ + t;
        const bf16* pr = c.PROJ() + (size_t)row * NPROJ;
        const float cs = c.ROPE()[(2048 + t) * 32 + f], sn = c.ROPE()[2052 * 32 + (2048 + t) * 32 + f];
        const float ka = bflo((unsigned)pr[C_RK + h * 64 + f]), kb = bflo((unsigned)pr[C_RK + h * 64 + 32 + f]);
        const float qa = bflo((unsigned)pr[C_RQ + h * 64 + f]), qb = bflo((unsigned)pr[C_RQ + h * 64 + 32 + f]);
        const float kk = (lane < 32 ? ka * cs - kb * sn : ka * sn + kb * cs) * 0.125f;
        const float qq = lane < 32 ? qa * cs - qb * sn : qa * sn + qb * cs;
        const float vv = bflo((unsigned)pr[C_RV + h * 64 + lane]), gt = bflo((unsigned)pr[C_RG + h * 64 + lane]);
        float o = 0.f;
#pragma unroll
        for (int d = 0; d < 64; ++d) { const float kd = rdl(kk, d), qd = rdl(qq, d); S[d] = fmaf(gamma, S[d], kd * vv); o = fmaf(qd, S[d], o); }
        const float mu = wave_sum(o) * (1.f / 64.f), dv = o - mu, rstd = rsqrtf(wave_sum(dv * dv) * (1.f / 64.f) + EPS);
        c.XN()[(size_t)row * D + h * 64 + lane] = (bf16)f2bf((dv * rstd * ng + nb) * silu(gt));
    }
    float* so = c.out() + O_RETS + ((size_t)(l * DB + b) * 6 + h) * 4096 + lane;
#pragma unroll
    for (int d = 0; d < 64; ++d) { so[d * 64] = S[d]; if ((d & 15) == 15) asm volatile("" ::: "memory"); }
}
__device__ __forceinline__ void gla_sample_wave(const Ctx& c, int l, int b, int h) {
    const int lane = c.lane, l2 = 64 + (lane & 31), dl = lane < 48 ? lane : 47;
    float S1[48], S2[48];
    const float* s0 = c.in(I_SGLA) + ((size_t)((l * DB + b) * 4 + h) * 48) * 96;
#pragma unroll
    for (int d = 0; d < 48; ++d) { S1[d] = s0[d * 96 + lane]; S2[d] = s0[d * 96 + l2]; if ((d & 3) == 3) asm volatile("" ::: "memory"); }
    const float* gwp = c.in(I_GGW) + (size_t)(l * 16) * 192 + h * 48 + dl;
    const float gbd = c.in(I_GGB)[l * 192 + h * 48 + dl];
    const float n1 = c.in(I_GNG)[l * 96 + lane], n2 = c.in(I_GNG)[l * 96 + l2];
#pragma unroll 1
    for (int t = 0; t < DSEQ; ++t) {
        const int row = TP + b * DSEQ + t;
        const bf16* pr = c.PROJ() + (size_t)row * NPROJ;
        const u32x4 g0 = *(const u32x4*)(pr + C_GLR), g1 = *(const u32x4*)(pr + C_GLR + 8);
        const float gl[16] = {bflo(g0.x), bfhi(g0.x), bflo(g0.y), bfhi(g0.y), bflo(g0.z), bfhi(g0.z), bflo(g0.w), bfhi(g0.w),
                              bflo(g1.x), bfhi(g1.x), bflo(g1.y), bfhi(g1.y), bflo(g1.z), bfhi(g1.z), bflo(g1.w), bfhi(g1.w)};
        float x = gbd;
#pragma unroll
        for (int r = 0; r < 16; ++r) x = fmaf(gl[r], gwp[r * 192], x);
        const float al = __expf((fminf(x, 0.f) - __logf(1.f + __expf(-fabsf(x)))) * (1.f / 16.f));
        const float kk = lane < 48 ? bflo((unsigned)pr[C_GK + h * 48 + dl]) : 0.f;
        const float qq = lane < 48 ? bflo((unsigned)pr[C_GQ + h * 48 + dl]) * 0.14433756729740643f : 0.f;
        const float v1 = bflo((unsigned)pr[C_GV + h * 96 + lane]), v2 = bflo((unsigned)pr[C_GV + h * 96 + l2]);
        const float t1 = bflo((unsigned)pr[C_GG + h * 96 + lane]), t2 = bflo((unsigned)pr[C_GG + h * 96 + l2]);
        float o1 = 0.f, o2 = 0.f;
#pragma unroll
        for (int d = 0; d < 48; ++d) { const float ad = rdl(al, d), kd = rdl(kk, d), qd = rdl(qq, d);
            S1[d] = fmaf(ad, S1[d], kd * v1); o1 = fmaf(qd, S1[d], o1); S2[d] = fmaf(ad, S2[d], kd * v2); o2 = fmaf(qd, S2[d], o2); }
        const float rs = rsqrtf(wave_sum(o1 * o1 + (lane < 32 ? o2 * o2 : 0.f)) * (1.f / 96.f) + EPS);
        bf16* dst = c.XN() + (size_t)row * D + 640 + h * 96;
        dst[lane] = (bf16)f2bf(o1 * rs * n1 * silu(t1));
        if (lane < 32) dst[l2] = (bf16)f2bf(o2 * rs * n2 * silu(t2));
    }
    float* so = c.out() + O_GLAS + ((size_t)(l * DB + b) * 4 + h) * 4608;
#pragma unroll
    for (int d = 0; d < 48; ++d) { so[d * 96 + lane] = S1[d]; if (lane < 32) so[d * 96 + l2] = S2[d]; if ((d & 3) == 3) asm volatile("" ::: "memory"); }
}

struct OneUnit {
    int pm, pn;
    __device__ bool next(int i, pg8::Unit& u) const { if (i != 0) return false; u.pm = pm; u.pn = pn; u.ko = 0; return true; }
    __device__ __forceinline__ void a_ready(const pg8::Unit&) const {}
    __device__ __forceinline__ void done(const pg8::Unit&) const {}
};
#define MIX_QUEUE_BEGIN(NTASK, CTR) \
    volatile __attribute__((address_space(3))) unsigned* qw_ = (volatile __attribute__((address_space(3))) unsigned*)((PG8_LAS unsigned char*)L_las + 143360 + 64); \
    unsigned* ctr_ = (unsigned*)c0_.ap->ws + (CTR); \
    int qi_ = 0; \
    for (int task = c0_.bx; task < (NTASK); ) { \
        Ctx c = c0_; asm volatile("" : "+v"(c.tid)); c.lane = c.tid & 63; c.wave = __builtin_amdgcn_readfirstlane(c.tid >> 6); \
        unsigned nxt_ = 0u; if (c.tid == 0) nxt_ = __hip_atomic_fetch_add(ctr_, 1u, __ATOMIC_RELAXED, __HIP_MEMORY_SCOPE_AGENT); \
        int r = task;
#define MIX_QUEUE_END() \
        __syncthreads(); \
        if (c.tid == 0) qw_[qi_] = nxt_ + (unsigned)c0_.G; \
        __syncthreads(); \
        task = (int)qw_[qi_]; qi_ ^= 1; }

__device__ __forceinline__ void mixA_phase(const Ctx& c0_, int l, float* L, PG8_LAS unsigned char* L_las) {
    constexpr int NS = NSEG - 1, NS5 = NSEG5 - 1;
    constexpr int NQ = 24, NG = NB * NS * 4, N5 = NB * NS5 * 2, NR = NB * NS * 6;
    MIX_QUEUE_BEGIN(NQ + NG + N5 + NR, 8192 + 64 * (2 * l))
        if (r < NQ) {
            pg8::Gemm g{c.XN(), c.W1T(), MR, NPROJ, D, D, 256}; OneUnit S{TP / 256 + r / 12, r % 12};
            pg8::EpiBf16<0> E{c.PROJ(), NPROJ, nullptr, 0, 0, 1.f};
            pg8::gemm_phase<pg8::EpiBf16<0>, OneUnit, true, true>(L_las, g, S, E); }
        else if ((r -= NQ) < NG) { const int h = r % 4, seg = (r / 4) % NS, b = r / (4 * NS); lin_task<true, true>(c, l, b, h, seg, L); }
        else if ((r -= NG) < N5) { const int oct = r % 2, seg = (r / 2) % NS5, b = r / (2 * NS5); s5_task<true>(c, l, false, b, oct, seg, L); }
        else { r -= N5; const int h = r % 6, seg = (r / 6) % NS, b = r / (6 * NS); lin_task<false, true>(c, l, b, h, seg, L); }
    MIX_QUEUE_END()
}
__device__ __forceinline__ void mixC_phase(const Ctx& c0_, int l, float* L, PG8_LAS unsigned char* L_las) {
    constexpr int NG = NB * NSEG * 4, N5 = NB * NSEG5 * 2, NR = NB * NSEG * 6;
    constexpr int M5 = (TS / 64) * 2, MG = DB * 4 / 8, MRT = DB * 6 / 8;
    MIX_QUEUE_BEGIN(NG + N5 + NR + M5 + MG + MRT, 8192 + 64 * (2 * l + 1))
        if (r < NG) { const int h = r % 4, seg = (r / 4) % NSEG, b = r / (4 * NSEG); lin_task<true, false>(c, l, b, h, seg, L); }
        else if ((r -= NG) < N5) { const int oct = r % 2, seg = (r / 2) % NSEG5, b = r / (2 * NSEG5); s5_task<false>(c, l, false, b, oct, seg, L); }
        else if ((r -= N5) < NR) { const int h = r % 6, seg = (r / 6) % NSEG, b = r / (6 * NSEG); lin_task<false, false>(c, l, b, h, seg, L); }
        else if ((r -= NR) < M5) { s5_task<false>(c, l, true, r / 2, r % 2, 0, L); }
        else if ((r -= M5) < MG) { const int q = 8 * r + c.wave; gla_sample_wave(c, l, q / 4, q % 4); }
        else { r -= MG; const int q = 8 * r + c.wave; ret_sample_wave(c, l, q / 6, q % 6); }
    MIX_QUEUE_END()
}

__device__ __forceinline__ void act_phase(const Ctx& c, int l) {
    constexpr int JB = DFF / 8, RB = MR / 16;
    const int gt = c.bx * 512 + c.tid, ngt = c.G * 512;
    const float* cw = c.in(I_FCW) + (size_t)l * 3 * DFF; const float* cb = c.in(I_FCB) + (size_t)l * DFF;
    for (int it = gt; it < JB * RB; it += ngt) {
        const int jb = it % JB, rb = it / JB, j0 = 8 * jb, r0 = 16 * rb;
        float w0[8], w1[8], w2[8], bb[8];
#pragma unroll
        for (int e = 0; e < 8; ++e) { w0[e] = cw[j0 + e]; w1[e] = cw[DFF + j0 + e]; w2[e] = cw[2 * DFF + j0 + e]; bb[e] = cb[j0 + e]; }
        float x2[8], x1[8];
        const bool sample = r0 >= TP;
        for (int rr = 0; rr < 16; ++rr) {
            const int r = r0 + rr;
            const int t = sample ? ((r - TP) & 3) : (r & (SEQ - 1));
            if (rr == 0 || t == 0) {
                if (t >= 2) { const u32x4 a = *(const u32x4*)(c.ABUF() + (size_t)(r - 2) * DFF + j0), bq = *(const u32x4*)(c.ABUF() + (size_t)(r - 1) * DFF + j0);
                    x2[0] = bflo(a.x); x2[1] = bfhi(a.x); x2[2] = bflo(a.y); x2[3] = bfhi(a.y); x2[4] = bflo(a.z); x2[5] = bfhi(a.z); x2[6] = bflo(a.w); x2[7] = bfhi(a.w);
                    x1[0] = bflo(bq.x); x1[1] = bfhi(bq.x); x1[2] = bflo(bq.y); x1[3] = bfhi(bq.y); x1[4] = bflo(bq.z); x1[5] = bfhi(bq.z); x1[6] = bflo(bq.w); x1[7] = bfhi(bq.w); }
                else {
                    if (sample) { const float* cs = c.in(I_SCONV) + ((size_t)(l * DB + ((r - TP) >> 2)) * 2) * DFF + j0;
#pragma unroll
                        for (int e = 0; e < 8; ++e) { x2[e] = cs[e]; x1[e] = cs[DFF + e]; } }
                    else {
#pragma unroll
                        for (int e = 0; e < 8; ++e) { x2[e] = 0.f; x1[e] = 0.f; } } }
            }
            const u32x4 a = *(const u32x4*)(c.ABUF() + (size_t)r * DFF + j0);
            const u32x4 gq = *(const u32x4*)(c.GATE() + (size_t)r * DFF + j0);
            const float x0[8] = {bflo(a.x), bfhi(a.x), bflo(a.y), bfhi(a.y), bflo(a.z), bfhi(a.z), bflo(a.w), bfhi(a.w)};
            const float gv[8] = {bflo(gq.x), bfhi(gq.x), bflo(gq.y), bfhi(gq.y), bflo(gq.z), bfhi(gq.z), bflo(gq.w), bfhi(gq.w)};
            float o[8];
#pragma unroll
            for (int e = 0; e < 8; ++e) { const float cv = bb[e] + w0[e] * x2[e] + w1[e] * x1[e] + w2[e] * x0[e]; o[e] = gelu_tanh(cv) * gv[e]; x2[e] = x1[e]; x1[e] = x0[e]; }
            u32x4 wv; wv.x = pk2(o[0], o[1]); wv.y = pk2(o[2], o[3]); wv.z = pk2(o[4], o[5]); wv.w = pk2(o[6], o[7]);
            *(u32x4*)(c.GATE() + (size_t)r * DFF + j0) = wv;
        }
    }
}

#define XB_TMO      128
#define XB_XCNT(j)  (256  + 64 * (j))
#define XB_XSUB(j)  (1280 + 64 * (j))
#define XB_XGEN(j)  (2304 + 64 * (j))
#define XB_TOP      3328
#define XB_TOPGEN   3392
#define XCD_BAR_WORDS 3456
#define XB_SPIN_CAP (1u << 18)

__device__ __forceinline__ unsigned xb_ld(unsigned* p)              { return __hip_atomic_load(p, __ATOMIC_RELAXED, __HIP_MEMORY_SCOPE_AGENT); }
__device__ __forceinline__ unsigned xb_add(unsigned* p, unsigned v) { return __hip_atomic_fetch_add(p, v, __ATOMIC_RELAXED, __HIP_MEMORY_SCOPE_AGENT); }
__device__ __forceinline__ unsigned xb_xcc_id() { return (unsigned)__builtin_amdgcn_s_getreg((3 << 11) | 20) & 0xFu; }
#define XB_SPIN(cond, bar) do { unsigned _sp = 0; while (cond) { __builtin_amdgcn_s_sleep(1); \
    if ((++_sp & 255u) == 0u) { if (xb_ld(&(bar)[XB_TMO])) break; if (_sp > XB_SPIN_CAP) { atomicAdd(&(bar)[XB_TMO], 1u); break; } } } } while (0)

struct XcdBarrier {
    unsigned* bar; unsigned x;
    volatile __attribute__((address_space(3))) unsigned* st;
};

__device__ __forceinline__ XcdBarrier xcd_barrier_post(unsigned* bar, volatile __attribute__((address_space(3))) unsigned* st) {
    XcdBarrier b; b.bar = bar; b.x = xb_xcc_id(); b.st = st;
    if (threadIdx.x == 0) (void)xb_add(&bar[XB_XCNT(b.x)], 1u);
    return b;
}
__device__ __forceinline__ void xcd_barrier_complete(unsigned* bar, unsigned x, unsigned& nloc, unsigned& nx) {
    const unsigned G = gridDim.x * gridDim.y * gridDim.z;
    unsigned sum, cnt, mine, sp = 0u;
    for (;;) {
        sum = 0u; cnt = 0u; mine = 0u;
#pragma unroll
        for (unsigned j = 0; j < 16; ++j) { const unsigned c = xb_ld(&bar[XB_XCNT(j)]); sum += c; cnt += (c > 0u) ? 1u : 0u; mine = (j == x) ? c : mine; }
        if (sum == G) break;
        __builtin_amdgcn_s_sleep(1);
        if ((++sp & 255u) == 0u) { if (xb_ld(&bar[XB_TMO])) break; if (sp > XB_SPIN_CAP) { atomicAdd(&bar[XB_TMO], 1u); break; } }
    }
    nloc = mine > 0u ? mine : 1u; nx = cnt > 0u ? cnt : 1u;
}

__device__ __forceinline__ void xcd_barrier(const XcdBarrier& b) {
    asm volatile("s_waitcnt vmcnt(0)" ::: "memory");
    __syncthreads();
    if (threadIdx.x == 0) {
        unsigned* bar = b.bar;
        __builtin_amdgcn_s_waitcnt(0);
        unsigned nloc = b.st[0], nx = b.st[1];
        if (nloc == 0u) { xcd_barrier_complete(bar, b.x, nloc, nx); b.st[0] = nloc; b.st[1] = nx; }
        const unsigned old = xb_add(&bar[XB_XSUB(b.x)], 1u);
        const unsigned gen = old / nloc;
        if (old + 1u == (gen + 1u) * nloc) {
            __builtin_amdgcn_fence(__ATOMIC_RELEASE, "agent");
            asm volatile("s_waitcnt vmcnt(0)" ::: "memory");
            const unsigned og = xb_add(&bar[XB_TOP], 1u);
            const unsigned tg = og / nx;
            if (og + 1u == (tg + 1u) * nx) xb_add(&bar[XB_TOPGEN], 1u);
            else XB_SPIN(xb_ld(&bar[XB_TOPGEN]) == tg, bar);
            __builtin_amdgcn_fence(__ATOMIC_ACQUIRE, "agent");
            xb_add(&bar[XB_XGEN(b.x)], 1u);
            asm volatile("s_waitcnt vmcnt(0)" ::: "memory");
        } else {
            XB_SPIN(xb_ld(&bar[XB_XGEN(b.x)]) == gen, bar);
            __builtin_amdgcn_fence(__ATOMIC_ACQUIRE, "agent");
            asm volatile("s_waitcnt vmcnt(0)" ::: "memory");
        }
    }
    __syncthreads();
}

#define gsync(B) xcd_barrier(B)
template <int l>
__device__ __forceinline__ void layer_body(float* L, PG8_LAS unsigned char* ring, const XcdBarrier& grid) {

        { const Ctx c = mkctx(); prep_phase(c, l, L); }
        gsync(grid);
        {
            const Ctx c = mkctx();
            pg8::Gemm g{c.XN(), c.W1T(), TP, NPROJ, D, D, 256}; pg8::StaticOrder S; S.init(TP, NPROJ, c.G, c.bx);
            pg8::EpiBf16<0> E{c.PROJ(), NPROJ, nullptr, 0, 0, 1.f};
            pg8::gemm_phase<pg8::EpiBf16<0>, pg8::StaticOrder, true, true>(ring, g, S, E);
        }
        gsync(grid);
        if (NSEG > 1) { { const Ctx c = mkctx(); mixA_phase(c, l, L, ring); } gsync(grid); }
        { const Ctx c = mkctx(); mixC_phase(c, l, L, ring); }
        gsync(grid);
        {
            const Ctx c = mkctx();
            int kglu = 256; asm volatile("" : "+s"(kglu)); pg8::Gemm g{c.Y5(), c.GLUT(), MR, 256, 256, kglu, 256}; pg8::StaticOrder S; S.init(MR, 256, c.G, c.bx);
            EpiGlu E{c.Y5(), c.in(I_GLUB) + l * 256, c.XN()};
            pg8::gemm_phase<EpiGlu, pg8::StaticOrder, true, true>(ring, g, S, E);
        }
        gsync(grid);
        {
            const Ctx c = mkctx();
            pg8::Gemm g{c.XN(), c.W2T(), TP, D, D, D, 256}; pg8::StaticOrder S; S.init(TP, D, c.G, c.bx);
            EpiRes E{l == 0 ? c.in(I_XP) : (const float*)c.out(), l == 0 ? c.in(I_XS) : (const float*)(c.out() + (size_t)TP * D), c.out()};
            pg8::gemm_phase<EpiRes, pg8::StaticOrder, true, true>(ring, g, S, E);
            int ks_ = 256; asm volatile("" : "+s"(ks_));
            pg8::Gemm gt{c.XN(), c.W2T(), MR, D, D, ks_, 256}; TailOrder ST_; ST_.init(D / 256, c.G, c.bx);
            EpiPart EP{c.PART()};
            pg8::gemm_phase<EpiPart, TailOrder, true, true>(ring, gt, ST_, EP);
        }
        gsync(grid);
        { const Ctx c = mkctx(); const float* gg = c.in(I_NFG) + (size_t)l * D; float* xo = c.out(); bf16* xn = c.XN();
          for (int m = c.gw; m < TP; m += 2 * c.ngw) { const int m1 = m + c.ngw;
              if (m1 < TP) norm_rows2_bf16(xo + (size_t)m * D, xo + (size_t)m1 * D, gg, xn + (size_t)m * D, xn + (size_t)m1 * D, c.lane);
              else norm_row_bf16(xo + (size_t)m * D, gg, xn + (size_t)m * D, c.lane); }
          for (int m = TP + c.gw; m < MR; m += c.ngw)
              norm_row_bf16(l == 0 ? c.in(I_XS) + (size_t)(m - TP) * D : (const float*)(xo + (size_t)m * D), gg, xn + (size_t)m * D, c.lane, c.PART() + (size_t)(m - TP) * D, D / 256, xo + (size_t)m * D); }
        gsync(grid);
        {
            const Ctx c = mkctx();
            pg8::Gemm g{c.XN() - 2 * D, c.W3T(), 67 * 256, NUP, D, D, 254}; pg8::StaticOrder S; S.init(67 * 256, NUP, c.G, c.bx);
            EpiAct E{c.GATE(), c.out() + O_CONVP + (size_t)l * NB * 2 * DFF, c.out() + O_CONVS + (size_t)l * DB * 2 * DFF,
                     c.in(I_FCW) + (size_t)l * 3 * DFF, c.in(I_FCB) + (size_t)l * DFF, c.in(I_SCONV) + (size_t)l * DB * 2 * DFF, (PG8_LAS float*)(ring + 131072)};
            pg8::gemm_phase<EpiAct, pg8::StaticOrder, true, true>(ring, g, S, E);
        }
        gsync(grid);
        {
            const Ctx c = mkctx();
            pg8::Gemm g{c.GATE(), c.W4T(), TP, D, DFF, DFF, 256}; pg8::StaticOrder S; S.init(TP, D, c.G, c.bx);
            EpiRes E{c.out(), c.out() + (size_t)TP * D, c.out()};
            pg8::gemm_phase<EpiRes, pg8::StaticOrder, true, true>(ring, g, S, E);
            int ks_ = 256; asm volatile("" : "+s"(ks_));
            pg8::Gemm gt{c.GATE(), c.W4T(), MR, D, DFF, ks_, 256}; TailOrder ST_; ST_.init(DFF / 256, c.G, c.bx);
            EpiPart EP{c.PART()};
            pg8::gemm_phase<EpiPart, TailOrder, true, true>(ring, gt, ST_, EP);
        }
        gsync(grid);
    }

__global__ void __launch_bounds__(512, 2) fwd(Args args) {
    extern __shared__ __attribute__((aligned(16))) unsigned char lds[];
    float* L = (float*)lds;
    PG8_LAS unsigned char* ring = (PG8_LAS unsigned char*)lds;

    volatile __attribute__((address_space(3))) unsigned* bst = (volatile __attribute__((address_space(3))) unsigned*)((PG8_LAS unsigned char*)lds + 143360);
    if (threadIdx.x < 2) bst[threadIdx.x] = 0u;
    __syncthreads();
    unsigned* barw; { KArgs kp = (KArgs)__builtin_amdgcn_kernarg_segment_ptr(); barw = (unsigned*)kp->ws; }
    const XcdBarrier grid = xcd_barrier_post(barw, bst);
    cg::this_grid().sync();
    layer_body<0>(L, ring, grid);
    layer_body<1>(L, ring, grid);
    { const Ctx c = mkctx(); const float* gg = c.in(I_NFIN); float* xo = c.out();
      for (int m = c.gw; m < TP; m += 2 * c.ngw) { const int m1 = m + c.ngw;
          if (m1 < TP) norm_rows2_f32(xo + (size_t)m * D, xo + (size_t)m1 * D, gg, c.lane); else norm_row_f32(xo + (size_t)m * D, gg, c.lane); }
      for (int m = TP + c.gw; m < MR; m += c.ngw) norm_row_f32(xo + (size_t)m * D, gg, c.lane, c.PART() + (size_t)(m - TP) * D, DFF / 256); }
}
}

extern "C" void kernel_launch(void* const* d_in, const int* in_sizes, int n_in, void* d_out, int out_size, void* d_ws, size_t ws_size, hipStream_t stream) {
    static int grid = 0;
    if (grid == 0) {
        if (n_in != mk::N_IN || out_size != (int)mk::O_END || ws_size < mk::WS_END) { fprintf(stderr, "kernel_launch: unexpected sizes n_in %d out %d ws %zu (need %zu)\n", n_in, out_size, ws_size, (size_t)mk::WS_END); }
        int dev = 0, cus = 0, per_cu = 0;
        hipGetDevice(&dev); hipDeviceGetAttribute(&cus, hipDeviceAttributeMultiprocessorCount, dev);
        hipFuncSetAttribute((const void*)mk::fwd, hipFuncAttributeMaxDynamicSharedMemorySize, mk::LDS_BYTES);
        hipOccupancyMaxActiveBlocksPerMultiprocessor(&per_cu, (const void*)mk::fwd, 512, mk::LDS_BYTES);
        if (per_cu < 1) { fprintf(stderr, "kernel_launch: occupancy query says %d blocks per CU\n", per_cu); per_cu = 1; }
        grid = cus * 1;
        (void)hipGetLastError();
    }
    (void)hipMemsetAsync(d_ws, 0, 65536, stream);
    mk::Args a{};
    for (int i = 0; i < mk::N_IN; ++i) a.in[i] = (const float*)d_in[i];
    a.out = (float*)d_out; a.ws = (unsigned char*)d_ws;
    void* kargs[] = {&a};
    hipError_t e = hipLaunchCooperativeKernel((const void*)mk::fwd, dim3(grid), dim3(512), kargs, mk::LDS_BYTES, stream);
    if (e != hipSuccess) fprintf(stderr, "cooperative launch failed: %s (grid %d)\n", hipGetErrorString(e), grid);
}
```

```cpp
#include <hip/hip_runtime.h>
#include <hip/hip_cooperative_groups.h>
#include <cstdio>
#include <cstdint>
namespace cg = cooperative_groups;
namespace pg8 {
#define PG8_LAS __attribute__((address_space(3)))
typedef unsigned short bf16_t;
typedef short bf16x8 __attribute__((ext_vector_type(8)));
typedef float f32x4 __attribute__((ext_vector_type(4)));
typedef unsigned u32x4 __attribute__((ext_vector_type(4)));
constexpr int BM = 256, BK = 64, HALF = 128, HTB = HALF * BK * 2  , STAGE_BYTES = 8 * HTB, NXCD = 8, WGM = 8;

__host__ __device__ __forceinline__ int lds_byte(int r, int c) { const int st = (r >> 4) * 2 + (c >> 5), rr = r & 15, cc = c & 31, ob = rr * 64 + cc * 2; return st * 1024 + (ob ^ (((ob >> 9) & 1) << 5)); }
__host__ __device__ __forceinline__ void stage_rc(int b, int& R, int& C) { const int st = b / 1024, sb = b % 1024, swz = sb ^ (((sb >> 9) & 1) << 5); R = (st >> 1) * 16 + swz / 64; C = (st & 1) * 32 + (swz % 64) / 2; }
__host__ __device__ __forceinline__ int perm32(int rho) { const int n = rho >> 4, i = rho & 15; return 8 * (i >> 2) + 4 * n + (i & 3); }

struct Unit { int pm, pn, ko; };
struct Gemm { const bf16_t* A; const bf16_t* Bt; int M, N, K, KL, MS; };

struct StaticOrder {
    int nM, nN, nwg, G, c;
    __host__ __device__ void init(int M, int N, int G_, int c_) { nM = M / BM; nN = N / BM; nwg = nM * nN; G = G_; c = c_; }
    __host__ __device__ bool next(int i, Unit& u) const {
        const long L = (long)i * G + c; if (L >= nwg) return false;
        int wgid = (int)L; { const int q = nwg / NXCD, r = nwg % NXCD, xcd = wgid % NXCD, off = wgid / NXCD; wgid = (xcd < r ? xcd * (q + 1) : r * (q + 1) + (xcd - r) * q) + off; }
        const int nig = WGM * nN, gid = wgid / nig, fm = gid * WGM, gsz = (nM - fm) < WGM ? (nM - fm) : WGM;
        u.pm = fm + ((wgid % nig) % gsz); u.pn = (wgid % nig) / gsz; u.ko = 0; return true;
    }
    __device__ __forceinline__ void a_ready(const Unit&) const {}
    __device__ __forceinline__ void done(const Unit&) const {}
};

__device__ __forceinline__ unsigned cvt_pk_bf16(float lo, float hi) { unsigned r; asm volatile("v_cvt_pk_bf16_f32 %0, %1, %2" : "=v"(r) : "v"(lo), "v"(hi)); return r; }
typedef float f32x2 __attribute__((ext_vector_type(2)));
__device__ __forceinline__ f32x2 gelu_pk(f32x2 v) {
    const f32x2 av = __builtin_elementwise_abs(v), d = av * 0.2316418882f + 1.0f;
    f32x2 t; t.x = __builtin_amdgcn_rcpf(d.x); t.y = __builtin_amdgcn_rcpf(d.y);
    f32x2 q = t * 0.5307027145f + (-0.7265760135f); q = q * t + 0.7107068705f; q = q * t + (-0.142248368f); q = q * t + 0.127414796f; q = q * t;
    const f32x2 s = (v * v) * (-0.72134752044f);
    f32x2 e; e.x = __builtin_amdgcn_exp2f(s.x); e.y = __builtin_amdgcn_exp2f(s.y);
    const f32x2 m = v * (q * e), r = v - m;
    f32x2 o; o.x = v.x < 0.f ? m.x : r.x; o.y = v.y < 0.f ? m.y : r.y; return o;
}

template <int ACT  > struct EpiBf16 {
    static constexpr bool PERM = true, AFTER_DRAIN = false; static_assert(ACT == 0 || ACT == 1, "EpiBf16: ACT is 0 (none) or 1 (gelu_pk)");
    bf16_t* O; int ldc; const float* bias; int split_cols; size_t split_stride; float scale0;
    __device__ __forceinline__ void operator()(const f32x4 (&acc)[2][2][4][2], const Unit& u, int wr, int wc, int fr, int fq) const {
        const int row0 = u.pm * BM + wr * 64 + fr; int colt = u.pn * BM; bf16_t* base = O;
        float sc = 1.f; if (split_cols) { const int t = colt / split_cols; base += (size_t)t * split_stride; colt -= t * split_cols; if (t == 0) sc = scale0; }
        const int col0 = colt + wc * 32 + 8 * fq, bcol0 = u.pn * BM + wc * 32 + 8 * fq;
        f32x4 bv[2][2];
#pragma unroll
        for (int bj = 0; bj < 2; ++bj)
#pragma unroll
            for (int n = 0; n < 2; ++n) bv[bj][n] = bias ? *(const f32x4*)(bias + bcol0 + bj * HALF + 4 * n) : (f32x4){0.f, 0.f, 0.f, 0.f};
#pragma unroll
        for (int ai = 0; ai < 2; ++ai)
#pragma unroll
            for (int m = 0; m < 4; ++m) { bf16_t* rowp = base + (size_t)(row0 + ai * HALF + m * 16) * ldc + col0;
#pragma unroll
                for (int bj = 0; bj < 2; ++bj) { f32x4 v0 = acc[ai][bj][m][0] + bv[bj][0], v1 = acc[ai][bj][m][1] + bv[bj][1];
                    if (ACT == 1) { f32x2 a = gelu_pk((f32x2){v0[0], v0[1]}), b = gelu_pk((f32x2){v0[2], v0[3]}), c = gelu_pk((f32x2){v1[0], v1[1]}), d = gelu_pk((f32x2){v1[2], v1[3]});
                        v0 = (f32x4){a.x, a.y, b.x, b.y}; v1 = (f32x4){c.x, c.y, d.x, d.y}; }
                    v0 = v0 * sc; v1 = v1 * sc; u32x4 w; w.x = cvt_pk_bf16(v0[0], v0[1]); w.y = cvt_pk_bf16(v0[2], v0[3]); w.z = cvt_pk_bf16(v1[0], v1[1]); w.w = cvt_pk_bf16(v1[2], v1[3]);
                    *(u32x4*)(rowp + bj * HALF) = w; } }
    }
};
template <class Epi, class Sched, bool ALIGN_EPI = false, bool SP2 = false>
__device__ __forceinline__ void gemm_phase(PG8_LAS unsigned char* lds, const Gemm g, const Sched& S, const Epi& E) {
    int tid_ = threadIdx.x; asm volatile("" : "+v"(tid_)); const int tid = tid_, wid = __builtin_amdgcn_readfirstlane(tid >> 6), lane = tid & 63, wr = wid >> 2, wc = wid & 3, fr = lane & 15, fq = lane >> 4;
    const int K = g.K, nt = g.KL / BK;
    unsigned voffA[2], voffB[2];
#pragma unroll
    for (int i = 0; i < 2; ++i) { int R, C; stage_rc(tid * 16 + i * 8192, R, C); const int Rb = Epi::PERM ? ((R & ~31) + perm32(R & 31)) : R;
        voffA[i] = (unsigned)(R * K + C) * 2u; voffB[i] = (unsigned)(Rb * K + C) * 2u; }
    const size_t kstep = (size_t)(BK * 2);
    const size_t hstep = (size_t)HALF * K * 2;
    const size_t tstep = 2 * hstep;
    const size_t tstepA = (size_t)g.MS * K * 2;
    const unsigned ldsw = (unsigned)wid * 1024u;
    const int aoff = lds_byte(wr * 64 + fr, fq * 8), boff = lds_byte(wc * 32 + fr, fq * 8);
#define PG8_SA(b, h) (((b) * 2 + (h)) * HTB)
#define PG8_SB(b, h) ((4 + (b) * 2 + (h)) * HTB)
#define PG8_STAGE(bufoff, gbase, voff) do { _Pragma("unroll") for (int _i = 0; _i < 2; ++_i) \
        __builtin_amdgcn_global_load_lds((const unsigned*)((const char*)(gbase) + (voff)[_i]), (PG8_LAS unsigned*)(lds + (bufoff) + ldsw + _i * 8192), 16, 0, 0); } while (0)
#define PG8_LDA(dst, b, h) do { _Pragma("unroll") for (int m = 0; m < 4; ++m) _Pragma("unroll") for (int k = 0; k < 2; ++k) dst[m][k] = *(const PG8_LAS bf16x8*)(lds + PG8_SA(b, h) + aoff + m * 2048 + k * 1024); } while (0)
#define PG8_LDB(dst, b, h) do { _Pragma("unroll") for (int n = 0; n < 2; ++n) _Pragma("unroll") for (int k = 0; k < 2; ++k) dst[n][k] = *(const PG8_LAS bf16x8*)(lds + PG8_SB(b, h) + boff + n * 2048 + k * 1024); } while (0)
#define PG8_MMA(ai, bj, At, Bt) do { __builtin_amdgcn_s_setprio(1); _Pragma("unroll") for (int m = 0; m < 4; ++m) _Pragma("unroll") for (int n = 0; n < 2; ++n) _Pragma("unroll") for (int k = 0; k < 2; ++k) \
        acc[ai][bj][m][n] = __builtin_amdgcn_mfma_f32_16x16x32_bf16(Bt[n][k], At[m][k], acc[ai][bj][m][n], 0, 0, 0); __builtin_amdgcn_s_setprio(0); } while (0)
#define PG8_WAIT_V(n) asm volatile("s_waitcnt vmcnt(" #n ")" ::: "memory")
#define PG8_WAIT_L(n) asm volatile("s_waitcnt lgkmcnt(" #n ")" ::: "memory")
#define PG8_BAR __builtin_amdgcn_s_barrier()
#define PG8_SCHED __builtin_amdgcn_sched_barrier(0)
    Unit cur, nxt; int ui = 0;
    if (!S.next(0, cur)) return;
    f32x4 acc[2][2][4][2];
#pragma unroll
    for (int a = 0; a < 2; ++a)
#pragma unroll
        for (int b = 0; b < 2; ++b)
#pragma unroll
            for (int m = 0; m < 4; ++m)
#pragma unroll
                for (int n = 0; n < 2; ++n) acc[a][b][m][n] = (f32x4){0.f, 0.f, 0.f, 0.f};
    bf16x8 At[4][2], B0[2][2], B1[2][2];
    const char* cA = (const char*)g.A + (size_t)cur.pm * tstepA + (size_t)cur.ko * 2; const char* cB = (const char*)g.Bt + (size_t)cur.pn * tstep + (size_t)cur.ko * 2;
    S.a_ready(cur);
    if constexpr (SP2) {
        PG8_STAGE(PG8_SB(0, 0), cB, voffB); PG8_STAGE(PG8_SB(0, 1), cB + hstep, voffB); PG8_STAGE(PG8_SA(0, 0), cA, voffA); PG8_STAGE(PG8_SA(0, 1), cA + hstep, voffA);
        if (wr == 1) PG8_BAR;
        PG8_WAIT_V(2); PG8_BAR;
        PG8_STAGE(PG8_SB(1, 0), cB + kstep, voffB); PG8_STAGE(PG8_SA(1, 0), cA + kstep, voffA); PG8_STAGE(PG8_SB(1, 1), cB + hstep + kstep, voffB);
        PG8_WAIT_V(6); PG8_BAR;
    } else {
        PG8_STAGE(PG8_SB(0, 0), cB, voffB); PG8_STAGE(PG8_SA(0, 0), cA, voffA); PG8_STAGE(PG8_SB(0, 1), cB + hstep, voffB); PG8_STAGE(PG8_SA(0, 1), cA + hstep, voffA);
        if (wr == 1) PG8_BAR;
        PG8_WAIT_V(4); PG8_BAR;
        PG8_STAGE(PG8_SB(1, 0), cB + kstep, voffB); PG8_STAGE(PG8_SA(1, 0), cA + kstep, voffA); PG8_STAGE(PG8_SB(1, 1), cB + hstep + kstep, voffB);
        PG8_WAIT_V(6); PG8_BAR;
    }
    for (;;) {
        const bool has_next = S.next(ui + 1, nxt);
        const char* nA = has_next ? (const char*)g.A + (size_t)nxt.pm * tstepA + (size_t)nxt.ko * 2 : cA; const char* nB = has_next ? (const char*)g.Bt + (size_t)nxt.pn * tstep + (size_t)nxt.ko * 2 : cB;
        for (int t = 0; t < nt; t += 2) {
            const bool last = (t == nt - 2);
            const char* a1 = cA + (size_t)(t + 1) * kstep;
            const char* a2 = last ? nA : cA + (size_t)(t + 2) * kstep; const char* b2 = last ? nB : cB + (size_t)(t + 2) * kstep;
            const char* a3 = a2 + kstep; const char* b3 = b2 + kstep;
            if (last && has_next) S.a_ready(nxt);
            if constexpr (SP2) {
            PG8_LDB(B0, 0, 0); PG8_LDB(B1, 0, 1); PG8_SCHED; PG8_LDA(At, 0, 0); PG8_STAGE(PG8_SA(1, 1), a1 + hstep, voffA);
            PG8_WAIT_V(8); PG8_WAIT_L(0); PG8_BAR; PG8_MMA(0, 0, At, B0); PG8_MMA(0, 1, At, B1); PG8_BAR; PG8_SCHED;
            PG8_LDA(At, 0, 1); PG8_STAGE(PG8_SB(0, 0), b2, voffB); PG8_STAGE(PG8_SB(0, 1), b2 + hstep, voffB); PG8_STAGE(PG8_SA(0, 0), a2, voffA);
            PG8_WAIT_V(8); PG8_WAIT_L(0); PG8_BAR; PG8_MMA(1, 0, At, B0); PG8_MMA(1, 1, At, B1); PG8_BAR; PG8_SCHED;
            PG8_LDB(B0, 1, 0); PG8_LDB(B1, 1, 1); PG8_SCHED; PG8_LDA(At, 1, 0); PG8_STAGE(PG8_SA(0, 1), a2 + hstep, voffA);
            PG8_WAIT_V(8); PG8_WAIT_L(0); PG8_BAR; PG8_MMA(0, 0, At, B0); PG8_MMA(0, 1, At, B1); PG8_BAR; PG8_SCHED;
            PG8_LDA(At, 1, 1); PG8_STAGE(PG8_SB(1, 0), b3, voffB); PG8_STAGE(PG8_SB(1, 1), b3 + hstep, voffB); PG8_STAGE(PG8_SA(1, 0), a3, voffA);
            PG8_WAIT_V(8); PG8_WAIT_L(0); PG8_BAR; PG8_MMA(1, 0, At, B0); PG8_MMA(1, 1, At, B1); PG8_BAR; PG8_SCHED;
            } else {
            PG8_LDB(B0, 0, 0); PG8_SCHED; PG8_LDA(At, 0, 0); PG8_STAGE(PG8_SA(1, 1), a1 + hstep, voffA);
            PG8_WAIT_L(8); PG8_BAR; PG8_WAIT_L(0); PG8_MMA(0, 0, At, B0); PG8_BAR; PG8_SCHED;
            PG8_LDB(B1, 0, 1); PG8_STAGE(PG8_SB(0, 0), b2, voffB);
            PG8_BAR; PG8_WAIT_L(0); PG8_MMA(0, 1, At, B1); PG8_BAR;
            PG8_LDA(At, 0, 1); PG8_STAGE(PG8_SA(0, 0), a2, voffA);
            PG8_BAR; PG8_WAIT_L(0); PG8_MMA(1, 0, At, B0); PG8_BAR; PG8_SCHED;
            PG8_STAGE(PG8_SB(0, 1), b2 + hstep, voffB);
            PG8_WAIT_V(6); PG8_BAR; PG8_MMA(1, 1, At, B1); PG8_BAR;
            PG8_LDB(B0, 1, 0); PG8_SCHED; PG8_LDA(At, 1, 0); PG8_STAGE(PG8_SA(0, 1), a2 + hstep, voffA);
            PG8_WAIT_L(8); PG8_BAR; PG8_WAIT_L(0); PG8_MMA(0, 0, At, B0); PG8_BAR; PG8_SCHED;
            PG8_LDB(B1, 1, 1); PG8_STAGE(PG8_SB(1, 0), b3, voffB);
            PG8_BAR; PG8_WAIT_L(0); PG8_MMA(0, 1, At, B1); PG8_BAR;
            PG8_LDA(At, 1, 1); PG8_STAGE(PG8_SA(1, 0), a3, voffA);
            PG8_BAR; PG8_WAIT_L(0); PG8_MMA(1, 0, At, B0); PG8_BAR; PG8_SCHED;
            PG8_STAGE(PG8_SB(1, 1), b3 + hstep, voffB);
            PG8_WAIT_V(6); PG8_BAR; PG8_MMA(1, 1, At, B1); PG8_BAR;
            }
        }
        if constexpr (ALIGN_EPI) { if (wr == 0) PG8_BAR; }
        if constexpr (!Epi::AFTER_DRAIN) { E(acc, cur, wr, wc, fr, fq); S.done(cur); }
        if (!has_next) break;
#pragma unroll
        for (int a = 0; a < 2; ++a)
#pragma unroll
            for (int b = 0; b < 2; ++b)
#pragma unroll
                for (int m = 0; m < 4; ++m)
#pragma unroll
                    for (int n = 0; n < 2; ++n) acc[a][b][m][n] = (f32x4){0.f, 0.f, 0.f, 0.f};
        cur = nxt; cA = nA; cB = nB; ++ui;
        if constexpr (ALIGN_EPI) { if (wr == 1) PG8_BAR; }
    }
    PG8_WAIT_V(0);
    if constexpr (!ALIGN_EPI) { if (wr == 0) PG8_BAR; }
    PG8_BAR;
    if constexpr (Epi::AFTER_DRAIN) { E.fused(acc, cur, wr, wc, fr, fq, lds, wid, lane); S.done(cur); }
#undef PG8_SA
#undef PG8_SB
#undef PG8_STAGE
#undef PG8_LDA
#undef PG8_LDB
#undef PG8_MMA
#undef PG8_WAIT_V
#undef PG8_WAIT_L
#undef PG8_BAR
#undef PG8_SCHED
}
}

namespace mk {
typedef unsigned short bf16;
typedef float f32x4 __attribute__((ext_vector_type(4)));
typedef unsigned u32x4 __attribute__((ext_vector_type(4)));
typedef unsigned u32x2 __attribute__((ext_vector_type(2)));

constexpr int D = 1024, TP = 16384, TS = 512, MR = TP + TS;
constexpr int SEQ = 2048, NB = 8, DB = 128, DSEQ = 4;
constexpr int INC = 2960, NPROJ = 3072, DFF = 2816, NUP = 5632;
constexpr int NSEG = 8, LSEG = SEQ / NSEG;
constexpr int NSEG5 = 8, LSEG5 = SEQ / NSEG5, LOG2_LSEG5 = 8;
constexpr int C_RQ = 0, C_RK = 384, C_RV = 768, C_RG = 1152, C_SU = 1536, C_GQ = 1792, C_GK = 1984, C_GV = 2176, C_GG = 2560, C_GLR = 2944;
constexpr float EPS = 1e-6f;

constexpr size_t MiB = 1u << 20;
constexpr size_t WS_W1T = 1 * MiB, WS_W2T = 7 * MiB, WS_W3T = 9 * MiB, WS_W4T = 20 * MiB;
constexpr size_t WS_GLUT = 25 * MiB + 512 * 1024, WS_ROPE = 25 * MiB + 768 * 1024;
constexpr size_t WS_XN = 27 * MiB;
constexpr size_t WS_BIG = 60 * MiB;
constexpr size_t WS_ABUF = WS_BIG, WS_GATE = WS_BIG + (size_t)MR * DFF * 2;
constexpr size_t WS_SEG = 160 * MiB;
constexpr size_t WS_Y5 = 172 * MiB;
constexpr size_t WS_END = WS_GATE + (size_t)MR * DFF * 2;
static_assert(WS_END <= 256 * MiB, "workspace");
static_assert(WS_BIG + (size_t)MR * NPROJ * 2 <= WS_SEG, "proj vs seg");
constexpr size_t SEG_RET = 0;
constexpr size_t SEG_GLA = SEG_RET + (size_t)8 * 6 * (NSEG - 1) * 4096 * 4;
constexpr size_t SEG_S5 = SEG_GLA + (size_t)8 * 4 * (NSEG - 1) * 4672 * 4;
static_assert(WS_SEG + SEG_S5 + (size_t)8 * (NSEG5 - 1) * 2048 * 4 <= WS_Y5, "seg");

constexpr size_t O_Y = 0;
constexpr size_t O_RETP = (size_t)MR * D;
constexpr size_t O_RETS = O_RETP + (size_t)2 * NB * 6 * 4096;
constexpr size_t O_S5RP = O_RETS + (size_t)2 * DB * 6 * 4096;
constexpr size_t O_S5RS = O_S5RP + (size_t)2 * NB * 1024;
constexpr size_t O_S5IP = O_S5RS + (size_t)2 * DB * 1024;
constexpr size_t O_S5IS = O_S5IP + (size_t)2 * NB * 1024;
constexpr size_t O_GLAP = O_S5IS + (size_t)2 * DB * 1024;
constexpr size_t O_GLAS = O_GLAP + (size_t)2 * NB * 4 * 4608;
constexpr size_t O_CONVP = O_GLAS + (size_t)2 * DB * 4 * 4608;
constexpr size_t O_CONVS = O_CONVP + (size_t)2 * NB * 2 * DFF;
constexpr size_t O_END = O_CONVS + (size_t)2 * DB * 2 * DFF;
static_assert(O_END == 31088640, "out size");

constexpr int LDS_BYTES = 147456;

enum { I_XP = 0, I_XS, I_SRET, I_S5R, I_S5I, I_SGLA, I_SCONV, I_NMG, I_WIN, I_RNG, I_RNB, I_LRE, I_LIM, I_LDT, I_BRE, I_BIM, I_CRE, I_CIM, I_S5D,
       I_GLUW, I_GLUB, I_GGW, I_GGB, I_GNG, I_WOUT, I_NFG, I_FWIN, I_FCW, I_FCB, I_FWOUT, I_NFIN, N_IN };

struct Args { const float* in[N_IN]; float* out; unsigned char* ws; };

__device__ __forceinline__ float bflo(unsigned w) { return __uint_as_float(w << 16); }
__device__ __forceinline__ float bfhi(unsigned w) { return __uint_as_float(w & 0xffff0000u); }
__device__ __forceinline__ unsigned pk2(float lo, float hi) { unsigned r; asm("v_cvt_pk_bf16_f32 %0, %1, %2" : "=v"(r) : "v"(lo), "v"(hi)); return r; }
__device__ __forceinline__ unsigned f2bf(float f) { return pk2(f, 0.f) & 0xffffu; }
__device__ __forceinline__ float silu(float x) { return x * __builtin_amdgcn_rcpf(1.f + __builtin_amdgcn_exp2f(-1.4426950408889634f * x)); }
__device__ __forceinline__ float sigmoidf_(float x) { return __builtin_amdgcn_rcpf(1.f + __builtin_amdgcn_exp2f(-1.4426950408889634f * x)); }
__device__ __forceinline__ float gelu_tanh(float x) {
    const float v = x * fmaf(x * x, 0.044715f, 1.f);
    const float e = __builtin_amdgcn_exp2f(v * (2.f * 0.7978845608028654f * 1.4426950408889634f));
    return fmaf(-x, __builtin_amdgcn_rcpf(e + 1.f), x);
}
__device__ __forceinline__ float rdl(float x, int l) { return __int_as_float(__builtin_amdgcn_readlane(__float_as_int(x), l)); }
__device__ __forceinline__ float wave_sum(float v) {
#pragma unroll
    for (int o = 1; o < 64; o <<= 1) v += __shfl_xor(v, o);
    return v;
}

struct EpiRes {
    static constexpr bool PERM = false, AFTER_DRAIN = false;
    const float* baseP; const float* baseS; float* out;
    __device__ __forceinline__ void operator()(const pg8::f32x4 (&acc)[2][2][4][2], const pg8::Unit& u, int wr, int wc, int fr, int fq) const {
        const int row0 = u.pm * 256 + wr * 64 + fr, col0 = u.pn * 256 + wc * 32 + 4 * fq;
        const float* base = (u.pm < TP / 256) ? baseP : (baseS - (size_t)TP * D);
#pragma unroll
        for (int ai = 0; ai < 2; ++ai)
#pragma unroll
            for (int m = 0; m < 4; ++m) { const size_t off = (size_t)(row0 + ai * 128 + m * 16) * D + col0;
#pragma unroll
                for (int bj = 0; bj < 2; ++bj)
#pragma unroll
                    for (int n = 0; n < 2; ++n) { const pg8::f32x4 bs = *(const pg8::f32x4*)(base + off + bj * 128 + n * 16);
                        *(pg8::f32x4*)(out + off + bj * 128 + n * 16) = bs + acc[ai][bj][m][n]; }
                if (m & 1) asm volatile("" ::: "memory"); }
    }
};
struct TailOrder {
    int S, G, c;
    __device__ void init(int S_, int G_, int c_) { S = S_; G = G_; c = c_; }
    __device__ bool next(int i, pg8::Unit& u) const { const int Lq = i * G + c; if (Lq >= 8 * S) return false; const int ks = Lq % S, tile = Lq / S; u.pn = tile & 3; u.pm = TP / 256 + (tile >> 2); u.ko = ks * 256; return true; }
    __device__ __forceinline__ void a_ready(const pg8::Unit&) const {}
    __device__ __forceinline__ void done(const pg8::Unit&) const {}
};
struct EpiPart {
    static constexpr bool PERM = false, AFTER_DRAIN = false;
    float* part;
    __device__ __forceinline__ void operator()(const pg8::f32x4 (&acc)[2][2][4][2], const pg8::Unit& u, int wr, int wc, int fr, int fq) const {
        const int row0 = (u.pm - TP / 256) * 256 + wr * 64 + fr, col0 = u.pn * 256 + wc * 32 + 4 * fq;
        float* dst = part + (size_t)(u.ko >> 8) * TS * D;
#pragma unroll
        for (int ai = 0; ai < 2; ++ai)
#pragma unroll
            for (int m = 0; m < 4; ++m) { const size_t off = (size_t)(row0 + ai * 128 + m * 16) * D + col0;
#pragma unroll
                for (int bj = 0; bj < 2; ++bj)
#pragma unroll
                    for (int n = 0; n < 2; ++n) *(pg8::f32x4*)(dst + off + bj * 128 + n * 16) = acc[ai][bj][m][n]; }
    }
};
struct EpiGlu {
    static constexpr bool PERM = true, AFTER_DRAIN = false;
    const bf16* y5; const float* bias; bf16* mix;
    __device__ __forceinline__ void operator()(const pg8::f32x4 (&acc)[2][2][4][2], const pg8::Unit& u, int wr, int wc, int fr, int fq) const {
        const int row0 = u.pm * 256 + wr * 64 + fr, col0 = wc * 32 + 8 * fq;
#pragma unroll
        for (int bj = 0; bj < 2; ++bj) { const int c = col0 + bj * 128;
            const f32x4 b0 = *(const f32x4*)(bias + c), b1 = *(const f32x4*)(bias + c + 4);
#pragma unroll
            for (int ai = 0; ai < 2; ++ai)
#pragma unroll
                for (int m = 0; m < 4; ++m) { const size_t r = (size_t)(row0 + ai * 128 + m * 16);
                    const u32x4 yv = *(const u32x4*)(y5 + r * 256 + c);
                    const pg8::f32x4 v0 = acc[ai][bj][m][0], v1 = acc[ai][bj][m][1];
                    u32x4 w;
                    w.x = pk2(bflo(yv.x) * sigmoidf_(v0[0] + b0[0]), bfhi(yv.x) * sigmoidf_(v0[1] + b0[1]));
                    w.y = pk2(bflo(yv.y) * sigmoidf_(v0[2] + b0[2]), bfhi(yv.y) * sigmoidf_(v0[3] + b0[3]));
                    w.z = pk2(bflo(yv.z) * sigmoidf_(v1[0] + b1[0]), bfhi(yv.z) * sigmoidf_(v1[1] + b1[1]));
                    w.w = pk2(bflo(yv.w) * sigmoidf_(v1[2] + b1[2]), bfhi(yv.w) * sigmoidf_(v1[3] + b1[3]));
                    *(u32x4*)(mix + r * D + 384 + c) = w; asm volatile("" ::: "memory"); } }
    }
};
struct EpiUp {
    static constexpr bool PERM = true, AFTER_DRAIN = false;
    bf16* abuf; bf16* gate; float* convP; float* convS;
    __device__ __forceinline__ void operator()(const pg8::f32x4 (&acc)[2][2][4][2], const pg8::Unit& u, int wr, int wc, int fr, int fq) const {
        const bool isA = u.pn < DFF / 256;
        bf16* dst = isA ? abuf : gate;
        const int colt = (isA ? u.pn : u.pn - DFF / 256) * 256 + wc * 32 + 8 * fq;
        const int row0 = u.pm * 256 + wr * 64 + fr;
#pragma unroll
        for (int ai = 0; ai < 2; ++ai)
#pragma unroll
            for (int m = 0; m < 4; ++m) { const int r = row0 + ai * 128 + m * 16;
#pragma unroll
                for (int bj = 0; bj < 2; ++bj) { const pg8::f32x4 v0 = acc[ai][bj][m][0], v1 = acc[ai][bj][m][1];
                    u32x4 w; w.x = pg8::cvt_pk_bf16(v0[0], v0[1]); w.y = pg8::cvt_pk_bf16(v0[2], v0[3]); w.z = pg8::cvt_pk_bf16(v1[0], v1[1]); w.w = pg8::cvt_pk_bf16(v1[2], v1[3]);
                    *(u32x4*)(dst + (size_t)r * DFF + colt + bj * 128) = w;
                    if (isA) {
                        float* cd = nullptr;
                        if (r < TP) { const int t = r & (SEQ - 1); if (t >= SEQ - 2) cd = convP + ((size_t)(r >> 11) * 2 + (t - (SEQ - 2))) * DFF; }
                        else { const int rs = r - TP, t = rs & 3; if (t >= 2) cd = convS + ((size_t)(rs >> 2) * 2 + (t - 2)) * DFF; }
                        if (cd) { *(pg8::f32x4*)(cd + colt + bj * 128) = v0; *(pg8::f32x4*)(cd + colt + bj * 128 + 4) = v1; }
                    } } }
    }
};

__device__ __forceinline__ float dpp_ror1(float x) { return __int_as_float(__builtin_amdgcn_update_dpp(0, __float_as_int(x), 0x121, 0xf, 0xf, false)); }
__device__ __forceinline__ float dpp_ror2(float x) { return __int_as_float(__builtin_amdgcn_update_dpp(0, __float_as_int(x), 0x122, 0xf, 0xf, false)); }
struct EpiAct {
    static constexpr bool PERM = true, AFTER_DRAIN = false;
    bf16* act; float* convP; float* convS; const float* cw; const float* cb; const float* cstate; PG8_LAS float* halo;
    __device__ __forceinline__ void operator()(const pg8::f32x4 (&acc)[2][2][4][2], const pg8::Unit& u, int wr, int wc, int fr, int fq) const {
        const int jl = wc * 32 + 8 * fq, j0 = u.pn * 128 + jl;
        if (fr >= 14) {
#pragma unroll
            for (int ai = 0; ai < 2; ++ai) { PG8_LAS float* hp = halo + ((ai * 2 + wr) * 2 + (fr - 14)) * 128 + jl;
                *(PG8_LAS pg8::f32x4*)hp = acc[ai][0][3][0]; *(PG8_LAS pg8::f32x4*)(hp + 4) = acc[ai][0][3][1]; } }
        float w0[8], w1[8], w2[8], bb[8];
#pragma unroll
        for (int e = 0; e < 8; ++e) { w0[e] = cw[j0 + e]; w1[e] = cw[DFF + j0 + e]; w2[e] = cw[2 * DFF + j0 + e]; bb[e] = cb[j0 + e]; }
        asm volatile("s_waitcnt lgkmcnt(0)" ::: "memory"); __builtin_amdgcn_s_barrier(); asm volatile("" ::: "memory");
#pragma unroll
        for (int ai = 0; ai < 2; ++ai)
#pragma unroll
            for (int m = 0; m < 4; ++m) {
                const int rr = ai * 128 + wr * 64 + m * 16 + fr, r = u.pm * 254 - 2 + rr;
                float cur[8], p1[8], p2[8];
#pragma unroll
                for (int e = 0; e < 8; ++e) cur[e] = acc[ai][0][m][e >> 2][e & 3];
                if (m == 0) {
                    float h0[8], h1[8];
                    const int pb = ai * 2 + wr - 1;
                    if (pb >= 0) { const PG8_LAS float* hp = halo + (pb * 2) * 128 + jl;
                        const pg8::f32x4 a0 = *(const PG8_LAS pg8::f32x4*)hp, a1 = *(const PG8_LAS pg8::f32x4*)(hp + 4), b0 = *(const PG8_LAS pg8::f32x4*)(hp + 128), b1 = *(const PG8_LAS pg8::f32x4*)(hp + 132);
#pragma unroll
                        for (int e = 0; e < 4; ++e) { h0[e] = a0[e]; h0[4 + e] = a1[e]; h1[e] = b0[e]; h1[4 + e] = b1[e]; } }
                    else {
#pragma unroll
                        for (int e = 0; e < 8; ++e) { h0[e] = 0.f; h1[e] = 0.f; } }
#pragma unroll
                    for (int e = 0; e < 8; ++e) { const float s1 = dpp_ror1(cur[e]), s2 = dpp_ror2(cur[e]); p1[e] = fr >= 1 ? s1 : h1[e]; p2[e] = fr >= 2 ? s2 : (fr == 1 ? h1[e] : h0[e]); }
                } else {
#pragma unroll
                    for (int e = 0; e < 8; ++e) { const float pv = acc[ai][0][m - 1][e >> 2][e & 3];
                        const float s1 = dpp_ror1(cur[e]), s2 = dpp_ror2(cur[e]), q1 = dpp_ror1(pv), q2 = dpp_ror2(pv); p1[e] = fr >= 1 ? s1 : q1; p2[e] = fr >= 2 ? s2 : q2; }
                }
                const bool live = rr >= 2 && r < MR;
                const bool smp = r >= TP;
                const int t = smp ? ((r - TP) & 3) : (r & (SEQ - 1));
                if (live && t < 2) {
                    if (smp) { const float* cs = cstate + (size_t)((r - TP) >> 2) * 2 * DFF + j0;
#pragma unroll
                        for (int e = 0; e < 8; ++e) { if (t == 0) { p2[e] = cs[e]; p1[e] = cs[DFF + e]; } else { p2[e] = cs[DFF + e]; } } }
                    else {
#pragma unroll
                        for (int e = 0; e < 8; ++e) { p2[e] = 0.f; if (t == 0) p1[e] = 0.f; } }
                }
                if (live) {
                    float o[8];
                    typedef float f32x2 __attribute__((ext_vector_type(2)));
#pragma unroll
                    for (int e = 0; e < 8; e += 2) {
                        f32x2 cv = (f32x2){bb[e], bb[e + 1]} + (f32x2){w0[e], w0[e + 1]} * (f32x2){p2[e], p2[e + 1]};
                        cv += (f32x2){w1[e], w1[e + 1]} * (f32x2){p1[e], p1[e + 1]}; cv += (f32x2){w2[e], w2[e + 1]} * (f32x2){cur[e], cur[e + 1]};
                        const f32x2 vv = cv * (cv * cv * 0.044715f + 1.f) * (2.f * 0.7978845608028654f * 1.4426950408889634f);
                        const float r0 = __builtin_amdgcn_rcpf(__builtin_amdgcn_exp2f(vv.x) + 1.f), r1 = __builtin_amdgcn_rcpf(__builtin_amdgcn_exp2f(vv.y) + 1.f);
                        const f32x2 gl = cv - cv * (f32x2){r0, r1};
                        const f32x2 go = gl * (f32x2){acc[ai][1][m][e >> 2][e & 3], acc[ai][1][m][(e + 1) >> 2][(e + 1) & 3]};
                        o[e] = go.x; o[e + 1] = go.y; }
                    u32x4 wv; wv.x = pk2(o[0], o[1]); wv.y = pk2(o[2], o[3]); wv.z = pk2(o[4], o[5]); wv.w = pk2(o[6], o[7]);
                    *(u32x4*)(act + (size_t)r * DFF + j0) = wv;
                    float* cd = nullptr;
                    if (!smp) { if (t >= SEQ - 2) cd = convP + ((size_t)(r >> 11) * 2 + (t - (SEQ - 2))) * DFF; }
                    else if (t >= 2) cd = convS + ((size_t)((r - TP) >> 2) * 2 + (t - 2)) * DFF;
                    if (cd) { *(pg8::f32x4*)(cd + j0) = acc[ai][0][m][0]; *(pg8::f32x4*)(cd + j0 + 4) = acc[ai][0][m][1]; }
                }
            }
    }
};

typedef const __attribute__((address_space(4))) Args* KArgs;
struct Ctx {
    KArgs ap; int tid, lane, wave, gw, ngw, bx, G;
    __device__ __forceinline__ const float* in(int i) const { return ap->in[i]; }
    __device__ __forceinline__ float* out() const { return ap->out; }
    __device__ __forceinline__ bf16* W1T() const { return (bf16*)(ap->ws + WS_W1T); }
    __device__ __forceinline__ bf16* W2T() const { return (bf16*)(ap->ws + WS_W2T); }
    __device__ __forceinline__ bf16* W3T() const { return (bf16*)(ap->ws + WS_W3T); }
    __device__ __forceinline__ bf16* W4T() const { return (bf16*)(ap->ws + WS_W4T); }
    __device__ __forceinline__ bf16* GLUT() const { return (bf16*)(ap->ws + WS_GLUT); }
    __device__ __forceinline__ bf16* XN() const { return (bf16*)(ap->ws + WS_XN); }
    __device__ __forceinline__ bf16* PROJ() const { return (bf16*)(ap->ws + WS_BIG); }
    __device__ __forceinline__ bf16* ABUF() const { return (bf16*)(ap->ws + WS_ABUF); }
    __device__ __forceinline__ bf16* GATE() const { return (bf16*)(ap->ws + WS_GATE); }
    __device__ __forceinline__ bf16* Y5() const { return (bf16*)(ap->ws + WS_Y5); }
    __device__ __forceinline__ float* ROPE() const { return (float*)(ap->ws + WS_ROPE); }
    __device__ __forceinline__ float* SEG() const { return (float*)(ap->ws + WS_SEG); }
    __device__ __forceinline__ float* PART() const { return (float*)(ap->ws + WS_BIG); }
};
__device__ __forceinline__ Ctx mkctx() {
    Ctx c; KArgs p = (KArgs)__builtin_amdgcn_kernarg_segment_ptr(); asm volatile("" : "+s"(p)); c.ap = p;
    int t_ = threadIdx.x; asm volatile("" : "+v"(t_)); int b_ = blockIdx.x; asm volatile("" : "+s"(b_)); int g_ = gridDim.x; asm volatile("" : "+s"(g_));
    c.tid = t_; c.lane = c.tid & 63; c.wave = __builtin_amdgcn_readfirstlane(c.tid >> 6); c.bx = b_; c.G = g_;
    c.gw = b_ * 8 + c.wave; c.ngw = g_ * 8; return c;
}

__device__ __forceinline__ void transpose_item(const float* W, int K, int N, bf16* WT, float* scr, int item, int lane, bool ILV = false) {
    const int nblk = (N + 31) / 32, kb = item / nblk, nb = item % nblk, k0 = 64 * kb, n0 = 32 * nb;
    const int dst0 = !ILV ? n0 : (n0 < DFF ? 256 * (n0 >> 7) + (n0 & 127) : 256 * ((n0 - DFF) >> 7) + 128 + ((n0 - DFF) & 127));
    const int nn = n0 + (lane & 31);
    float tv[32];
#pragma unroll
    for (int i = 0; i < 32; ++i) { const int kk = 2 * i + (lane >> 5); tv[i] = (nn < N) ? W[(size_t)(k0 + kk) * N + nn] : 0.f; }
#pragma unroll
    for (int i = 0; i < 32; ++i) { const int kk = 2 * i + (lane >> 5); scr[kk * 33 + (lane & 31)] = tv[i]; }
    asm volatile("s_waitcnt lgkmcnt(0)" ::: "memory");
    const int c = lane & 7;
#pragma unroll
    for (int j = 0; j < 4; ++j) { const int n = (lane >> 3) + 8 * j; const float* s = scr + (8 * c) * 33 + n;
        u32x4 o; o.x = pk2(s[0 * 33], s[1 * 33]); o.y = pk2(s[2 * 33], s[3 * 33]); o.z = pk2(s[4 * 33], s[5 * 33]); o.w = pk2(s[6 * 33], s[7 * 33]);
        *(u32x4*)(WT + (size_t)(dst0 + n) * K + k0 + 8 * c) = o; }
    asm volatile("s_waitcnt lgkmcnt(0)" ::: "memory");
}
__device__ __forceinline__ void norm_row_bf16(const float* xrow, const float* g, bf16* orow, int lane, const float* part = nullptr, int nS = 0, float* xout = nullptr) {
    const f32x4* xr = (const f32x4*)xrow + lane; const f32x4* gr = (const f32x4*)g + lane;
    f32x4 v[4]; float s = 0.f;
#pragma unroll
    for (int j = 0; j < 4; ++j) v[j] = xr[64 * j];
    if (part) { for (int q = 0; q < nS; ++q) { const f32x4* pp = (const f32x4*)(part + (size_t)q * TS * D) + lane;
#pragma unroll
            for (int j = 0; j < 4; ++j) v[j] += pp[64 * j]; }
#pragma unroll
        for (int j = 0; j < 4; ++j) ((f32x4*)xout + lane)[64 * j] = v[j]; }
#pragma unroll
    for (int j = 0; j < 4; ++j) { s += (v[j].x * v[j].x + v[j].y * v[j].y) + (v[j].z * v[j].z + v[j].w * v[j].w); }
    const float rs = rsqrtf(wave_sum(s) * (1.f / D) + EPS);
    u32x2* o8 = (u32x2*)orow + lane;
#pragma unroll
    for (int j = 0; j < 4; ++j) { const f32x4 gg = gr[64 * j]; u32x2 w; w.x = pk2(v[j].x * rs * gg.x, v[j].y * rs * gg.y); w.y = pk2(v[j].z * rs * gg.z, v[j].w * rs * gg.w); o8[64 * j] = w; }
}
__device__ __forceinline__ void norm_row_f32(float* xrow, const float* g, int lane, const float* part = nullptr, int nS = 0) {
    f32x4* xr = (f32x4*)xrow + lane; const f32x4* gr = (const f32x4*)g + lane;
    f32x4 v[4]; float s = 0.f;
#pragma unroll
    for (int j = 0; j < 4; ++j) v[j] = xr[64 * j];
    if (part) { for (int q = 0; q < nS; ++q) { const f32x4* pp = (const f32x4*)(part + (size_t)q * TS * D) + lane;
#pragma unroll
            for (int j = 0; j < 4; ++j) v[j] += pp[64 * j]; } }
#pragma unroll
    for (int j = 0; j < 4; ++j) { s += (v[j].x * v[j].x + v[j].y * v[j].y) + (v[j].z * v[j].z + v[j].w * v[j].w); }
    const float rs = rsqrtf(wave_sum(s) * (1.f / D) + EPS);
#pragma unroll
    for (int j = 0; j < 4; ++j) { const f32x4 gg = gr[64 * j]; xr[64 * j] = v[j] * rs * gg; }
}

__device__ __forceinline__ void norm_rows2_bf16(const float* x0, const float* x1, const float* g, bf16* o0, bf16* o1, int lane) {
    const f32x4* xr0 = (const f32x4*)x0 + lane; const f32x4* xr1 = (const f32x4*)x1 + lane; const f32x4* gr = (const f32x4*)g + lane;
    f32x4 v0[4], v1[4]; float s0 = 0.f, s1 = 0.f;
#pragma unroll
    for (int j = 0; j < 4; ++j) { v0[j] = xr0[64 * j]; v1[j] = xr1[64 * j]; }
#pragma unroll
    for (int j = 0; j < 4; ++j) { s0 += (v0[j].x * v0[j].x + v0[j].y * v0[j].y) + (v0[j].z * v0[j].z + v0[j].w * v0[j].w); s1 += (v1[j].x * v1[j].x + v1[j].y * v1[j].y) + (v1[j].z * v1[j].z + v1[j].w * v1[j].w); }
#pragma unroll
    for (int o = 1; o < 64; o <<= 1) { s0 += __shfl_xor(s0, o); s1 += __shfl_xor(s1, o); }
    const float r0 = rsqrtf(s0 * (1.f / D) + EPS), r1 = rsqrtf(s1 * (1.f / D) + EPS);
    u32x2* p0 = (u32x2*)o0 + lane; u32x2* p1 = (u32x2*)o1 + lane;
#pragma unroll
    for (int j = 0; j < 4; ++j) { const f32x4 gg = gr[64 * j];
        u32x2 w; w.x = pk2(v0[j].x * r0 * gg.x, v0[j].y * r0 * gg.y); w.y = pk2(v0[j].z * r0 * gg.z, v0[j].w * r0 * gg.w); p0[64 * j] = w;
        u32x2 z; z.x = pk2(v1[j].x * r1 * gg.x, v1[j].y * r1 * gg.y); z.y = pk2(v1[j].z * r1 * gg.z, v1[j].w * r1 * gg.w); p1[64 * j] = z; }
}
__device__ __forceinline__ void norm_rows2_f32(float* x0, float* x1, const float* g, int lane) {
    f32x4* xr0 = (f32x4*)x0 + lane; f32x4* xr1 = (f32x4*)x1 + lane; const f32x4* gr = (const f32x4*)g + lane;
    f32x4 v0[4], v1[4]; float s0 = 0.f, s1 = 0.f;
#pragma unroll
    for (int j = 0; j < 4; ++j) { v0[j] = xr0[64 * j]; v1[j] = xr1[64 * j]; }
#pragma unroll
    for (int j = 0; j < 4; ++j) { s0 += (v0[j].x * v0[j].x + v0[j].y * v0[j].y) + (v0[j].z * v0[j].z + v0[j].w * v0[j].w); s1 += (v1[j].x * v1[j].x + v1[j].y * v1[j].y) + (v1[j].z * v1[j].z + v1[j].w * v1[j].w); }
#pragma unroll
    for (int o = 1; o < 64; o <<= 1) { s0 += __shfl_xor(s0, o); s1 += __shfl_xor(s1, o); }
    const float r0 = rsqrtf(s0 * (1.f / D) + EPS), r1 = rsqrtf(s1 * (1.f / D) + EPS);
#pragma unroll
    for (int j = 0; j < 4; ++j) { const f32x4 gg = gr[64 * j]; xr0[64 * j] = v0[j] * r0 * gg; xr1[64 * j] = v1[j] * r1 * gg; }
}

__device__ __forceinline__ void prep_phase(const Ctx& c, int l, float* L) {
    float* scr = L + c.wave * 4096;
    constexpr int I1 = 16 * 93, I2 = 16 * 32, I3 = 16 * 176, I4 = 44 * 32, I5 = 4 * 8;
    constexpr int NIT = I1 + I2 + I3 + I4 + I5;
    const float* w_in = c.in(I_WIN) + (size_t)l * D * INC;
    const float* w_out = c.in(I_WOUT) + (size_t)l * D * D;
    const float* f_in = c.in(I_FWIN) + (size_t)l * D * NUP;
    const float* f_out = c.in(I_FWOUT) + (size_t)l * DFF * D;
    const float* gluw = c.in(I_GLUW) + (size_t)l * 256 * 256;
    for (int it = c.gw; it < NIT; it += c.ngw) {
        int r = it;
        if (r < I1) { transpose_item(w_in, D, INC, c.W1T(), scr, r, c.lane); continue; } r -= I1;
        if (r < I2) { transpose_item(w_out, D, D, c.W2T(), scr, r, c.lane); continue; } r -= I2;
        if (r < I3) { transpose_item(f_in, D, NUP, c.W3T(), scr, r, c.lane, true); continue; } r -= I3;
        if (r < I4) { transpose_item(f_out, DFF, D, c.W4T(), scr, r, c.lane); continue; } r -= I4;
        transpose_item(gluw, 256, 256, c.GLUT(), scr, r, c.lane);
    }
    { const int gt = c.gw * 64 + c.lane, ngt = c.ngw * 64; u32x4 z = {0u, 0u, 0u, 0u};
      for (int i = gt; i < (NPROJ - 2976) * D / 8; i += ngt) *(u32x4*)(c.W1T() + (size_t)2976 * D + (size_t)i * 8) = z; }
    const float* g = c.in(I_NMG) + (size_t)l * D;
    { const float* xp = (l == 0) ? c.in(I_XP) : (const float*)c.out();
      for (int m = c.gw; m < TP; m += 2 * c.ngw) { const int m1 = m + c.ngw;
          if (m1 < TP) norm_rows2_bf16(xp + (size_t)m * D, xp + (size_t)m1 * D, g, c.XN() + (size_t)m * D, c.XN() + (size_t)m1 * D, c.lane);
          else norm_row_bf16(xp + (size_t)m * D, g, c.XN() + (size_t)m * D, c.lane); } }
    for (int m = TP + c.gw; m < MR; m += c.ngw) {
        const float* xr = (l == 0) ? c.in(I_XS) + (size_t)(m - TP) * D : c.out() + (size_t)m * D;
        if (l > 0) norm_row_bf16(xr, g, c.XN() + (size_t)m * D, c.lane, c.PART() + (size_t)(m - TP) * D, DFF / 256, c.out() + (size_t)m * D);
        else norm_row_bf16(xr, g, c.XN() + (size_t)m * D, c.lane);
    }
    if (l == 0) {
        const int gt = c.gw * 64 + c.lane, ngt = c.ngw * 64;
        for (int i = gt; i < 2052 * 32; i += ngt) { const int ps = i >> 5, f = i & 31; const int pos = ps < 2048 ? ps : 16384 + (ps - 2048);
            const float inv = exp2f(-(float)f * (13.287712379549449f / 32.f));
            double a = (double)pos * (double)inv; a -= 6.283185307179586 * rint(a * 0.15915494309189535);
            const float af = (float)a; c.ROPE()[i] = cosf(af); c.ROPE()[2052 * 32 + i] = sinf(af); }
    }
}

template <bool PASSA>
__device__ __forceinline__ void ret_task(const Ctx& c, int l, bool sample, int b, int h, int seg, float* L) {
    const int tid = c.tid, lane = c.lane, w = c.wave, vl = lane & 7, dg = lane >> 3;
    const int len = sample ? DSEQ : LSEG;
    const int row0 = sample ? TP + b * DSEQ : b * SEQ + seg * LSEG;
    const int ridx0 = sample ? 2048 : seg * LSEG;
    const float gamma = 1.f - exp2f(-5.f - (float)h);
    float S[8];
    if (sample) { const float* s0 = c.in(I_SRET) + ((size_t)((l * DB + b) * 6 + h) * 64 + 8 * dg) * 64 + 8 * w + vl;
#pragma unroll
        for (int i = 0; i < 8; ++i) S[i] = s0[i * 64]; }
    else {
#pragma unroll
        for (int i = 0; i < 8; ++i) S[i] = 0.f;
        const float lg = log2f(gamma);
        if (!PASSA) for (int m = 0; m < seg; ++m) { const float f = exp2f((float)(LSEG * (seg - 1 - m)) * lg);
            const float* E = c.SEG() + SEG_RET / 4 + (size_t)((b * 6 + h) * (NSEG - 1) + m) * 4096 + (8 * dg) * 64 + 8 * w + vl;
#pragma unroll
            for (int i = 0; i < 8; ++i) S[i] += f * E[i * 64]; }
    }
    float* Qs = L; float* Ks = L + 4096; float* Vs = L + 8192; float* Os = L + 12288;
    const float* rg_g = c.in(I_RNG) + l * 384 + h * 64; const float* rg_b = c.in(I_RNB) + l * 384 + h * 64;
    for (int c0 = 0; c0 < len; c0 += 64) {
        const int n = (len - c0) < 64 ? (len - c0) : 64;
        { const int t = tid >> 3, cc = tid & 7;
          if (t < n) { const bf16* pr = c.PROJ() + (size_t)(row0 + c0 + t) * NPROJ;
            const float* rc = c.ROPE() + (size_t)(ridx0 + c0 + t) * 32 + 4 * cc; const float* rsn = rc + 2052 * 32;
            const f32x4 cs = *(const f32x4*)rc, sn = *(const f32x4*)rsn;
            { const u32x2 lo = *(const u32x2*)(pr + C_RK + h * 64 + 4 * cc), hi = *(const u32x2*)(pr + C_RK + h * 64 + 32 + 4 * cc);
              const f32x4 x1 = {bflo(lo.x), bfhi(lo.x), bflo(lo.y), bfhi(lo.y)}, x2 = {bflo(hi.x), bfhi(hi.x), bflo(hi.y), bfhi(hi.y)};
              *(f32x4*)(Ks + t * 64 + 4 * cc) = (x1 * cs - x2 * sn) * 0.125f; *(f32x4*)(Ks + t * 64 + 32 + 4 * cc) = (x1 * sn + x2 * cs) * 0.125f; }
            if (!PASSA) { const u32x2 lo = *(const u32x2*)(pr + C_RQ + h * 64 + 4 * cc), hi = *(const u32x2*)(pr + C_RQ + h * 64 + 32 + 4 * cc);
              const f32x4 x1 = {bflo(lo.x), bfhi(lo.x), bflo(lo.y), bfhi(lo.y)}, x2 = {bflo(hi.x), bfhi(hi.x), bflo(hi.y), bfhi(hi.y)};
              *(f32x4*)(Qs + t * 64 + 4 * cc) = x1 * cs - x2 * sn; *(f32x4*)(Qs + t * 64 + 32 + 4 * cc) = x1 * sn + x2 * cs; }
            { const u32x4 vv = *(const u32x4*)(pr + C_RV + h * 64 + 8 * cc);
              *(f32x4*)(Vs + t * 64 + 8 * cc) = (f32x4){bflo(vv.x), bfhi(vv.x), bflo(vv.y), bfhi(vv.y)};
              *(f32x4*)(Vs + t * 64 + 8 * cc + 4) = (f32x4){bflo(vv.z), bfhi(vv.z), bflo(vv.w), bfhi(vv.w)}; } } }
        __syncthreads();
        for (int tl0 = 0; tl0 < n; tl0 += 4) {
            float po[4];
#pragma unroll
            for (int u = 0; u < 4; ++u) { const int tl = tl0 + u;
                const f32x4 k0 = *(const f32x4*)(Ks + tl * 64 + 8 * dg), k1 = *(const f32x4*)(Ks + tl * 64 + 8 * dg + 4);
                const float vv = Vs[tl * 64 + 8 * w + vl];
                const float kk[8] = {k0.x, k0.y, k0.z, k0.w, k1.x, k1.y, k1.z, k1.w};
#pragma unroll
                for (int i = 0; i < 8; ++i) S[i] = fmaf(gamma, S[i], kk[i] * vv);
                if (!PASSA) {
                    const f32x4 q0 = *(const f32x4*)(Qs + tl * 64 + 8 * dg), q1 = *(const f32x4*)(Qs + tl * 64 + 8 * dg + 4);
                    po[u] = q0.x * S[0] + q0.y * S[1] + q0.z * S[2] + q0.w * S[3] + q1.x * S[4] + q1.y * S[5] + q1.z * S[6] + q1.w * S[7]; } }
            if (!PASSA) {
#pragma unroll
                for (int u = 0; u < 4; ++u) po[u] += __shfl_xor(po[u], 8);
#pragma unroll
                for (int u = 0; u < 4; ++u) po[u] += __shfl_xor(po[u], 16);
#pragma unroll
                for (int u = 0; u < 4; ++u) po[u] += __shfl_xor(po[u], 32);
                if (dg == 0) {
#pragma unroll
                    for (int u = 0; u < 4; ++u) Os[(tl0 + u) * 64 + 8 * w + vl] = po[u]; } }
        }
        __syncthreads();
        if (!PASSA) { const int t = tid >> 3, cc = tid & 7;
          if (t < n) { const int row = row0 + c0 + t;
            const f32x4 o0 = *(const f32x4*)(Os + t * 64 + 8 * cc), o1 = *(const f32x4*)(Os + t * 64 + 8 * cc + 4);
            float o[8] = {o0.x, o0.y, o0.z, o0.w, o1.x, o1.y, o1.z, o1.w};
            float s = 0.f;
#pragma unroll
            for (int i = 0; i < 8; ++i) s += o[i];
            s += __shfl_xor(s, 1); s += __shfl_xor(s, 2); s += __shfl_xor(s, 4);
            const float mu = s * (1.f / 64.f); float q = 0.f;
#pragma unroll
            for (int i = 0; i < 8; ++i) { o[i] -= mu; q += o[i] * o[i]; }
            q += __shfl_xor(q, 1); q += __shfl_xor(q, 2); q += __shfl_xor(q, 4);
            const float rstd = rsqrtf(q * (1.f / 64.f) + EPS);
            const u32x4 gv = *(const u32x4*)(c.PROJ() + (size_t)row * NPROJ + C_RG + h * 64 + 8 * cc);
            const float gt[8] = {bflo(gv.x), bfhi(gv.x), bflo(gv.y), bfhi(gv.y), bflo(gv.z), bfhi(gv.z), bflo(gv.w), bfhi(gv.w)};
            float r[8];
#pragma unroll
            for (int i = 0; i < 8; ++i) r[i] = (o[i] * rstd * rg_g[8 * cc + i] + rg_b[8 * cc + i]) * silu(gt[i]);
            u32x4 wv; wv.x = pk2(r[0], r[1]); wv.y = pk2(r[2], r[3]); wv.z = pk2(r[4], r[5]); wv.w = pk2(r[6], r[7]);
            *(u32x4*)(c.XN() + (size_t)row * D + h * 64 + 8 * cc) = wv; } }
    }
    if (PASSA) { float* E = c.SEG() + SEG_RET / 4 + (size_t)((b * 6 + h) * (NSEG - 1) + seg) * 4096 + (8 * dg) * 64 + 8 * w + vl;
#pragma unroll
        for (int i = 0; i < 8; ++i) E[i * 64] = S[i]; }
    else if (sample || seg == NSEG - 1) {
        float* so = c.out() + (sample ? O_RETS + ((size_t)(l * DB + b) * 6 + h) * 4096 : O_RETP + ((size_t)(l * NB + b) * 6 + h) * 4096) + (8 * dg) * 64 + 8 * w + vl;
#pragma unroll
        for (int i = 0; i < 8; ++i) so[i * 64] = S[i]; }
}

template <bool PASSA>
__device__ __forceinline__ void gla_task(const Ctx& c, int l, bool sample, int b, int h, int seg, float* L) {
    const int tid = c.tid, lane = c.lane, w = c.wave;
    const int vl = lane % 12, dgr = lane / 12, dg = dgr > 3 ? 3 : dgr;
    const int len = sample ? DSEQ : LSEG;
    const int row0 = sample ? TP + b * DSEQ : b * SEQ + seg * LSEG;
    float* Qs = L; float* Ks = L + 3072; float* As = L + 6144; float* Vs = L + 9216; float* Os = L + 15360; float* GW = L + 21504; float* DS = L + 22272;
    for (int i = tid; i < 768; i += 512) { const int r = i / 48, d = i % 48; GW[i] = c.in(I_GGW)[(size_t)(l * 16 + r) * 192 + h * 48 + d]; }
    if (tid < 48) DS[tid] = 0.f;
    float S[12];
    const int vcol = 12 * w + vl;
    if (sample) { const float* s0 = c.in(I_SGLA) + ((size_t)((l * DB + b) * 4 + h) * 48 + 12 * dg) * 96 + vcol;
#pragma unroll
        for (int i = 0; i < 12; ++i) S[i] = s0[i * 96]; }
    else {
#pragma unroll
        for (int i = 0; i < 12; ++i) S[i] = 0.f;
        if (!PASSA) for (int m = 0; m < seg; ++m) { const float* E = c.SEG() + SEG_GLA / 4 + (size_t)((b * 4 + h) * (NSEG - 1) + m) * 4672;
#pragma unroll
            for (int i = 0; i < 12; ++i) S[i] = __expf(E[4608 + 12 * dg + i]) * S[i] + E[(12 * dg + i) * 96 + vcol]; }
    }
    const float* gb = c.in(I_GGB) + l * 192 + h * 48;
    const float* gng = c.in(I_GNG) + l * 96;
    __syncthreads();
    for (int c0 = 0; c0 < len; c0 += 64) {
        const int n = (len - c0) < 64 ? (len - c0) : 64;
        { const int t = tid >> 3, cc = tid & 7;
          if (t < n) { const bf16* pr = c.PROJ() + (size_t)(row0 + c0 + t) * NPROJ;
            const u32x4 g0 = *(const u32x4*)(pr + C_GLR), g1 = *(const u32x4*)(pr + C_GLR + 8);
            const float gl[16] = {bflo(g0.x), bfhi(g0.x), bflo(g0.y), bfhi(g0.y), bflo(g0.z), bfhi(g0.z), bflo(g0.w), bfhi(g0.w),
                                  bflo(g1.x), bfhi(g1.x), bflo(g1.y), bfhi(g1.y), bflo(g1.z), bfhi(g1.z), bflo(g1.w), bfhi(g1.w)};
#pragma unroll
            for (int j = 0; j < 6; ++j) { const int d = 6 * cc + j; float x = gb[d];
#pragma unroll
                for (int r = 0; r < 16; ++r) x = fmaf(gl[r], GW[r * 48 + d], x);
                const float lg = (fminf(x, 0.f) - __logf(1.f + __expf(-fabsf(x)))) * (1.f / 16.f);
                As[t * 48 + d] = __expf(lg);
                if (PASSA) atomicAdd(&DS[d], lg); }
            const unsigned* kq = (const unsigned*)(pr + C_GK + h * 48 + 6 * cc);
#pragma unroll
            for (int j = 0; j < 3; ++j) { const unsigned wv = kq[j]; Ks[t * 48 + 6 * cc + 2 * j] = bflo(wv); Ks[t * 48 + 6 * cc + 2 * j + 1] = bfhi(wv); }
            if (!PASSA) { const unsigned* qq = (const unsigned*)(pr + C_GQ + h * 48 + 6 * cc);
#pragma unroll
                for (int j = 0; j < 3; ++j) { const unsigned wv = qq[j]; Qs[t * 48 + 6 * cc + 2 * j] = bflo(wv) * 0.14433756729740643f; Qs[t * 48 + 6 * cc + 2 * j + 1] = bfhi(wv) * 0.14433756729740643f; } }
            const u32x2* vp = (const u32x2*)(pr + C_GV + h * 96 + 12 * cc);
#pragma unroll
            for (int j = 0; j < 3; ++j) { const u32x2 wv = vp[j]; *(f32x4*)(Vs + t * 96 + 12 * cc + 4 * j) = (f32x4){bflo(wv.x), bfhi(wv.x), bflo(wv.y), bfhi(wv.y)}; } } }
        __syncthreads();
        for (int tl0 = 0; tl0 < n; tl0 += 4) {
            float po[4];
#pragma unroll
            for (int u = 0; u < 4; ++u) { const int tl = tl0 + u;
                const f32x4* kp = (const f32x4*)(Ks + tl * 48 + 12 * dg); const f32x4* ap = (const f32x4*)(As + tl * 48 + 12 * dg);
                const f32x4 k0 = kp[0], k1 = kp[1], k2 = kp[2], a0 = ap[0], a1 = ap[1], a2 = ap[2];
                const float vv = Vs[tl * 96 + vcol];
                const float kk[12] = {k0.x, k0.y, k0.z, k0.w, k1.x, k1.y, k1.z, k1.w, k2.x, k2.y, k2.z, k2.w};
                const float aa[12] = {a0.x, a0.y, a0.z, a0.w, a1.x, a1.y, a1.z, a1.w, a2.x, a2.y, a2.z, a2.w};
#pragma unroll
                for (int i = 0; i < 12; ++i) S[i] = fmaf(aa[i], S[i], kk[i] * vv);
                if (!PASSA) {
                    const f32x4* qp = (const f32x4*)(Qs + tl * 48 + 12 * dg); const f32x4 q0 = qp[0], q1 = qp[1], q2 = qp[2];
                    po[u] = q0.x * S[0] + q0.y * S[1] + q0.z * S[2] + q0.w * S[3] + q1.x * S[4] + q1.y * S[5] + q1.z * S[6] + q1.w * S[7] + q2.x * S[8] + q2.y * S[9] + q2.z * S[10] + q2.w * S[11]; } }
            if (!PASSA) {
#pragma unroll
                for (int u = 0; u < 4; ++u) po[u] += __shfl(po[u], (lane + 24) & 63);
#pragma unroll
                for (int u = 0; u < 4; ++u) po[u] += __shfl(po[u], (lane + 12) & 63);
                if (lane < 12) {
#pragma unroll
                    for (int u = 0; u < 4; ++u) Os[(tl0 + u) * 96 + vcol] = po[u]; } }
        }
        __syncthreads();
        if (!PASSA) { const int t = tid >> 3, cc = tid & 7;
          if (t < n) { const int row = row0 + c0 + t;
            const f32x4* op = (const f32x4*)(Os + t * 96 + 12 * cc); const f32x4 o0 = op[0], o1 = op[1], o2 = op[2];
            const float o[12] = {o0.x, o0.y, o0.z, o0.w, o1.x, o1.y, o1.z, o1.w, o2.x, o2.y, o2.z, o2.w};
            float q = 0.f;
#pragma unroll
            for (int i = 0; i < 12; ++i) q += o[i] * o[i];
            q += __shfl_xor(q, 1); q += __shfl_xor(q, 2); q += __shfl_xor(q, 4);
            const float rs = rsqrtf(q * (1.f / 96.f) + EPS);
            const u32x2* gp = (const u32x2*)(c.PROJ() + (size_t)row * NPROJ + C_GG + h * 96 + 12 * cc);
            u32x2* dst = (u32x2*)(c.XN() + (size_t)row * D + 640 + h * 96 + 12 * cc);
#pragma unroll
            for (int j = 0; j < 3; ++j) { const u32x2 gv = gp[j];
                const float r0 = o[4 * j] * rs * gng[12 * cc + 4 * j] * silu(bflo(gv.x)), r1 = o[4 * j + 1] * rs * gng[12 * cc + 4 * j + 1] * silu(bfhi(gv.x));
                const float r2 = o[4 * j + 2] * rs * gng[12 * cc + 4 * j + 2] * silu(bflo(gv.y)), r3 = o[4 * j + 3] * rs * gng[12 * cc + 4 * j + 3] * silu(bfhi(gv.y));
                u32x2 wv; wv.x = pk2(r0, r1); wv.y = pk2(r2, r3); dst[j] = wv; } } }
    }
    if (PASSA) { float* E = c.SEG() + SEG_GLA / 4 + (size_t)((b * 4 + h) * (NSEG - 1) + seg) * 4672;
        if (lane < 48) {
#pragma unroll
            for (int i = 0; i < 12; ++i) E[(12 * dg + i) * 96 + vcol] = S[i]; }
        if (tid < 48) E[4608 + tid] = DS[tid]; }
    else if (sample || seg == NSEG - 1) {
        float* so = c.out() + (sample ? O_GLAS + ((size_t)(l * DB + b) * 4 + h) * 4608 : O_GLAP + ((size_t)(l * NB + b) * 4 + h) * 4608);
        if (lane < 48) {
#pragma unroll
            for (int i = 0; i < 12; ++i) so[(12 * dg + i) * 96 + vcol] = S[i]; } }
}

template <bool GLA, bool PASSA>
__device__ __forceinline__ void lin_task(const Ctx& c, int l, int b, int h, int seg, float* L) {
    typedef short bf16x8_t __attribute__((ext_vector_type(8)));
    constexpr int DK = GLA ? 48 : 64, DV = GLA ? 96 : 64, NVT = DV / 16, NT = GLA ? 3 : 2, RS = 72;
    const int tid = c.tid, lane = c.lane, w = c.wave, fr = lane & 15, fq = lane >> 4;
    const int row0 = b * SEQ + seg * LSEG;
    bf16* QT = (bf16*)L; bf16* KT = QT + 64 * RS; bf16* KH = KT + 64 * RS; bf16* VT = KH + 64 * RS; bf16* PP = VT + 96 * RS; bf16* ST = PP + 64 * RS;
    float* Os = (float*)(ST + 96 * RS); float* LG = Os + 64 * 96; float* SEGS = LG + 64 * 48; float* BEND = SEGS + 8 * 48; float* GW = BEND + 64;
    const float gamma = 1.f - exp2f(-5.f - (float)h), lg2 = log2f(gamma);
    if (GLA) {
        for (int i = tid; i < 16 * RS; i += 512) KH[48 * RS + i] = 0;
        if (tid < 16) BEND[48 + tid] = 0.f;
    }
    pg8::f32x4 accS[NT];
#pragma unroll
    for (int i = 0; i < NT; ++i) { const int id = w * NT + i, dt = id / NVT, vt = id % NVT, d0 = 16 * dt + 4 * fq, v = 16 * vt + fr;
        accS[i] = (pg8::f32x4){0.f, 0.f, 0.f, 0.f};
        if (!PASSA) {
            if (!GLA) {
#pragma unroll
                for (int m = 0; m < NSEG - 1; ++m) { const float f = m < seg ? exp2f((float)(LSEG * (seg - 1 - m)) * lg2) : 0.f;
                    const float* E = c.SEG() + SEG_RET / 4 + (size_t)((b * 6 + h) * (NSEG - 1) + m) * 4096;
                    const f32x4 ev = *(const f32x4*)(E + v * 64 + d0);
#pragma unroll
                    for (int r = 0; r < 4; ++r) accS[i][r] += f * ev[r]; } }
            else if (d0 < 48) {
#pragma unroll
                for (int m = 0; m < NSEG - 1; ++m) { const float* E = c.SEG() + SEG_GLA / 4 + (size_t)((b * 4 + h) * (NSEG - 1) + m) * 4672;
                    const f32x4 dl4 = *(const f32x4*)(E + 4608 + d0), ev4 = *(const f32x4*)(E + v * 48 + d0);
#pragma unroll
                    for (int r = 0; r < 4; ++r) accS[i][r] = m < seg ? __expf(dl4[r]) * accS[i][r] + ev4[r] : accS[i][r]; } }
            u32x2 sv; sv.x = pk2(accS[i][0], accS[i][1]); sv.y = pk2(accS[i][2], accS[i][3]); *(u32x2*)(ST + v * RS + d0) = sv;
        } }
    float dlsum[6] = {0.f, 0.f, 0.f, 0.f, 0.f, 0.f};
    const float* gb = c.in(I_GGB) + l * 192 + h * 48;
    const int gt0 = w, gt1 = w + 8, gmt0 = gt0 / 3, gnt0 = gt0 % 3, gmt1 = (gt1 < 12 ? gt1 : 0) / 3, gnt1 = (gt1 < 12 ? gt1 : 0) % 3;
    bf16x8_t gwf0 = {0, 0, 0, 0, 0, 0, 0, 0}, gwf1 = {0, 0, 0, 0, 0, 0, 0, 0};
    if (GLA && fq < 2) { const float* gw = c.in(I_GGW) + (size_t)(l * 16 + 8 * fq) * 192 + h * 48 + fr;
        float t0[8], t1[8];
#pragma unroll
        for (int j = 0; j < 8; ++j) { t0[j] = gw[(size_t)j * 192 + 16 * gnt0]; t1[j] = gw[(size_t)j * 192 + 16 * gnt1]; }
        u32x4 a = {pk2(t0[0], t0[1]), pk2(t0[2], t0[3]), pk2(t0[4], t0[5]), pk2(t0[6], t0[7])}, bq = {pk2(t1[0], t1[1]), pk2(t1[2], t1[3]), pk2(t1[4], t1[5]), pk2(t1[6], t1[7])};
        gwf0 = __builtin_bit_cast(bf16x8_t, a); gwf1 = __builtin_bit_cast(bf16x8_t, bq); }
    __syncthreads();
    const int t = tid >> 3, cc = tid & 7;
    u32x2 r_klo, r_khi, r_qlo, r_qhi; u32x4 r_v4, r_g4; f32x4 r_cs, r_sn;
    u32x4 r_glr0 = {0u, 0u, 0u, 0u}, r_glr1 = {0u, 0u, 0u, 0u}; unsigned r_k[3], r_q[3]; u32x2 r_v2[3], r_g2[3];
#define LIN_LOAD(cn) do { const bf16* pr_ = c.PROJ() + (size_t)(row0 + (cn) + t) * NPROJ; \
        if (!GLA) { const float* rc_ = c.ROPE() + (size_t)(seg * LSEG + (cn) + t) * 32 + 4 * cc; r_cs = *(const f32x4*)rc_; r_sn = *(const f32x4*)(rc_ + 2052 * 32); \
            r_klo = *(const u32x2*)(pr_ + C_RK + h * 64 + 4 * cc); r_khi = *(const u32x2*)(pr_ + C_RK + h * 64 + 32 + 4 * cc); r_v4 = *(const u32x4*)(pr_ + C_RV + h * 64 + 8 * cc); \
            if (!PASSA) { r_qlo = *(const u32x2*)(pr_ + C_RQ + h * 64 + 4 * cc); r_qhi = *(const u32x2*)(pr_ + C_RQ + h * 64 + 32 + 4 * cc); r_g4 = *(const u32x4*)(pr_ + C_RG + h * 64 + 8 * cc); } } \
        else { if (fq < 2) { r_glr0 = *(const u32x4*)(c.PROJ() + (size_t)(row0 + (cn) + 16 * gmt0 + fr) * NPROJ + C_GLR + 8 * fq); if (gt1 < 12) r_glr1 = *(const u32x4*)(c.PROJ() + (size_t)(row0 + (cn) + 16 * gmt1 + fr) * NPROJ + C_GLR + 8 * fq); } \
            _Pragma("unroll") for (int j_ = 0; j_ < 3; ++j_) { r_k[j_] = ((const unsigned*)(pr_ + C_GK + h * 48 + 6 * cc))[j_]; r_v2[j_] = ((const u32x2*)(pr_ + C_GV + h * 96 + 12 * cc))[j_]; \
                if (!PASSA) { r_q[j_] = ((const unsigned*)(pr_ + C_GQ + h * 48 + 6 * cc))[j_]; r_g2[j_] = ((const u32x2*)(pr_ + C_GG + h * 96 + 12 * cc))[j_]; } } } } while (0)
    LIN_LOAD(0);
    for (int c0 = 0; c0 < LSEG; c0 += 64) {
        u32x4 g4c = {0u, 0u, 0u, 0u}; u32x2 g2c[3] = {{0u, 0u}, {0u, 0u}, {0u, 0u}};
        if (!PASSA) { if (!GLA) g4c = r_g4; else { g2c[0] = r_g2[0]; g2c[1] = r_g2[1]; g2c[2] = r_g2[2]; } }
        if (!GLA) {
            const f32x4 cs = r_cs, sn = r_sn;
            const float eq = __builtin_amdgcn_exp2f((float)(t + 1) * lg2), ek = __builtin_amdgcn_exp2f(-(float)(t + 1) * lg2) * 0.125f, eh = __builtin_amdgcn_exp2f((float)(63 - t) * lg2) * 0.125f;
            { const u32x2 lo = r_klo, hi = r_khi;
              const f32x4 x1 = {bflo(lo.x), bfhi(lo.x), bflo(lo.y), bfhi(lo.y)}, x2 = {bflo(hi.x), bfhi(hi.x), bflo(hi.y), bfhi(hi.y)};
              const f32x4 k1 = x1 * cs - x2 * sn, k2 = x1 * sn + x2 * cs;
              if (!PASSA) { u32x2 a; a.x = pk2(k1.x * ek, k1.y * ek); a.y = pk2(k1.z * ek, k1.w * ek); *(u32x2*)(KT + t * RS + 4 * cc) = a;
                            u32x2 bq; bq.x = pk2(k2.x * ek, k2.y * ek); bq.y = pk2(k2.z * ek, k2.w * ek); *(u32x2*)(KT + t * RS + 32 + 4 * cc) = bq; }
#pragma unroll
              for (int e = 0; e < 4; ++e) { KH[(4 * cc + e) * RS + t] = (bf16)f2bf(k1[e] * eh); KH[(32 + 4 * cc + e) * RS + t] = (bf16)f2bf(k2[e] * eh); } }
            if (!PASSA) { const u32x2 lo = r_qlo, hi = r_qhi;
              const f32x4 x1 = {bflo(lo.x), bfhi(lo.x), bflo(lo.y), bfhi(lo.y)}, x2 = {bflo(hi.x), bfhi(hi.x), bflo(hi.y), bfhi(hi.y)};
              const f32x4 q1 = (x1 * cs - x2 * sn) * eq, q2 = (x1 * sn + x2 * cs) * eq;
              u32x2 a; a.x = pk2(q1.x, q1.y); a.y = pk2(q1.z, q1.w); *(u32x2*)(QT + t * RS + 4 * cc) = a;
              u32x2 bq; bq.x = pk2(q2.x, q2.y); bq.y = pk2(q2.z, q2.w); *(u32x2*)(QT + t * RS + 32 + 4 * cc) = bq; }
            { const unsigned vw[4] = {r_v4.x, r_v4.y, r_v4.z, r_v4.w};
#pragma unroll
              for (int e = 0; e < 4; ++e) { VT[(8 * cc + 2 * e) * RS + t] = (bf16)(vw[e] & 0xffffu); VT[(8 * cc + 2 * e + 1) * RS + t] = (bf16)(vw[e] >> 16); } }
            if (c0 + 64 < LSEG) LIN_LOAD(c0 + 64);
        } else {
            float kf[6], qf[6]; unsigned vw[6];
            { { const pg8::f32x4 z4 = {0.f, 0.f, 0.f, 0.f};
                const pg8::f32x4 x0 = __builtin_amdgcn_mfma_f32_16x16x32_bf16(__builtin_bit_cast(bf16x8_t, r_glr0), gwf0, z4, 0, 0, 0);
                const float b0 = gb[16 * gnt0 + fr];
#pragma unroll
                for (int j = 0; j < 4; ++j) { const float x = x0[j] + b0; LG[(16 * gmt0 + 4 * fq + j) * 48 + 16 * gnt0 + fr] = (fminf(x, 0.f) - __logf(1.f + __expf(-fabsf(x)))) * (1.f / 16.f); }
                if (gt1 < 12) { const pg8::f32x4 x1 = __builtin_amdgcn_mfma_f32_16x16x32_bf16(__builtin_bit_cast(bf16x8_t, r_glr1), gwf1, z4, 0, 0, 0);
                    const float b1 = gb[16 * gnt1 + fr];
#pragma unroll
                    for (int j = 0; j < 4; ++j) { const float x = x1[j] + b1; LG[(16 * gmt1 + 4 * fq + j) * 48 + 16 * gnt1 + fr] = (fminf(x, 0.f) - __logf(1.f + __expf(-fabsf(x)))) * (1.f / 16.f); } } }
#pragma unroll
              for (int j = 0; j < 3; ++j) { const unsigned wv = r_k[j]; kf[2 * j] = bflo(wv); kf[2 * j + 1] = bfhi(wv); }
              if (!PASSA) {
#pragma unroll
                  for (int j = 0; j < 3; ++j) { const unsigned wv = r_q[j]; qf[2 * j] = bflo(wv) * 0.14433756729740643f; qf[2 * j + 1] = bfhi(wv) * 0.14433756729740643f; } }
#pragma unroll
              for (int j = 0; j < 3; ++j) { vw[2 * j] = r_v2[j].x; vw[2 * j + 1] = r_v2[j].y; } }
            if (c0 + 64 < LSEG) LIN_LOAD(c0 + 64);
            __syncthreads();
            if (tid < 384) { const int d = tid % 48, sg = tid / 48; float lv[8];
#pragma unroll
                for (int i = 0; i < 8; ++i) lv[i] = LG[(8 * sg + i) * 48 + d];
#pragma unroll
                for (int i = 1; i < 8; ++i) lv[i] += lv[i - 1];
#pragma unroll
                for (int i = 0; i < 8; ++i) LG[(8 * sg + i) * 48 + d] = lv[i];
                SEGS[sg * 48 + d] = lv[7]; }
            __syncthreads();
            { float qv[6], kv[6];
#pragma unroll
              for (int j = 0; j < 6; ++j) { const int d = 6 * cc + j; float pre = 0.f, tot = 0.f;
#pragma unroll
                for (int s = 0; s < 8; ++s) { const float sv = SEGS[s * 48 + d]; tot += sv; if (s < (t >> 3)) pre += sv; }
                pre += LG[t * 48 + d];
                if (!PASSA) { qv[j] = qf[j] * __expf(pre); kv[j] = kf[j] * __expf(-pre); }
                KH[d * RS + t] = (bf16)f2bf(kf[j] * __expf(tot - pre));
                if (t == 0) { BEND[d] = tot; dlsum[j] += tot; } }
              if (!PASSA) {
#pragma unroll
                for (int j = 0; j < 3; ++j) { *(unsigned*)(QT + t * RS + 6 * cc + 2 * j) = pk2(qv[2 * j], qv[2 * j + 1]); *(unsigned*)(KT + t * RS + 6 * cc + 2 * j) = pk2(kv[2 * j], kv[2 * j + 1]); } } }
            if (!PASSA) { *(unsigned*)(QT + t * RS + 48 + 2 * cc) = 0u; *(unsigned*)(KT + t * RS + 48 + 2 * cc) = 0u; }
#pragma unroll
            for (int e = 0; e < 6; ++e) { VT[(12 * cc + 2 * e) * RS + t] = (bf16)(vw[e] & 0xffffu); VT[(12 * cc + 2 * e + 1) * RS + t] = (bf16)(vw[e] >> 16); }
        }
        __syncthreads();
        __builtin_amdgcn_s_setprio(1);
        if (!PASSA) {
#pragma unroll
            for (int i = 0; i < 2; ++i) { const int id = 2 * w + i, it = id >> 2, jt = id & 3;
                pg8::f32x4 acc = {0.f, 0.f, 0.f, 0.f};
                if (jt <= it) {
#pragma unroll
                    for (int ks = 0; ks < 2; ++ks) { const bf16x8_t a = *(const bf16x8_t*)(KT + (16 * jt + fr) * RS + 32 * ks + 8 * fq), bq = *(const bf16x8_t*)(QT + (16 * it + fr) * RS + 32 * ks + 8 * fq);
                        acc = __builtin_amdgcn_mfma_f32_16x16x32_bf16(a, bq, acc, 0, 0, 0); } }
                { const int ii = 16 * it + fr, j0 = 16 * jt + 4 * fq;
                  u32x2 pw; pw.x = pk2(j0 <= ii ? acc[0] : 0.f, j0 + 1 <= ii ? acc[1] : 0.f); pw.y = pk2(j0 + 2 <= ii ? acc[2] : 0.f, j0 + 3 <= ii ? acc[3] : 0.f);
                  *(u32x2*)(PP + ii * RS + j0) = pw; } } }
#pragma unroll
        for (int i = 0; i < NT; ++i) { const int id = w * NT + i, dt = id / NVT, vt = id % NVT;
            if (GLA) {
#pragma unroll
                for (int r = 0; r < 4; ++r) accS[i][r] *= __expf(BEND[16 * dt + 4 * fq + r]); }
            else { const float g64 = exp2f(64.f * lg2); accS[i] = accS[i] * g64; }
#pragma unroll
            for (int ks = 0; ks < 2; ++ks) { const bf16x8_t a = *(const bf16x8_t*)(KH + (16 * dt + fr) * RS + 32 * ks + 8 * fq), bv = *(const bf16x8_t*)(VT + (16 * vt + fr) * RS + 32 * ks + 8 * fq);
                accS[i] = __builtin_amdgcn_mfma_f32_16x16x32_bf16(a, bv, accS[i], 0, 0, 0); } }
        __builtin_amdgcn_s_setprio(0);
        __syncthreads();
        __builtin_amdgcn_s_setprio(1);
        if (!PASSA) {
#pragma unroll
            for (int i = 0; i < NT; ++i) { const int id = w * NT + i, it = id / NVT, vt = id % NVT;
                pg8::f32x4 acc = {0.f, 0.f, 0.f, 0.f};
#pragma unroll
                for (int ks = 0; ks < 2; ++ks) { const bf16x8_t a = *(const bf16x8_t*)(PP + (16 * it + fr) * RS + 32 * ks + 8 * fq), bv = *(const bf16x8_t*)(VT + (16 * vt + fr) * RS + 32 * ks + 8 * fq);
                    acc = __builtin_amdgcn_mfma_f32_16x16x32_bf16(a, bv, acc, 0, 0, 0); }
#pragma unroll
                for (int ks = 0; ks < 2; ++ks) { const bf16x8_t a = *(const bf16x8_t*)(QT + (16 * it + fr) * RS + 32 * ks + 8 * fq), bs = *(const bf16x8_t*)(ST + (16 * vt + fr) * RS + 32 * ks + 8 * fq);
                    acc = __builtin_amdgcn_mfma_f32_16x16x32_bf16(a, bs, acc, 0, 0, 0); }
#pragma unroll
                for (int r = 0; r < 4; ++r) Os[(16 * it + 4 * fq + r) * DV + 16 * vt + fr] = acc[r]; } }
        __builtin_amdgcn_s_setprio(0);
        __syncthreads();
        if (!PASSA) {
#pragma unroll
            for (int i = 0; i < NT; ++i) { const int id = w * NT + i, dt = id / NVT, vt = id % NVT, d0 = 16 * dt + 4 * fq, v = 16 * vt + fr;
                u32x2 sv; sv.x = pk2(accS[i][0], accS[i][1]); sv.y = pk2(accS[i][2], accS[i][3]); *(u32x2*)(ST + v * RS + d0) = sv; }
            const int row = row0 + c0 + t;
            if (!GLA) {
                const f32x4 o0 = *(const f32x4*)(Os + t * 64 + 8 * cc), o1 = *(const f32x4*)(Os + t * 64 + 8 * cc + 4);
                float o[8] = {o0.x, o0.y, o0.z, o0.w, o1.x, o1.y, o1.z, o1.w};
                float s = 0.f;
#pragma unroll
                for (int i = 0; i < 8; ++i) s += o[i];
                s += __shfl_xor(s, 1); s += __shfl_xor(s, 2); s += __shfl_xor(s, 4);
                const float mu = s * (1.f / 64.f); float q = 0.f;
#pragma unroll
                for (int i = 0; i < 8; ++i) { o[i] -= mu; q += o[i] * o[i]; }
                q += __shfl_xor(q, 1); q += __shfl_xor(q, 2); q += __shfl_xor(q, 4);
                const float rstd = rsqrtf(q * (1.f / 64.f) + EPS);
                const float* rg_g = c.in(I_RNG) + l * 384 + h * 64; const float* rg_b = c.in(I_RNB) + l * 384 + h * 64;
                const u32x4 gv = g4c;
                const float gt[8] = {bflo(gv.x), bfhi(gv.x), bflo(gv.y), bfhi(gv.y), bflo(gv.z), bfhi(gv.z), bflo(gv.w), bfhi(gv.w)};
                float r[8];
#pragma unroll
                for (int i = 0; i < 8; ++i) r[i] = (o[i] * rstd * rg_g[8 * cc + i] + rg_b[8 * cc + i]) * silu(gt[i]);
                u32x4 wv; wv.x = pk2(r[0], r[1]); wv.y = pk2(r[2], r[3]); wv.z = pk2(r[4], r[5]); wv.w = pk2(r[6], r[7]);
                *(u32x4*)(c.XN() + (size_t)row * D + h * 64 + 8 * cc) = wv;
            } else {
                const float* gng = c.in(I_GNG) + l * 96;
                const f32x4* op = (const f32x4*)(Os + t * 96 + 12 * cc); const f32x4 o0 = op[0], o1 = op[1], o2 = op[2];
                const float o[12] = {o0.x, o0.y, o0.z, o0.w, o1.x, o1.y, o1.z, o1.w, o2.x, o2.y, o2.z, o2.w};
                float q = 0.f;
#pragma unroll
                for (int i = 0; i < 12; ++i) q += o[i] * o[i];
                q += __shfl_xor(q, 1); q += __shfl_xor(q, 2); q += __shfl_xor(q, 4);
                const float rs = rsqrtf(q * (1.f / 96.f) + EPS);
                u32x2* dst = (u32x2*)(c.XN() + (size_t)row * D + 640 + h * 96 + 12 * cc);
#pragma unroll
                for (int j = 0; j < 3; ++j) { const u32x2 gv = g2c[j];
                    const float r0 = o[4 * j] * rs * gng[12 * cc + 4 * j] * silu(bflo(gv.x)), r1 = o[4 * j + 1] * rs * gng[12 * cc + 4 * j + 1] * silu(bfhi(gv.x));
                    const float r2 = o[4 * j + 2] * rs * gng[12 * cc + 4 * j + 2] * silu(bflo(gv.y)), r3 = o[4 * j + 3] * rs * gng[12 * cc + 4 * j + 3] * silu(bfhi(gv.y));
                    u32x2 wv; wv.x = pk2(r0, r1); wv.y = pk2(r2, r3); dst[j] = wv; }
            }
        }
    }
    if (PASSA || seg == NSEG - 1) {
        float* E = PASSA ? c.SEG() + (GLA ? SEG_GLA / 4 + (size_t)((b * 4 + h) * (NSEG - 1) + seg) * 4672 : SEG_RET / 4 + (size_t)((b * 6 + h) * (NSEG - 1) + seg) * 4096)
                         : c.out() + (GLA ? O_GLAP + ((size_t)(l * NB + b) * 4 + h) * 4608 : O_RETP + ((size_t)(l * NB + b) * 6 + h) * 4096);
#pragma unroll
        for (int i = 0; i < NT; ++i) { const int id = w * NT + i, dt = id / NVT, vt = id % NVT, d0 = 16 * dt + 4 * fq, v = 16 * vt + fr;
            if (d0 < DK) {
                if (PASSA) *(f32x4*)(E + v * DK + d0) = (f32x4){accS[i][0], accS[i][1], accS[i][2], accS[i][3]};
                else {
#pragma unroll
                    for (int r = 0; r < 4; ++r) E[(d0 + r) * DV + v] = accS[i][r]; } } }
        if (GLA && PASSA && tid < 8) {
#pragma unroll
            for (int j = 0; j < 6; ++j) E[4608 + 6 * tid + j] = dlsum[j]; }
    }
}

template <bool PASSA>
__device__ __forceinline__ void s5_task(const Ctx& c, int l, bool sample, int b, int oct, int seg, float* L) {
    typedef short bf16x8_t __attribute__((ext_vector_type(8)));
    const int tid = c.tid, lane = c.lane, w = c.wave, fr = lane & 15, fq = lane >> 4;
    const int g = 8 * oct + w, p = lane;
    const int len = sample ? 64 : LSEG5;
    const int row0 = sample ? TP + b * 64 : b * SEQ + seg * LSEG5;
    constexpr int HS = 136;
    bf16* Ub = (bf16*)L;
    float* Xw = L + 4096 + w * 2048;
    bf16* Hw = (bf16*)(L + 20480) + w * (16 * HS);
    float ar, ai;
    bf16x8_t bx[8], cb[4];
    { const int gp = (l * 16 + g) * 64 + p;
      const float lr = fminf(c.in(I_LRE)[gp], -1e-4f), li = c.in(I_LIM)[gp], dt = expf(c.in(I_LDT)[l * 16 + g]);
      const float mag = expf(lr * dt), ang = li * dt; ar = mag * cosf(ang); ai = mag * sinf(ang);
      const float den = lr * lr + li * li, cr = ((ar - 1.f) * lr + ai * li) / den, ci = (ai * lr - (ar - 1.f) * li) / den;
#pragma unroll
      for (int n = 0; n < 8; ++n) { const int ps = 16 * (n & 3) + fr; const float crs = __shfl(cr, ps), cis = __shfl(ci, ps);
          u32x4 t4 = {0u, 0u, 0u, 0u};
          if (fq < 2) { const float* brp = c.in(I_BRE) + ((size_t)((l * 16 + g) * 64 + ps)) * 16 + 8 * fq; const float* bip = c.in(I_BIM) + ((size_t)((l * 16 + g) * 64 + ps)) * 16 + 8 * fq;
              const f32x4 r0 = *(const f32x4*)brp, r1 = *(const f32x4*)(brp + 4), i0 = *(const f32x4*)bip, i1 = *(const f32x4*)(bip + 4);
              float v[8];
#pragma unroll
              for (int e = 0; e < 4; ++e) { v[e] = n < 4 ? crs * r0[e] - cis * i0[e] : crs * i0[e] + cis * r0[e]; v[4 + e] = n < 4 ? crs * r1[e] - cis * i1[e] : crs * i1[e] + cis * r1[e]; }
              t4 = (u32x4){pk2(v[0], v[1]), pk2(v[2], v[3]), pk2(v[4], v[5]), pk2(v[6], v[7])}; }
          bx[n] = __builtin_bit_cast(bf16x8_t, t4); }
      if (!PASSA) {
#pragma unroll
          for (int s = 0; s < 4; ++s) { const float* src = (s < 2 ? c.in(I_CRE) : c.in(I_CIM)) + (size_t)((l * 16 + g) * 16 + fr) * 64 + 32 * (s & 1) + 8 * fq;
              const f32x4 v0 = *(const f32x4*)src, v1 = *(const f32x4*)(src + 4); const float sg = s < 2 ? 1.f : -1.f;
              u32x4 t4 = {pk2(sg * v0.x, sg * v0.y), pk2(sg * v0.z, sg * v0.w), pk2(sg * v1.x, sg * v1.y), pk2(sg * v1.z, sg * v1.w)}; cb[s] = __builtin_bit_cast(bf16x8_t, t4); } }
    }
    float hr = 0.f, hi = 0.f;
    float s0r[16], s0i[16];
    if (sample) {
#pragma unroll
        for (int j = 0; j < 16; ++j) { s0r[j] = c.in(I_S5R)[(size_t)(l * DB + 16 * b + j) * 1024 + g * 64 + p]; s0i[j] = c.in(I_S5I)[(size_t)(l * DB + 16 * b + j) * 1024 + g * 64 + p]; } }
    else {
        if (!PASSA && seg > 0) { float pr = ar, pi = ai;
#pragma unroll
            for (int k = 0; k < LOG2_LSEG5; ++k) { const float nr = pr * pr - pi * pi, ni = 2.f * pr * pi; pr = nr; pi = ni; }
            float er[NSEG5 - 1], ei[NSEG5 - 1];
#pragma unroll
            for (int m = 0; m < NSEG5 - 1; ++m) { const float* E = c.SEG() + SEG_S5 / 4 + (size_t)(b * (NSEG5 - 1) + m) * 2048 + g * 64 + p; er[m] = E[0]; ei[m] = E[1024]; }
#pragma unroll
            for (int m = 0; m < NSEG5 - 1; ++m) { if (m < seg) { const float nr = pr * hr - pi * hi + er[m], ni = pr * hi + pi * hr + ei[m]; hr = nr; hi = ni; } } }
    }
    static_assert(LSEG5 == (1 << LOG2_LSEG5), "A^LSEG5 squaring count");
    const float dval = c.in(I_S5D)[l * 256 + 128 * oct + 16 * w + fr];
    for (int c0 = 0; c0 < len; c0 += 64) {
        const int n = (len - c0) < 64 ? (len - c0) : 64;
        { const int t = tid >> 3, cc = tid & 7;
          if (t < n) { const bf16* pr = c.PROJ() + (size_t)(row0 + c0 + t) * NPROJ + C_SU + 128 * oct + 16 * cc;
            const u32x4 u0 = *(const u32x4*)pr, u1 = *(const u32x4*)(pr + 8);
            *(u32x4*)(Ub + t * 128 + 16 * cc) = u0; *(u32x4*)(Ub + t * 128 + 16 * cc + 8) = u1; } }
        __syncthreads();
#pragma unroll
        for (int tb = 0; tb < 64; tb += 16) { if (tb >= n) break;
            const int nb = (n - tb) < 16 ? (n - tb) : 16;
            { bf16x8_t a = {0, 0, 0, 0, 0, 0, 0, 0};
              if (fq < 2) a = *(const bf16x8_t*)(Ub + (tb + fr) * 128 + 16 * w + 8 * fq);
              __builtin_amdgcn_s_setprio(1);
#pragma unroll
              for (int n8 = 0; n8 < 8; ++n8) { const pg8::f32x4 z4 = {0.f, 0.f, 0.f, 0.f};
                  const pg8::f32x4 xa = __builtin_amdgcn_mfma_f32_16x16x32_bf16(a, bx[n8], z4, 0, 0, 0);
#pragma unroll
                  for (int j = 0; j < 4; ++j) Xw[(4 * fq + j) * 128 + 16 * n8 + fr] = xa[j]; } }
            __builtin_amdgcn_s_setprio(0);
            asm volatile("s_waitcnt lgkmcnt(0)" ::: "memory");
#pragma unroll
            for (int tt = 0; tt < 16; ++tt) { if (tt >= nb) break;
                if (sample && (tt & 3) == 0) { hr = s0r[(tb + tt) >> 2]; hi = s0i[(tb + tt) >> 2]; }
                typedef float f32x2 __attribute__((ext_vector_type(2)));
                f32x2 hn = (f32x2){Xw[tt * 128 + p], Xw[tt * 128 + 64 + p]} + (f32x2){hr, hi} * ar;
                hn += (f32x2){-hi, hr} * ai; hr = hn.x; hi = hn.y;
                if (!PASSA && sample && (tt & 3) == 3) { const size_t so = (size_t)(l * DB + 16 * b + ((tb + tt) >> 2)) * 1024 + g * 64 + p; c.out()[O_S5RS + so] = hr; c.out()[O_S5IS + so] = hi; }
                if (!PASSA) { const unsigned hh = pk2(hr, hi); Hw[tt * HS + p] = (bf16)(hh & 0xffffu); Hw[tt * HS + 64 + p] = (bf16)(hh >> 16); }
            }
            if (!PASSA) {
                asm volatile("s_waitcnt lgkmcnt(0)" ::: "memory");
                pg8::f32x4 acc = {0.f, 0.f, 0.f, 0.f};
#pragma unroll
                for (int s = 0; s < 4; ++s) { const bf16x8_t a = *(const bf16x8_t*)(Hw + fr * HS + 32 * s + 8 * fq);
                    acc = __builtin_amdgcn_mfma_f32_16x16x32_bf16(a, cb[s], acc, 0, 0, 0); }
#pragma unroll
                for (int j = 0; j < 4; ++j) { const int tq = 4 * fq + j;
                    if (tq < nb) { const int t = tb + tq; const float u = bflo((unsigned)Ub[t * 128 + 16 * w + fr]);
                        c.Y5()[(size_t)(row0 + c0 + t) * 256 + 128 * oct + 16 * w + fr] = (bf16)f2bf(gelu_tanh(acc[j] + dval * u)); } }
            }
            asm volatile("s_waitcnt lgkmcnt(0)" ::: "memory");
        }
        __syncthreads();
    }
    if (PASSA) { float* E = c.SEG() + SEG_S5 / 4 + (size_t)(b * (NSEG5 - 1) + seg) * 2048 + g * 64 + p; E[0] = hr; E[1024] = hi; }
    else if (sample) { }
    else if (seg == NSEG5 - 1) { c.out()[O_S5RP + (size_t)(l * NB + b) * 1024 + g * 64 + p] = hr; c.out()[O_S5IP + (size_t)(l * NB + b) * 1024 + g * 64 + p] = hi; }
}

__device__ __forceinline__ void ret_sample_wave(const Ctx& c, int l, int b, int h) {
    const int lane = c.lane, f = lane & 31;
    const float gamma = 1.f - exp2f(-5.f - (float)h);
    float S[64];
    const float* s0 = c.in(I_SRET) + ((size_t)((l * DB + b) * 6 + h) * 64) * 64 + lane;
#pragma unroll
    for (int d = 0; d < 64; ++d) { S[d] = s0[d * 64]; if ((d & 15) == 15) asm volatile("" ::: "memory"); }
    const float ng = c.in(I_RNG)[l * 384 + h * 64 + lane], nb = c.in(I_RNB)[l * 384 + h * 64 + lane];
#pragma unroll 1
    for (int t = 0; t < DSEQ; ++t) {
        const int row = TP + b * DSEQ + t;
        const bf16* pr = c.PROJ() + (size_t)row * NPROJ;
        const float cs = c.ROPE()[(2048 + t) * 32 + f], sn = c.ROPE()[2052 * 32 + (2048 + t) * 32 + f];
        const float ka = bflo((unsigned)pr[C_RK + h * 64 + f]), kb = bflo((unsigned)pr[C_RK + h * 64 + 32 + f]);
        const float qa = bflo((unsigned)pr[C_RQ + h * 64 + f]), qb = bflo((unsigned)pr[C_RQ + h * 64 + 32 + f]);
        const float kk = (lane < 32 ? ka * cs - kb * sn : ka * sn + kb * cs) * 0.125f;
        const float qq = lane < 32 ? qa * cs - qb * sn : qa * sn + qb * cs;
        const float vv = bflo((unsigned)pr[C_RV + h * 64 + lane]), gt = bflo((unsigned)pr[C_RG + h * 64 + lane]);
        float o = 0.f;
#pragma unroll
        for (int d = 0; d < 64; ++d) { const float kd = rdl(kk, d), qd = rdl(qq, d); S[d] = fmaf(gamma, S[d], kd * vv); o = fmaf(qd, S[d], o); }
        const float mu = wave_sum(o) * (1.f / 64.f), dv = o - mu, rstd = rsqrtf(wave_sum(dv * dv) * (1.f / 64.f) + EPS);
        c.XN()[(size_t)row * D + h * 64 + lane] = (bf16)f2bf((dv * rstd * ng + nb) * silu(gt));
    }
    float* so = c.out() + O_RETS + ((size_t)(l * DB + b) * 6 + h) * 4096 + lane;
#pragma unroll
    for (int d = 0; d < 64; ++d) { so[d * 64] = S[d]; if ((d & 15) == 15) asm volatile("" ::: "memory"); }
}
__device__ __forceinline__ void gla_sample_wave(const Ctx& c, int l, int b, int h) {
    const int lane = c.lane, l2 = 64 + (lane & 31), dl = lane < 48 ? lane : 47;
    float S1[48], S2[48];
    const float* s0 = c.in(I_SGLA) + ((size_t)((l * DB + b) * 4 + h) * 48) * 96;
#pragma unroll
    for (int d = 0; d < 48; ++d) { S1[d] = s0[d * 96 + lane]; S2[d] = s0[d * 96 + l2]; if ((d & 3) == 3) asm volatile("" ::: "memory"); }
    const float* gwp = c.in(I_GGW) + (size_t)(l * 16) * 192 + h * 48 + dl;
    const float gbd = c.in(I_GGB)[l * 192 + h * 48 + dl];
    const float n1 = c.in(I_GNG)[l * 96 + lane], n2 = c.in(I_GNG)[l * 96 + l2];
#pragma unroll 1
    for (int t = 0; t < DSEQ; ++t) {
        const int row = TP + b * DSEQ + t;
        const bf16* pr = c.PROJ() + (size_t)row * NPROJ;
        const u32x4 g0 = *(const u32x4*)(pr + C_GLR), g1 = *(const u32x4*)(pr + C_GLR + 8);
        const float gl[16] = {bflo(g0.x), bfhi(g0.x), bflo(g0.y), bfhi(g0.y), bflo(g0.z), bfhi(g0.z), bflo(g0.w), bfhi(g0.w),
                              bflo(g1.x), bfhi(g1.x), bflo(g1.y), bfhi(g1.y), bflo(g1.z), bfhi(g1.z), bflo(g1.w), bfhi(g1.w)};
        float x = gbd;
#pragma unroll
        for (int r = 0; r < 16; ++r) x = fmaf(gl[r], gwp[r * 192], x);
        const float al = __expf((fminf(x, 0.f) - __logf(1.f + __expf(-fabsf(x)))) * (1.f / 16.f));
        const float kk = lane < 48 ? bflo((unsigned)pr[C_GK + h * 48 + dl]) : 0.f;
        const float qq = lane < 48 ? bflo((unsigned)pr[C_GQ + h * 48 + dl]) * 0.14433756729740643f : 0.f;
        const float v1 = bflo((unsigned)pr[C_GV + h * 96 + lane]), v2 = bflo((unsigned)pr[C_GV + h * 96 + l2]);
        const float t1 = bflo((unsigned)pr[C_GG + h * 96 + lane]), t2 = bflo((unsigned)pr[C_GG + h * 96 + l2]);
        float o1 = 0.f, o2 = 0.f;
#pragma unroll
        for (int d = 0; d < 48; ++d) { const float ad = rdl(al, d), kd = rdl(kk, d), qd = rdl(qq, d);
            S1[d] = fmaf(ad, S1[d], kd * v1); o1 = fmaf(qd, S1[d], o1); S2[d] = fmaf(ad, S2[d], kd * v2); o2 = fmaf(qd, S2[d], o2); }
        const float rs = rsqrtf(wave_sum(o1 * o1 + (lane < 32 ? o2 * o2 : 0.f)) * (1.f / 96.f) + EPS);
        bf16* dst = c.XN() + (size_t)row * D + 640 + h * 96;
        dst[lane] = (bf16)f2bf(o1 * rs * n1 * silu(t1));
        if (lane < 32) dst[l2] = (bf16)f2bf(o2 * rs * n2 * silu(t2));
    }
    float* so = c.out() + O_GLAS + ((size_t)(l * DB + b) * 4 + h) * 4608;
#pragma unroll
    for (int d = 0; d < 48; ++d) { so[d * 96 + lane] = S1[d]; if (lane < 32) so[d * 96 + l2] = S2[d]; if ((d & 3) == 3) asm volatile("" ::: "memory"); }
}

struct OneUnit {
    int pm, pn;
    __device__ bool next(int i, pg8::Unit& u) const { if (i != 0) return false; u.pm = pm; u.pn = pn; u.ko = 0; return true; }
    __device__ __forceinline__ void a_ready(const pg8::Unit&) const {}
    __device__ __forceinline__ void done(const pg8::Unit&) const {}
};
#define MIX_QUEUE_BEGIN(NTASK, CTR) \
    volatile __attribute__((address_space(3))) unsigned* qw_ = (volatile __attribute__((address_space(3))) unsigned*)((PG8_LAS unsigned char*)L_las + 143360 + 64); \
    unsigned* ctr_ = (unsigned*)c0_.ap->ws + (CTR); \
    int qi_ = 0; \
    for (int task = c0_.bx; task < (NTASK); ) { \
        Ctx c = c0_; asm volatile("" : "+v"(c.tid)); c.lane = c.tid & 63; c.wave = __builtin_amdgcn_readfirstlane(c.tid >> 6); \
        unsigned nxt_ = 0u; if (c.tid == 0) nxt_ = __hip_atomic_fetch_add(ctr_, 1u, __ATOMIC_RELAXED, __HIP_MEMORY_SCOPE_AGENT); \
        int r = task;
#define MIX_QUEUE_END() \
        __syncthreads(); \
        if (c.tid == 0) qw_[qi_] = nxt_ + (unsigned)c0_.G; \
        __syncthreads(); \
        task = (int)qw_[qi_]; qi_ ^= 1; }

__device__ __forceinline__ void mixA_phase(const Ctx& c0_, int l, float* L, PG8_LAS unsigned char* L_las) {
    constexpr int NS = NSEG - 1, NS5 = NSEG5 - 1;
    constexpr int NQ = 24, NG = NB * NS * 4, N5 = NB * NS5 * 2, NR = NB * NS * 6;
    MIX_QUEUE_BEGIN(NQ + NG + N5 + NR, 8192 + 64 * (2 * l))
        if (r < NQ) {
            pg8::Gemm g{c.XN(), c.W1T(), MR, NPROJ, D, D, 256}; OneUnit S{TP / 256 + r / 12, r % 12};
            pg8::EpiBf16<0> E{c.PROJ(), NPROJ, nullptr, 0, 0, 1.f};
            pg8::gemm_phase<pg8::EpiBf16<0>, OneUnit, true, true>(L_las, g, S, E); }
        else if ((r -= NQ) < NG) { const int h = r % 4, seg = (r / 4) % NS, b = r / (4 * NS); lin_task<true, true>(c, l, b, h, seg, L); }
        else if ((r -= NG) < N5) { const int oct = r % 2, seg = (r / 2) % NS5, b = r / (2 * NS5); s5_task<true>(c, l, false, b, oct, seg, L); }
        else { r -= N5; const int h = r % 6, seg = (r / 6) % NS, b = r / (6 * NS); lin_task<false, true>(c, l, b, h, seg, L); }
    MIX_QUEUE_END()
}
__device__ __forceinline__ void mixC_phase(const Ctx& c0_, int l, float* L, PG8_LAS unsigned char* L_las) {
    constexpr int NG = NB * NSEG * 4, N5 = NB * NSEG5 * 2, NR = NB * NSEG * 6;
    constexpr int M5 = (TS / 64) * 2, MG = DB * 4 / 8, MRT = DB * 6 / 8;
    MIX_QUEUE_BEGIN(NG + N5 + NR + M5 + MG + MRT, 8192 + 64 * (2 * l + 1))
        if (r < NG) { const int h = r % 4, seg = (r / 4) % NSEG, b = r / (4 * NSEG); lin_task<true, false>(c, l, b, h, seg, L); }
        else if ((r -= NG) < N5) { const int oct = r % 2, seg = (r / 2) % NSEG5, b = r / (2 * NSEG5); s5_task<false>(c, l, false, b, oct, seg, L); }
        else if ((r -= N5) < NR) { const int h = r % 6, seg = (r / 6) % NSEG, b = r / (6 * NSEG); lin_task<false, false>(c, l, b, h, seg, L); }
        else if ((r -= NR) < M5) { s5_task<false>(c, l, true, r / 2, r % 2, 0, L); }
        else if ((r -= M5) < MG) { const int q = 8 * r + c.wave; gla_sample_wave(c, l, q / 4, q % 4); }
        else { r -= MG; const int q = 8 * r + c.wave; ret_sample_wave(c, l, q / 6, q % 6); }
    MIX_QUEUE_END()
}

__device__ __forceinline__ void act_phase(const Ctx& c, int l) {
    constexpr int JB = DFF / 8, RB = MR / 16;
    const int gt = c.bx * 512 + c.tid, ngt = c.G * 512;
    const float* cw = c.in(I_FCW) + (size_t)l * 3 * DFF; const float* cb = c.in(I_FCB) + (size_t)l * DFF;
    for (int it = gt; it < JB * RB; it += ngt) {
        const int jb = it % JB, rb = it / JB, j0 = 8 * jb, r0 = 16 * rb;
        float w0[8], w1[8], w2[8], bb[8];
#pragma unroll
        for (int e = 0; e < 8; ++e) { w0[e] = cw[j0 + e]; w1[e] = cw[DFF + j0 + e]; w2[e] = cw[2 * DFF + j0 + e]; bb[e] = cb[j0 + e]; }
        float x2[8], x1[8];
        const bool sample = r0 >= TP;
        for (int rr = 0; rr < 16; ++rr) {
            const int r = r0 + rr;
            const int t = sample ? ((r - TP) & 3) : (r & (SEQ - 1));
            if (rr == 0 || t == 0) {
                if (t >= 2) { const u32x4 a = *(const u32x4*)(c.ABUF() + (size_t)(r - 2) * DFF + j0), bq = *(const u32x4*)(c.ABUF() + (size_t)(r - 1) * DFF + j0);
                    x2[0] = bflo(a.x); x2[1] = bfhi(a.x); x2[2] = bflo(a.y); x2[3] = bfhi(a.y); x2[4] = bflo(a.z); x2[5] = bfhi(a.z); x2[6] = bflo(a.w); x2[7] = bfhi(a.w);
                    x1[0] = bflo(bq.x); x1[1] = bfhi(bq.x); x1[2] = bflo(bq.y); x1[3] = bfhi(bq.y); x1[4] = bflo(bq.z); x1[5] = bfhi(bq.z); x1[6] = bflo(bq.w); x1[7] = bfhi(bq.w); }
                else {
                    if (sample) { const float* cs = c.in(I_SCONV) + ((size_t)(l * DB + ((r - TP) >> 2)) * 2) * DFF + j0;
#pragma unroll
                        for (int e = 0; e < 8; ++e) { x2[e] = cs[e]; x1[e] = cs[DFF + e]; } }
                    else {
#pragma unroll
                        for (int e = 0; e < 8; ++e) { x2[e] = 0.f; x1[e] = 0.f; } } }
            }
            const u32x4 a = *(const u32x4*)(c.ABUF() + (size_t)r * DFF + j0);
            const u32x4 gq = *(const u32x4*)(c.GATE() + (size_t)r * DFF + j0);
            const float x0[8] = {bflo(a.x), bfhi(a.x), bflo(a.y), bfhi(a.y), bflo(a.z), bfhi(a.z), bflo(a.w), bfhi(a.w)};
            const float gv[8] = {bflo(gq.x), bfhi(gq.x), bflo(gq.y), bfhi(gq.y), bflo(gq.z), bfhi(gq.z), bflo(gq.w), bfhi(gq.w)};
            float o[8];
#pragma unroll
            for (int e = 0; e < 8; ++e) { const float cv = bb[e] + w0[e] * x2[e] + w1[e] * x1[e] + w2[e] * x0[e]; o[e] = gelu_tanh(cv) * gv[e]; x2[e] = x1[e]; x1[e] = x0[e]; }
            u32x4 wv; wv.x = pk2(o[0], o[1]); wv.y = pk2(o[2], o[3]); wv.z = pk2(o[4], o[5]); wv.w = pk2(o[6], o[7]);
            *(u32x4*)(c.GATE() + (size_t)r * DFF + j0) = wv;
        }
    }
}

#define XB_TMO      128
#define XB_XCNT(j)  (256  + 64 * (j))
#define XB_XSUB(j)  (1280 + 64 * (j))
#define XB_XGEN(j)  (2304 + 64 * (j))
#define XB_TOP      3328
#define XB_TOPGEN   3392
#define XCD_BAR_WORDS 3456
#define XB_SPIN_CAP (1u << 18)

__device__ __forceinline__ unsigned xb_ld(unsigned* p)              { return __hip_atomic_load(p, __ATOMIC_RELAXED, __HIP_MEMORY_SCOPE_AGENT); }
__device__ __forceinline__ unsigned xb_add(unsigned* p, unsigned v) { return __hip_atomic_fetch_add(p, v, __ATOMIC_RELAXED, __HIP_MEMORY_SCOPE_AGENT); }
__device__ __forceinline__ unsigned xb_xcc_id() { return (unsigned)__builtin_amdgcn_s_getreg((3 << 11) | 20) & 0xFu; }
#define XB_SPIN(cond, bar) do { unsigned _sp = 0; while (cond) { __builtin_amdgcn_s_sleep(1); \
    if ((++_sp & 255u) == 0u) { if (xb_ld(&(bar)[XB_TMO])) break; if (_sp > XB_SPIN_CAP) { atomicAdd(&(bar)[XB_TMO], 1u); break; } } } } while (0)

struct XcdBarrier {
    unsigned* bar; unsigned x;
    volatile __attribute__((address_space(3))) unsigned* st;
};

__device__ __forceinline__ XcdBarrier xcd_barrier_post(unsigned* bar, volatile __attribute__((address_space(3))) unsigned* st) {
    XcdBarrier b; b.bar = bar; b.x = xb_xcc_id(); b.st = st;
    if (threadIdx.x == 0) (void)xb_add(&bar[XB_XCNT(b.x)], 1u);
    return b;
}
__device__ __forceinline__ void xcd_barrier_complete(unsigned* bar, unsigned x, unsigned& nloc, unsigned& nx) {
    const unsigned G = gridDim.x * gridDim.y * gridDim.z;
    unsigned sum, cnt, mine, sp = 0u;
    for (;;) {
        sum = 0u; cnt = 0u; mine = 0u;
#pragma unroll
        for (unsigned j = 0; j < 16; ++j) { const unsigned c = xb_ld(&bar[XB_XCNT(j)]); sum += c; cnt += (c > 0u) ? 1u : 0u; mine = (j == x) ? c : mine; }
        if (sum == G) break;
        __builtin_amdgcn_s_sleep(1);
        if ((++sp & 255u) == 0u) { if (xb_ld(&bar[XB_TMO])) break; if (sp > XB_SPIN_CAP) { atomicAdd(&bar[XB_TMO], 1u); break; } }
    }
    nloc = mine > 0u ? mine : 1u; nx = cnt > 0u ? cnt : 1u;
}

__device__ __forceinline__ void xcd_barrier(const XcdBarrier& b) {
    asm volatile("s_waitcnt vmcnt(0)" ::: "memory");
    __syncthreads();
    if (threadIdx.x == 0) {
        unsigned* bar = b.bar;
        __builtin_amdgcn_s_waitcnt(0);
        unsigned nloc = b.st[0], nx = b.st[1];
        if (nloc == 0u) { xcd_barrier_complete(bar, b.x, nloc, nx); b.st[0] = nloc; b.st[1] = nx; }
        const unsigned old = xb_add(&bar[XB_XSUB(b.x)], 1u);
        const unsigned gen = old / nloc;
        if (old + 1u == (gen + 1u) * nloc) {
            __builtin_amdgcn_fence(__ATOMIC_RELEASE, "agent");
            asm volatile("s_waitcnt vmcnt(0)" ::: "memory");
            const unsigned og = xb_add(&bar[XB_TOP], 1u);
            const unsigned tg = og / nx;
            if (og + 1u == (tg + 1u) * nx) xb_add(&bar[XB_TOPGEN], 1u);
            else XB_SPIN(xb_ld(&bar[XB_TOPGEN]) == tg, bar);
            __builtin_amdgcn_fence(__ATOMIC_ACQUIRE, "agent");
            xb_add(&bar[XB_XGEN(b.x)], 1u);
            asm volatile("s_waitcnt vmcnt(0)" ::: "memory");
        } else {
            XB_SPIN(xb_ld(&bar[XB_XGEN(b.x)]) == gen, bar);
            __builtin_amdgcn_fence(__ATOMIC_ACQUIRE, "agent");
            asm volatile("s_waitcnt vmcnt(0)" ::: "memory");
        }
    }
    __syncthreads();
}

#define gsync(B) xcd_barrier(B)
template <int l>
__device__ __forceinline__ void layer_body(float* L, PG8_LAS unsigned char* ring, const XcdBarrier& grid) {

        { const Ctx c = mkctx(); prep_phase(c, l, L); }
        gsync(grid);
        {
            const Ctx c = mkctx();
            pg8::Gemm g{c.XN(), c.W1T(), TP, NPROJ, D, D, 256}; pg8::StaticOrder S; S.init(TP, NPROJ, c.G, c.bx);
            pg8::EpiBf16<0> E{c.PROJ(), NPROJ, nullptr, 0, 0, 1.f};
            pg8::gemm_phase<pg8::EpiBf16<0>, pg8::StaticOrder, true, true>(ring, g, S, E);
        }
        gsync(grid);
        if (NSEG > 1) { { const Ctx c = mkctx(); mixA_phase(c, l, L, ring); } gsync(grid); }
        { const Ctx c = mkctx(); mixC_phase(c, l, L, ring); }
        gsync(grid);
        {
            const Ctx c = mkctx();
            int kglu = 256; asm volatile("" : "+s"(kglu)); pg8::Gemm g{c.Y5(), c.GLUT(), MR, 256, 256, kglu, 256}; pg8::StaticOrder S; S.init(MR, 256, c.G, c.bx);
            EpiGlu E{c.Y5(), c.in(I_GLUB) + l * 256, c.XN()};
            pg8::gemm_phase<EpiGlu, pg8::StaticOrder, true, true>(ring, g, S, E);
        }
        gsync(grid);
        {
            const Ctx c = mkctx();
            pg8::Gemm g{c.XN(), c.W2T(), TP, D, D, D, 256}; pg8::StaticOrder S; S.init(TP, D, c.G, c.bx);
            EpiRes E{l == 0 ? c.in(I_XP) : (const float*)c.out(), l == 0 ? c.in(I_XS) : (const float*)(c.out() + (size_t)TP * D), c.out()};
            pg8::gemm_phase<EpiRes, pg8::StaticOrder, true, true>(ring, g, S, E);
            int ks_ = 256; asm volatile("" : "+s"(ks_));
            pg8::Gemm gt{c.XN(), c.W2T(), MR, D, D, ks_, 256}; TailOrder ST_; ST_.init(D / 256, c.G, c.bx);
            EpiPart EP{c.PART()};
            pg8::gemm_phase<EpiPart, TailOrder, true, true>(ring, gt, ST_, EP);
        }
        gsync(grid);
        { const Ctx c = mkctx(); const float* gg = c.in(I_NFG) + (size_t)l * D; float* xo = c.out(); bf16* xn = c.XN();
          for (int m = c.gw; m < TP; m += 2 * c.ngw) { const int m1 = m + c.ngw;
              if (m1 < TP) norm_rows2_bf16(xo + (size_t)m * D, xo + (size_t)m1 * D, gg, xn + (size_t)m * D, xn + (size_t)m1 * D, c.lane);
              else norm_row_bf16(xo + (size_t)m * D, gg, xn + (size_t)m * D, c.lane); }
          for (int m = TP + c.gw; m < MR; m += c.ngw)
              norm_row_bf16(l == 0 ? c.in(I_XS) + (size_t)(m - TP) * D : (const float*)(xo + (size_t)m * D), gg, xn + (size_t)m * D, c.lane, c.PART() + (size_t)(m - TP) * D, D / 256, xo + (size_t)m * D); }
        gsync(grid);
        {
            const Ctx c = mkctx();
            pg8::Gemm g{c.XN() - 2 * D, c.W3T(), 67 * 256, NUP, D, D, 254}; pg8::StaticOrder S; S.init(67 * 256, NUP, c.G, c.bx);
            EpiAct E{c.GATE(), c.out() + O_CONVP + (size_t)l * NB * 2 * DFF, c.out() + O_CONVS + (size_t)l * DB * 2 * DFF,
                     c.in(I_FCW) + (size_t)l * 3 * DFF, c.in(I_FCB) + (size_t)l * DFF, c.in(I_SCONV) + (size_t)l * DB * 2 * DFF, (PG8_LAS float*)(ring + 131072)};
            pg8::gemm_phase<EpiAct, pg8::StaticOrder, true, true>(ring, g, S, E);
        }
        gsync(grid);
        {
            const Ctx c = mkctx();
            pg8::Gemm g{c.GATE(), c.W4T(), TP, D, DFF, DFF, 256}; pg8::StaticOrder S; S.init(TP, D, c.G, c.bx);
            EpiRes E{c.out(), c.out() + (size_t)TP * D, c.out()};
            pg8::gemm_phase<EpiRes, pg8::StaticOrder, true, true>(ring, g, S, E);
            int ks_ = 256; asm volatile("" : "+s"(ks_));
            pg8::Gemm gt{c.GATE(), c.W4T(), MR, D, DFF, ks_, 256}; TailOrder ST_; ST_.init(DFF / 256, c.G, c.bx);
            EpiPart EP{c.PART()};
            pg8::gemm_phase<EpiPart, TailOrder, true, true>(ring, gt, ST_, EP);
        }
        gsync(grid);
    }

__global__ void __launch_bounds__(512, 2) fwd(Args args) {
    extern __shared__ __attribute__((aligned(16))) unsigned char lds[];
    float* L = (float*)lds;
    PG8_LAS unsigned char* ring = (PG8_LAS unsigned char*)lds;

    volatile __attribute__((address_space(3))) unsigned* bst = (volatile __attribute__((address_space(3))) unsigned*)((PG8_LAS unsigned char*)lds + 143360);
    if (threadIdx.x < 2) bst[threadIdx.x] = 0u;
    __syncthreads();
    unsigned* barw; { KArgs kp = (KArgs)__builtin_amdgcn_kernarg_segment_ptr(); barw = (unsigned*)kp->ws; }
    const XcdBarrier grid = xcd_barrier_post(barw, bst);
    cg::this_grid().sync();
    layer_body<0>(L, ring, grid);
    layer_body<1>(L, ring, grid);
    { const Ctx c = mkctx(); const float* gg = c.in(I_NFIN); float* xo = c.out();
      for (int m = c.gw; m < TP; m += 2 * c.ngw) { const int m1 = m + c.ngw;
          if (m1 < TP) norm_rows2_f32(xo + (size_t)m * D, xo + (size_t)m1 * D, gg, c.lane); else norm_row_f32(xo + (size_t)m * D, gg, c.lane); }
      for (int m = TP + c.gw; m < MR; m += c.ngw) norm_row_f32(xo + (size_t)m * D, gg, c.lane, c.PART() + (size_t)(m - TP) * D, DFF / 256); }
}
}

extern "C" void kernel_launch(void* const* d_in, const int* in_sizes, int n_in, void* d_out, int out_size, void* d_ws, size_t ws_size, hipStream_t stream) {
    static int grid = 0;
    if (grid == 0) {
        if (n_in != mk::N_IN || out_size != (int)mk::O_END || ws_size < mk::WS_END) { fprintf(stderr, "kernel_launch: unexpected sizes n_in %d out %d ws %zu (need %zu)\n", n_in, out_size, ws_size, (size_t)mk::WS_END); }
        int dev = 0, cus = 0, per_cu = 0;
        hipGetDevice(&dev); hipDeviceGetAttribute(&cus, hipDeviceAttributeMultiprocessorCount, dev);
        hipFuncSetAttribute((const void*)mk::fwd, hipFuncAttributeMaxDynamicSharedMemorySize, mk::LDS_BYTES);
        hipOccupancyMaxActiveBlocksPerMultiprocessor(&per_cu, (const void*)mk::fwd, 512, mk::LDS_BYTES);
        if (per_cu < 1) { fprintf(stderr, "kernel_launch: occupancy query says %d blocks per CU\n", per_cu); per_cu = 1; }
        grid = cus * 1;
        (void)hipGetLastError();
    }
    (void)hipMemsetAsync(d_ws, 0, 65536, stream);
    mk::Args a{};
    for (int i = 0; i < mk::N_IN; ++i) a.in[i] = (const float*)d_in[i];
    a.out = (float*)d_out; a.ws = (unsigned char*)d_ws;
    void* kargs[] = {&a};
    hipError_t e = hipLaunchCooperativeKernel((const void*)mk::fwd, dim3(grid), dim3(512), kargs, mk::LDS_BYTES, stream);
    if (e != hipSuccess) fprintf(stderr, "cooperative launch failed: %s (grid %d)\n", hipGetErrorString(e), grid);
}
```

```cpp
#include <hip/hip_runtime.h>
#include <hip/hip_cooperative_groups.h>
#include <cstdio>
#include <cstdint>
namespace cg = cooperative_groups;
namespace pg8 {
#define PG8_LAS __attribute__((address_space(3)))
typedef unsigned short bf16_t;
typedef short bf16x8 __attribute__((ext_vector_type(8)));
typedef float f32x4 __attribute__((ext_vector_type(4)));
typedef unsigned u32x4 __attribute__((ext_vector_type(4)));
constexpr int BM = 256, BK = 64, HALF = 128, HTB = HALF * BK * 2  , STAGE_BYTES = 8 * HTB, NXCD = 8, WGM = 8;

__host__ __device__ __forceinline__ int lds_byte(int r, int c) { const int st = (r >> 4) * 2 + (c >> 5), rr = r & 15, cc = c & 31, ob = rr * 64 + cc * 2; return st * 1024 + (ob ^ (((ob >> 9) & 1) << 5)); }
__host__ __device__ __forceinline__ void stage_rc(int b, int& R, int& C) { const int st = b / 1024, sb = b % 1024, swz = sb ^ (((sb >> 9) & 1) << 5); R = (st >> 1) * 16 + swz / 64; C = (st & 1) * 32 + (swz % 64) / 2; }
__host__ __device__ __forceinline__ int perm32(int rho) { const int n = rho >> 4, i = rho & 15; return 8 * (i >> 2) + 4 * n + (i & 3); }

struct Unit { int pm, pn, ko; };
struct Gemm { const bf16_t* A; const bf16_t* Bt; int M, N, K, KL, MS; };

struct StaticOrder {
    int nM, nN, nwg, G, c;
    __host__ __device__ void init(int M, int N, int G_, int c_) { nM = M / BM; nN = N / BM; nwg = nM * nN; G = G_; c = c_; }
    __host__ __device__ bool next(int i, Unit& u) const {
        const long L = (long)i * G + c; if (L >= nwg) return false;
        int wgid = (int)L; { const int q = nwg / NXCD, r = nwg % NXCD, xcd = wgid % NXCD, off = wgid / NXCD; wgid = (xcd < r ? xcd * (q + 1) : r * (q + 1) + (xcd - r) * q) + off; }
        const int nig = WGM * nN, gid = wgid / nig, fm = gid * WGM, gsz = (nM - fm) < WGM ? (nM - fm) : WGM;
        u.pm = fm + ((wgid % nig) % gsz); u.pn = (wgid % nig) / gsz; u.ko = 0; return true;
    }
    __device__ __forceinline__ void a_ready(const Unit&) const {}
    __device__ __forceinline__ void done(const Unit&) const {}
};

__device__ __forceinline__ unsigned cvt_pk_bf16(float lo, float hi) { unsigned r; asm volatile("v_cvt_pk_bf16_f32 %0, %1, %2" : "=v"(r) : "v"(lo), "v"(hi)); return r; }
typedef float f32x2 __attribute__((ext_vector_type(2)));
__device__ __forceinline__ f32x2 gelu_pk(f32x2 v) {
    const f32x2 av = __builtin_elementwise_abs(v), d = av * 0.2316418882f + 1.0f;
    f32x2 t; t.x = __builtin_amdgcn_rcpf(d.x); t.y = __builtin_amdgcn_rcpf(d.y);
    f32x2 q = t * 0.5307027145f + (-0.7265760135f); q = q * t + 0.7107068705f; q = q * t + (-0.142248368f); q = q * t + 0.127414796f; q = q * t;
    const f32x2 s = (v * v) * (-0.72134752044f);
    f32x2 e; e.x = __builtin_amdgcn_exp2f(s.x); e.y = __builtin_amdgcn_exp2f(s.y);
    const f32x2 m = v * (q * e), r = v - m;
    f32x2 o; o.x = v.x < 0.f ? m.x : r.x; o.y = v.y < 0.f ? m.y : r.y; return o;
}

template <int ACT  > struct EpiBf16 {
    static constexpr bool PERM = true, AFTER_DRAIN = false; static_assert(ACT == 0 || ACT == 1, "EpiBf16: ACT is 0 (none) or 1 (gelu_pk)");
    bf16_t* O; int ldc; const float* bias; int split_cols; size_t split_stride; float scale0;
    __device__ __forceinline__ void operator()(const f32x4 (&acc)[2][2][4][2], const Unit& u, int wr, int wc, int fr, int fq) const {
        const int row0 = u.pm * BM + wr * 64 + fr; int colt = u.pn * BM; bf16_t* base = O;
        float sc = 1.f; if (split_cols) { const int t = colt / split_cols; base += (size_t)t * split_stride; colt -= t * split_cols; if (t == 0) sc = scale0; }
        const int col0 = colt + wc * 32 + 8 * fq, bcol0 = u.pn * BM + wc * 32 + 8 * fq;
        f32x4 bv[2][2];
#pragma unroll
        for (int bj = 0; bj < 2; ++bj)
#pragma unroll
            for (int n = 0; n < 2; ++n) bv[bj][n] = bias ? *(const f32x4*)(bias + bcol0 + bj * HALF + 4 * n) : (f32x4){0.f, 0.f, 0.f, 0.f};
#pragma unroll
        for (int ai = 0; ai < 2; ++ai)
#pragma unroll
            for (int m = 0; m < 4; ++m) { bf16_t* rowp = base + (size_t)(row0 + ai * HALF + m * 16) * ldc + col0;
#pragma unroll
                for (int bj = 0; bj < 2; ++bj) { f32x4 v0 = acc[ai][bj][m][0] + bv[bj][0], v1 = acc[ai][bj][m][1] + bv[bj][1];
                    if (ACT == 1) { f32x2 a = gelu_pk((f32x2){v0[0], v0[1]}), b = gelu_pk((f32x2){v0[2], v0[3]}), c = gelu_pk((f32x2){v1[0], v1[1]}), d = gelu_pk((f32x2){v1[2], v1[3]});
                        v0 = (f32x4){a.x, a.y, b.x, b.y}; v1 = (f32x4){c.x, c.y, d.x, d.y}; }
                    v0 = v0 * sc; v1 = v1 * sc; u32x4 w; w.x = cvt_pk_bf16(v0[0], v0[1]); w.y = cvt_pk_bf16(v0[2], v0[3]); w.z = cvt_pk_bf16(v1[0], v1[1]); w.w = cvt_pk_bf16(v1[2], v1[3]);
                    *(u32x4*)(rowp + bj * HALF) = w; } }
    }
};
template <class Epi, class Sched, bool ALIGN_EPI = false, bool SP2 = false>
__device__ __forceinline__ void gemm_phase(PG8_LAS unsigned char* lds, const Gemm g, const Sched& S, const Epi& E) {
    int tid_ = threadIdx.x; asm volatile("" : "+v"(tid_)); const int tid = tid_, wid = __builtin_amdgcn_readfirstlane(tid >> 6), lane = tid & 63, wr = wid >> 2, wc = wid & 3, fr = lane & 15, fq = lane >> 4;
    const int K = g.K, nt = g.KL / BK;
    unsigned voffA[2], voffB[2];
#pragma unroll
    for (int i = 0; i < 2; ++i) { int R, C; stage_rc(tid * 16 + i * 8192, R, C); const int Rb = Epi::PERM ? ((R & ~31) + perm32(R & 31)) : R;
        voffA[i] = (unsigned)(R * K + C) * 2u; voffB[i] = (unsigned)(Rb * K + C) * 2u; }
    const size_t kstep = (size_t)(BK * 2);
    const size_t hstep = (size_t)HALF * K * 2;
    const size_t tstep = 2 * hstep;
    const size_t tstepA = (size_t)g.MS * K * 2;
    const unsigned ldsw = (unsigned)wid * 1024u;
    const int aoff = lds_byte(wr * 64 + fr, fq * 8), boff = lds_byte(wc * 32 + fr, fq * 8);
#define PG8_SA(b, h) (((b) * 2 + (h)) * HTB)
#define PG8_SB(b, h) ((4 + (b) * 2 + (h)) * HTB)
#define PG8_STAGE(bufoff, gbase, voff) do { _Pragma("unroll") for (int _i = 0; _i < 2; ++_i) \
        __builtin_amdgcn_global_load_lds((const unsigned*)((const char*)(gbase) + (voff)[_i]), (PG8_LAS unsigned*)(lds + (bufoff) + ldsw + _i * 8192), 16, 0, 0); } while (0)
#define PG8_LDA(dst, b, h) do { _Pragma("unroll") for (int m = 0; m < 4; ++m) _Pragma("unroll") for (int k = 0; k < 2; ++k) dst[m][k] = *(const PG8_LAS bf16x8*)(lds + PG8_SA(b, h) + aoff + m * 2048 + k * 1024); } while (0)
#define PG8_LDB(dst, b, h) do { _Pragma("unroll") for (int n = 0; n < 2; ++n) _Pragma("unroll") for (int k = 0; k < 2; ++k) dst[n][k] = *(const PG8_LAS bf16x8*)(lds + PG8_SB(b, h) + boff + n * 2048 + k * 1024); } while (0)
#define PG8_MMA(ai, bj, At, Bt) do { __builtin_amdgcn_s_setprio(1); _Pragma("unroll") for (int m = 0; m < 4; ++m) _Pragma("unroll") for (int n = 0; n < 2; ++n) _Pragma("unroll") for (int k = 0; k < 2; ++k) \
        acc[ai][bj][m][n] = __builtin_amdgcn_mfma_f32_16x16x32_bf16(Bt[n][k], At[m][k], acc[ai][bj][m][n], 0, 0, 0); __builtin_amdgcn_s_setprio(0); } while (0)
#define PG8_WAIT_V(n) asm volatile("s_waitcnt vmcnt(" #n ")" ::: "memory")
#define PG8_WAIT_L(n) asm volatile("s_waitcnt lgkmcnt(" #n ")" ::: "memory")
#define PG8_BAR __builtin_amdgcn_s_barrier()
#define PG8_SCHED __builtin_amdgcn_sched_barrier(0)
    Unit cur, nxt; int ui = 0;
    if (!S.next(0, cur)) return;
    f32x4 acc[2][2][4][2];
#pragma unroll
    for (int a = 0; a < 2; ++a)
#pragma unroll
        for (int b = 0; b < 2; ++b)
#pragma unroll
            for (int m = 0; m < 4; ++m)
#pragma unroll
                for (int n = 0; n < 2; ++n) acc[a][b][m][n] = (f32x4){0.f, 0.f, 0.f, 0.f};
    bf16x8 At[4][2], B0[2][2], B1[2][2];
    const char* cA = (const char*)g.A + (size_t)cur.pm * tstepA + (size_t)cur.ko * 2; const char* cB = (const char*)g.Bt + (size_t)cur.pn * tstep + (size_t)cur.ko * 2;
    S.a_ready(cur);
    if constexpr (SP2) {
        PG8_STAGE(PG8_SB(0, 0), cB, voffB); PG8_STAGE(PG8_SB(0, 1), cB + hstep, voffB); PG8_STAGE(PG8_SA(0, 0), cA, voffA); PG8_STAGE(PG8_SA(0, 1), cA + hstep, voffA);
        if (wr == 1) PG8_BAR;
        PG8_WAIT_V(2); PG8_BAR;
        PG8_STAGE(PG8_SB(1, 0), cB + kstep, voffB); PG8_STAGE(PG8_SA(1, 0), cA + kstep, voffA); PG8_STAGE(PG8_SB(1, 1), cB + hstep + kstep, voffB);
        PG8_WAIT_V(6); PG8_BAR;
    } else {
        PG8_STAGE(PG8_SB(0, 0), cB, voffB); PG8_STAGE(PG8_SA(0, 0), cA, voffA); PG8_STAGE(PG8_SB(0, 1), cB + hstep, voffB); PG8_STAGE(PG8_SA(0, 1), cA + hstep, voffA);
        if (wr == 1) PG8_BAR;
        PG8_WAIT_V(4); PG8_BAR;
        PG8_STAGE(PG8_SB(1, 0), cB + kstep, voffB); PG8_STAGE(PG8_SA(1, 0), cA + kstep, voffA); PG8_STAGE(PG8_SB(1, 1), cB + hstep + kstep, voffB);
        PG8_WAIT_V(6); PG8_BAR;
    }
    for (;;) {
        const bool has_next = S.next(ui + 1, nxt);
        const char* nA = has_next ? (const char*)g.A + (size_t)nxt.pm * tstepA + (size_t)nxt.ko * 2 : cA; const char* nB = has_next ? (const char*)g.Bt + (size_t)nxt.pn * tstep + (size_t)nxt.ko * 2 : cB;
        for (int t = 0; t < nt; t += 2) {
            const bool last = (t == nt - 2);
            const char* a1 = cA + (size_t)(t + 1) * kstep;
            const char* a2 = last ? nA : cA + (size_t)(t + 2) * kstep; const char* b2 = last ? nB : cB + (size_t)(t + 2) * kstep;
            const char* a3 = a2 + kstep; const char* b3 = b2 + kstep;
            if (last && has_next) S.a_ready(nxt);
            if constexpr (SP2) {
            PG8_LDB(B0, 0, 0); PG8_LDB(B1, 0, 1); PG8_SCHED; PG8_LDA(At, 0, 0); PG8_STAGE(PG8_SA(1, 1), a1 + hstep, voffA);
            PG8_WAIT_V(8); PG8_WAIT_L(0); PG8_BAR; PG8_MMA(0, 0, At, B0); PG8_MMA(0, 1, At, B1); PG8_BAR; PG8_SCHED;
            PG8_LDA(At, 0, 1); PG8_STAGE(PG8_SB(0, 0), b2, voffB); PG8_STAGE(PG8_SB(0, 1), b2 + hstep, voffB); PG8_STAGE(PG8_SA(0, 0), a2, voffA);
            PG8_WAIT_V(8); PG8_WAIT_L(0); PG8_BAR; PG8_MMA(1, 0, At, B0); PG8_MMA(1, 1, At, B1); PG8_BAR; PG8_SCHED;
            PG8_LDB(B0, 1, 0); PG8_LDB(B1, 1, 1); PG8_SCHED; PG8_LDA(At, 1, 0); PG8_STAGE(PG8_SA(0, 1), a2 + hstep, voffA);
            PG8_WAIT_V(8); PG8_WAIT_L(0); PG8_BAR; PG8_MMA(0, 0, At, B0); PG8_MMA(0, 1, At, B1); PG8_BAR; PG8_SCHED;
            PG8_LDA(At, 1, 1); PG8_STAGE(PG8_SB(1, 0), b3, voffB); PG8_STAGE(PG8_SB(1, 1), b3 + hstep, voffB); PG8_STAGE(PG8_SA(1, 0), a3, voffA);
            PG8_WAIT_V(8); PG8_WAIT_L(0); PG8_BAR; PG8_MMA(1, 0, At, B0); PG8_MMA(1, 1, At, B1); PG8_BAR; PG8_SCHED;
            } else {
            PG8_LDB(B0, 0, 0); PG8_SCHED; PG8_LDA(At, 0, 0); PG8_STAGE(PG8_SA(1, 1), a1 + hstep, voffA);
            PG8_WAIT_L(8); PG8_BAR; PG8_WAIT_L(0); PG8_MMA(0, 0, At, B0); PG8_BAR; PG8_SCHED;
            PG8_LDB(B1, 0, 1); PG8_STAGE(PG8_SB(0, 0), b2, voffB);
            PG8_BAR; PG8_WAIT_L(0); PG8_MMA(0, 1, At, B1); PG8_BAR;
            PG8_LDA(At, 0, 1); PG8_STAGE(PG8_SA(0, 0), a2, voffA);
            PG8_BAR; PG8_WAIT_L(0); PG8_MMA(1, 0, At, B0); PG8_BAR; PG8_SCHED;
            PG8_STAGE(PG8_SB(0, 1), b2 + hstep, voffB);
            PG8_WAIT_V(6); PG8_BAR; PG8_MMA(1, 1, At, B1); PG8_BAR;
            PG8_LDB(B0, 1, 0); PG8_SCHED; PG8_LDA(At, 1, 0); PG8_STAGE(PG8_SA(0, 1), a2 + hstep, voffA);
            PG8_WAIT_L(8); PG8_BAR; PG8_WAIT_L(0); PG8_MMA(0, 0, At, B0); PG8_BAR; PG8_SCHED;
            PG8_LDB(B1, 1, 1); PG8_STAGE(PG8_SB(1, 0), b3, voffB);
            PG8_BAR; PG8_WAIT_L(0); PG8_MMA(0, 1, At, B1); PG8_BAR;
            PG8_LDA(At, 1, 1); PG8_STAGE(PG8_SA(1, 0), a3, voffA);
            PG8_BAR; PG8_WAIT_L(0); PG8_MMA(1, 0, At, B0); PG8_BAR; PG8_SCHED;
            PG8_STAGE(PG8_SB(1, 1), b3 + hstep, voffB);
            PG8_WAIT_V(6); PG8_BAR; PG8_MMA(1, 1, At, B1); PG8_BAR;
            }
        }
        if constexpr (ALIGN_EPI) { if (wr == 0) PG8_BAR; }
        if constexpr (!Epi::AFTER_DRAIN) { E(acc, cur, wr, wc, fr, fq); S.done(cur); }
        if (!has_next) break;
#pragma unroll
        for (int a = 0; a < 2; ++a)
#pragma unroll
            for (int b = 0; b < 2; ++b)
#pragma unroll
                for (int m = 0; m < 4; ++m)
#pragma unroll
                    for (int n = 0; n < 2; ++n) acc[a][b][m][n] = (f32x4){0.f, 0.f, 0.f, 0.f};
        cur = nxt; cA = nA; cB = nB; ++ui;
        if constexpr (ALIGN_EPI) { if (wr == 1) PG8_BAR; }
    }
    PG8_WAIT_V(0);
    if constexpr (!ALIGN_EPI) { if (wr == 0) PG8_BAR; }
    PG8_BAR;
    if constexpr (Epi::AFTER_DRAIN) { E.fused(acc, cur, wr, wc, fr, fq, lds, wid, lane); S.done(cur); }
#undef PG8_SA
#undef PG8_SB
#undef PG8_STAGE
#undef PG8_LDA
#undef PG8_LDB
#undef PG8_MMA
#undef PG8_WAIT_V
#undef PG8_WAIT_L
#undef PG8_BAR
#undef PG8_SCHED
}
}

namespace mk {
typedef unsigned short bf16;
typedef float f32x4 __attribute__((ext_vector_type(4)));
typedef unsigned u32x4 __attribute__((ext_vector_type(4)));
typedef unsigned u32x2 __attribute__((ext_vector_type(2)));

constexpr int D = 1024, TP = 16384, TS = 512, MR = TP + TS;
constexpr int SEQ = 2048, NB = 8, DB = 128, DSEQ = 4;
constexpr int INC = 2960, NPROJ = 3072, DFF = 2816, NUP = 5632;
constexpr int NSEG = 8, LSEG = SEQ / NSEG;
constexpr int NSEG5 = 8, LSEG5 = SEQ / NSEG5, LOG2_LSEG5 = 8;
constexpr int C_RQ = 0, C_RK = 384, C_RV = 768, C_RG = 1152, C_SU = 1536, C_GQ = 1792, C_GK = 1984, C_GV = 2176, C_GG = 2560, C_GLR = 2944;
constexpr float EPS = 1e-6f;

constexpr size_t MiB = 1u << 20;
constexpr size_t WS_W1T = 1 * MiB, WS_W2T = 7 * MiB, WS_W3T = 9 * MiB, WS_W4T = 20 * MiB;
constexpr size_t WS_GLUT = 25 * MiB + 512 * 1024, WS_ROPE = 25 * MiB + 768 * 1024;
constexpr size_t WS_XN = 27 * MiB;
constexpr size_t WS_BIG = 60 * MiB;
constexpr size_t WS_ABUF = WS_BIG, WS_GATE = WS_BIG + (size_t)MR * DFF * 2;
constexpr size_t WS_SEG = 160 * MiB;
constexpr size_t WS_Y5 = 172 * MiB;
constexpr size_t WS_END = WS_GATE + (size_t)MR * DFF * 2;
static_assert(WS_END <= 256 * MiB, "workspace");
static_assert(WS_BIG + (size_t)MR * NPROJ * 2 <= WS_SEG, "proj vs seg");
constexpr size_t SEG_RET = 0;
constexpr size_t SEG_GLA = SEG_RET + (size_t)8 * 6 * (NSEG - 1) * 4096 * 4;
constexpr size_t SEG_S5 = SEG_GLA + (size_t)8 * 4 * (NSEG - 1) * 4672 * 4;
static_assert(WS_SEG + SEG_S5 + (size_t)8 * (NSEG5 - 1) * 2048 * 4 <= WS_Y5, "seg");

constexpr size_t O_Y = 0;
constexpr size_t O_RETP = (size_t)MR * D;
constexpr size_t O_RETS = O_RETP + (size_t)2 * NB * 6 * 4096;
constexpr size_t O_S5RP = O_RETS + (size_t)2 * DB * 6 * 4096;
constexpr size_t O_S5RS = O_S5RP + (size_t)2 * NB * 1024;
constexpr size_t O_S5IP = O_S5RS + (size_t)2 * DB * 1024;
constexpr size_t O_S5IS = O_S5IP + (size_t)2 * NB * 1024;
constexpr size_t O_GLAP = O_S5IS + (size_t)2 * DB * 1024;
constexpr size_t O_GLAS = O_GLAP + (size_t)2 * NB * 4 * 4608;
constexpr size_t O_CONVP = O_GLAS + (size_t)2 * DB * 4 * 4608;
constexpr size_t O_CONVS = O_CONVP + (size_t)2 * NB * 2 * DFF;
constexpr size_t O_END = O_CONVS + (size_t)2 * DB * 2 * DFF;
static_assert(O_END == 31088640, "out size");

constexpr int LDS_BYTES = 147456;

enum { I_XP = 0, I_XS, I_SRET, I_S5R, I_S5I, I_SGLA, I_SCONV, I_NMG, I_WIN, I_RNG, I_RNB, I_LRE, I_LIM, I_LDT, I_BRE, I_BIM, I_CRE, I_CIM, I_S5D,
       I_GLUW, I_GLUB, I_GGW, I_GGB, I_GNG, I_WOUT, I_NFG, I_FWIN, I_FCW, I_FCB, I_FWOUT, I_NFIN, N_IN };

struct Args { const float* in[N_IN]; float* out; unsigned char* ws; };

__device__ __forceinline__ float bflo(unsigned w) { return __uint_as_float(w << 16); }
__device__ __forceinline__ float bfhi(unsigned w) { return __uint_as_float(w & 0xffff0000u); }
__device__ __forceinline__ unsigned pk2(float lo, float hi) { unsigned r; asm("v_cvt_pk_bf16_f32 %0, %1, %2" : "=v"(r) : "v"(lo), "v"(hi)); return r; }
__device__ __forceinline__ unsigned f2bf(float f) { return pk2(f, 0.f) & 0xffffu; }
__device__ __forceinline__ float silu(float x) { return x * __builtin_amdgcn_rcpf(1.f + __builtin_amdgcn_exp2f(-1.4426950408889634f * x)); }
__device__ __forceinline__ float sigmoidf_(float x) { return __builtin_amdgcn_rcpf(1.f + __builtin_amdgcn_exp2f(-1.4426950408889634f * x)); }
__device__ __forceinline__ float gelu_tanh(float x) {
    const float v = x * fmaf(x * x, 0.044715f, 1.f);
    const float e = __builtin_amdgcn_exp2f(v * (2.f * 0.7978845608028654f * 1.4426950408889634f));
    return fmaf(-x, __builtin_amdgcn_rcpf(e + 1.f), x);
}
__device__ __forceinline__ float rdl(float x, int l) { return __int_as_float(__builtin_amdgcn_readlane(__float_as_int(x), l)); }
__device__ __forceinline__ float wave_sum(float v) {
#pragma unroll
    for (int o = 1; o < 64; o <<= 1) v += __shfl_xor(v, o);
    return v;
}

struct EpiRes {
    static constexpr bool PERM = false, AFTER_DRAIN = false;
    const float* baseP; const float* baseS; float* out;
    __device__ __forceinline__ void operator()(const pg8::f32x4 (&acc)[2][2][4][2], const pg8::Unit& u, int wr, int wc, int fr, int fq) const {
        const int row0 = u.pm * 256 + wr * 64 + fr, col0 = u.pn * 256 + wc * 32 + 4 * fq;
        const float* base = (u.pm < TP / 256) ? baseP : (baseS - (size_t)TP * D);
#pragma unroll
        for (int ai = 0; ai < 2; ++ai)
#pragma unroll
            for (int m = 0; m < 4; ++m) { const size_t off = (size_t)(row0 + ai * 128 + m * 16) * D + col0;
#pragma unroll
                for (int bj = 0; bj < 2; ++bj)
#pragma unroll
                    for (int n = 0; n < 2; ++n) { const pg8::f32x4 bs = *(const pg8::f32x4*)(base + off + bj * 128 + n * 16);
                        *(pg8::f32x4*)(out + off + bj * 128 + n * 16) = bs + acc[ai][bj][m][n]; }
                if (m & 1) asm volatile("" ::: "memory"); }
    }
};
struct TailOrder {
    int S, G, c;
    __device__ void init(int S_, int G_, int c_) { S = S_; G = G_; c = c_; }
    __device__ bool next(int i, pg8::Unit& u) const { const int Lq = i * G + c; if (Lq >= 8 * S) return false; const int ks = Lq % S, tile = Lq / S; u.pn = tile & 3; u.pm = TP / 256 + (tile >> 2); u.ko = ks * 256; return true; }
    __device__ __forceinline__ void a_ready(const pg8::Unit&) const {}
    __device__ __forceinline__ void done(const pg8::Unit&) const {}
};
struct EpiPart {
    static constexpr bool PERM = false, AFTER_DRAIN = false;
    float* part;
    __device__ __forceinline__ void operator()(const pg8::f32x4 (&acc)[2][2][4][2], const pg8::Unit& u, int wr, int wc, int fr, int fq) const {
        const int row0 = (u.pm - TP / 256) * 256 + wr * 64 + fr, col0 = u.pn * 256 + wc * 32 + 4 * fq;
        float* dst = part + (size_t)(u.ko >> 8) * TS * D;
#pragma unroll
        for (int ai = 0; ai < 2; ++ai)
#pragma unroll
            for (int m = 0; m < 4; ++m) { const size_t off = (size_t)(row0 + ai * 128 + m * 16) * D + col0;
#pragma unroll
                for (int bj = 0; bj < 2; ++bj)
#pragma unroll
                    for (int n = 0; n < 2; ++n) *(pg8::f32x4*)(dst + off + bj * 128 + n * 16) = acc[ai][bj][m][n]; }
    }
};
struct EpiGlu {
    static constexpr bool PERM = true, AFTER_DRAIN = false;
    const bf16* y5; const float* bias; bf16* mix;
    __device__ __forceinline__ void operator()(const pg8::f32x4 (&acc)[2][2][4][2], const pg8::Unit& u, int wr, int wc, int fr, int fq) const {
        const int row0 = u.pm * 256 + wr * 64 + fr, col0 = wc * 32 + 8 * fq;
#pragma unroll
        for (int bj = 0; bj < 2; ++bj) { const int c = col0 + bj * 128;
            const f32x4 b0 = *(const f32x4*)(bias + c), b1 = *(const f32x4*)(bias + c + 4);
#pragma unroll
            for (int ai = 0; ai < 2; ++ai)
#pragma unroll
                for (int m = 0; m < 4; ++m) { const size_t r = (size_t)(row0 + ai * 128 + m * 16);
                    const u32x4 yv = *(const u32x4*)(y5 + r * 256 + c);
                    const pg8::f32x4 v0 = acc[ai][bj][m][0], v1 = acc[ai][bj][m][1];
                    u32x4 w;
                    w.x = pk2(bflo(yv.x) * sigmoidf_(v0[0] + b0[0]), bfhi(yv.x) * sigmoidf_(v0[1] + b0[1]));
                    w.y = pk2(bflo(yv.y) * sigmoidf_(v0[2] + b0[2]), bfhi(yv.y) * sigmoidf_(v0[3] + b0[3]));
                    w.z = pk2(bflo(yv.z) * sigmoidf_(v1[0] + b1[0]), bfhi(yv.z) * sigmoidf_(v1[1] + b1[1]));
                    w.w = pk2(bflo(yv.w) * sigmoidf_(v1[2] + b1[2]), bfhi(yv.w) * sigmoidf_(v1[3] + b1[3]));
                    *(u32x4*)(mix + r * D + 384 + c) = w; asm volatile("" ::: "memory"); } }
    }
};
struct EpiUp {
    static constexpr bool PERM = true, AFTER_DRAIN = false;
    bf16* abuf; bf16* gate; float* convP; float* convS;
    __device__ __forceinline__ void operator()(const pg8::f32x4 (&acc)[2][2][4][2], const pg8::Unit& u, int wr, int wc, int fr, int fq) const {
        const bool isA = u.pn < DFF / 256;
        bf16* dst = isA ? abuf : gate;
        const int colt = (isA ? u.pn : u.pn - DFF / 256) * 256 + wc * 32 + 8 * fq;
        const int row0 = u.pm * 256 + wr * 64 + fr;
#pragma unroll
        for (int ai = 0; ai < 2; ++ai)
#pragma unroll
            for (int m = 0; m < 4; ++m) { const int r = row0 + ai * 128 + m * 16;
#pragma unroll
                for (int bj = 0; bj < 2; ++bj) { const pg8::f32x4 v0 = acc[ai][bj][m][0], v1 = acc[ai][bj][m][1];
                    u32x4 w; w.x = pg8::cvt_pk_bf16(v0[0], v0[1]); w.y = pg8::cvt_pk_bf16(v0[2], v0[3]); w.z = pg8::cvt_pk_bf16(v1[0], v1[1]); w.w = pg8::cvt_pk_bf16(v1[2], v1[3]);
                    *(u32x4*)(dst + (size_t)r * DFF + colt + bj * 128) = w;
                    if (isA) {
                        float* cd = nullptr;
                        if (r < TP) { const int t = r & (SEQ - 1); if (t >= SEQ - 2) cd = convP + ((size_t)(r >> 11) * 2 + (t - (SEQ - 2))) * DFF; }
                        else { const int rs = r - TP, t = rs & 3; if (t >= 2) cd = convS + ((size_t)(rs >> 2) * 2 + (t - 2)) * DFF; }
                        if (cd) { *(pg8::f32x4*)(cd + colt + bj * 128) = v0; *(pg8::f32x4*)(cd + colt + bj * 128 + 4) = v1; }
                    } } }
    }
};

__device__ __forceinline__ float dpp_ror1(float x) { return __int_as_float(__builtin_amdgcn_update_dpp(0, __float_as_int(x), 0x121, 0xf, 0xf, false)); }
__device__ __forceinline__ float dpp_ror2(float x) { return __int_as_float(__builtin_amdgcn_update_dpp(0, __float_as_int(x), 0x122, 0xf, 0xf, false)); }
struct EpiAct {
    static constexpr bool PERM = true, AFTER_DRAIN = false;
    bf16* act; float* convP; float* convS; const float* cw; const float* cb; const float* cstate; PG8_LAS float* halo;
    __device__ __forceinline__ void operator()(const pg8::f32x4 (&acc)[2][2][4][2], const pg8::Unit& u, int wr, int wc, int fr, int fq) const {
        const int jl = wc * 32 + 8 * fq, j0 = u.pn * 128 + jl;
        if (fr >= 14) {
#pragma unroll
            for (int ai = 0; ai < 2; ++ai) { PG8_LAS float* hp = halo + ((ai * 2 + wr) * 2 + (fr - 14)) * 128 + jl;
                *(PG8_LAS pg8::f32x4*)hp = acc[ai][0][3][0]; *(PG8_LAS pg8::f32x4*)(hp + 4) = acc[ai][0][3][1]; } }
        float w0[8], w1[8], w2[8], bb[8];
#pragma unroll
        for (int e = 0; e < 8; ++e) { w0[e] = cw[j0 + e]; w1[e] = cw[DFF + j0 + e]; w2[e] = cw[2 * DFF + j0 + e]; bb[e] = cb[j0 + e]; }
        asm volatile("s_waitcnt lgkmcnt(0)" ::: "memory"); __builtin_amdgcn_s_barrier(); asm volatile("" ::: "memory");
#pragma unroll
        for (int ai = 0; ai < 2; ++ai)
#pragma unroll
            for (int m = 0; m < 4; ++m) {
                const int rr = ai * 128 + wr * 64 + m * 16 + fr, r = u.pm * 254 - 2 + rr;
                float cur[8], p1[8], p2[8];
#pragma unroll
                for (int e = 0; e < 8; ++e) cur[e] = acc[ai][0][m][e >> 2][e & 3];
                if (m == 0) {
                    float h0[8], h1[8];
                    const int pb = ai * 2 + wr - 1;
                    if (pb >= 0) { const PG8_LAS float* hp = halo + (pb * 2) * 128 + jl;
                        const pg8::f32x4 a0 = *(const PG8_LAS pg8::f32x4*)hp, a1 = *(const PG8_LAS pg8::f32x4*)(hp + 4), b0 = *(const PG8_LAS pg8::f32x4*)(hp + 128), b1 = *(const PG8_LAS pg8::f32x4*)(hp + 132);
#pragma unroll
                        for (int e = 0; e < 4; ++e) { h0[e] = a0[e]; h0[4 + e] = a1[e]; h1[e] = b0[e]; h1[4 + e] = b1[e]; } }
                    else {
#pragma unroll
                        for (int e = 0; e < 8; ++e) { h0[e] = 0.f; h1[e] = 0.f; } }
#pragma unroll
                    for (int e = 0; e < 8; ++e) { const float s1 = dpp_ror1(cur[e]), s2 = dpp_ror2(cur[e]); p1[e] = fr >= 1 ? s1 : h1[e]; p2[e] = fr >= 2 ? s2 : (fr == 1 ? h1[e] : h0[e]); }
                } else {
#pragma unroll
                    for (int e = 0; e < 8; ++e) { const float pv = acc[ai][0][m - 1][e >> 2][e & 3];
                        const float s1 = dpp_ror1(cur[e]), s2 = dpp_ror2(cur[e]), q1 = dpp_ror1(pv), q2 = dpp_ror2(pv); p1[e] = fr >= 1 ? s1 : q1; p2[e] = fr >= 2 ? s2 : q2; }
                }
                const bool live = rr >= 2 && r < MR;
                const bool smp = r >= TP;
                const int t = smp ? ((r - TP) & 3) : (r & (SEQ - 1));
                if (live && t < 2) {
                    if (smp) { const float* cs = cstate + (size_t)((r - TP) >> 2) * 2 * DFF + j0;
#pragma unroll
                        for (int e = 0; e < 8; ++e) { if (t == 0) { p2[e] = cs[e]; p1[e] = cs[DFF + e]; } else { p2[e] = cs[DFF + e]; } } }
                    else {
#pragma unroll
                        for (int e = 0; e < 8; ++e) { p2[e] = 0.f; if (t == 0) p1[e] = 0.f; } }
                }
                if (live) {
                    float o[8];
                    typedef float f32x2 __attribute__((ext_vector_type(2)));
#pragma unroll
                    for (int e = 0; e < 8; e += 2) {
                        f32x2 cv = (f32x2){bb[e], bb[e + 1]} + (f32x2){w0[e], w0[e + 1]} * (f32x2){p2[e], p2[e + 1]};
                        cv += (f32x2){w1[e], w1[e + 1]} * (f32x2){p1[e], p1[e + 1]}; cv += (f32x2){w2[e], w2[e + 1]} * (f32x2){cur[e], cur[e + 1]};
                        const f32x2 vv = cv * (cv * cv * 0.044715f + 1.f) * (2.f * 0.7978845608028654f * 1.4426950408889634f);
                        const float r0 = __builtin_amdgcn_rcpf(__builtin_amdgcn_exp2f(vv.x) + 1.f), r1 = __builtin_amdgcn_rcpf(__builtin_amdgcn_exp2f(vv.y) + 1.f);
                        const f32x2 gl = cv - cv * (f32x2){r0, r1};
                        const f32x2 go = gl * (f32x2){acc[ai][1][m][e >> 2][e & 3], acc[ai][1][m][(e + 1) >> 2][(e + 1) & 3]};
                        o[e] = go.x; o[e + 1] = go.y; }
                    u32x4 wv; wv.x = pk2(o[0], o[1]); wv.y = pk2(o[2], o[3]); wv.z = pk2(o[4], o[5]); wv.w = pk2(o[6], o[7]);
                    *(u32x4*)(act + (size_t)r * DFF + j0) = wv;
                    float* cd = nullptr;
                    if (!smp) { if (t >= SEQ - 2) cd = convP + ((size_t)(r >> 11) * 2 + (t - (SEQ - 2))) * DFF; }
                    else if (t >= 2) cd = convS + ((size_t)((r - TP) >> 2) * 2 + (t - 2)) * DFF;
                    if (cd) { *(pg8::f32x4*)(cd + j0) = acc[ai][0][m][0]; *(pg8::f32x4*)(cd + j0 + 4) = acc[ai][0][m][1]; }
                }
            }
    }
};

typedef const __attribute__((address_space(4))) Args* KArgs;
struct Ctx {
    KArgs ap; int tid, lane, wave, gw, ngw, bx, G;
    __device__ __forceinline__ const float* in(int i) const { return ap->in[i]; }
    __device__ __forceinline__ float* out() const { return ap->out; }
    __device__ __forceinline__ bf16* W1T() const { return (bf16*)(ap->ws + WS_W1T); }
    __device__ __forceinline__ bf16* W2T() const { return (bf16*)(ap->ws + WS_W2T); }
    __device__ __forceinline__ bf16* W3T() const { return (bf16*)(ap->ws + WS_W3T); }
    __device__ __forceinline__ bf16* W4T() const { return (bf16*)(ap->ws + WS_W4T); }
    __device__ __forceinline__ bf16* GLUT() const { return (bf16*)(ap->ws + WS_GLUT); }
    __device__ __forceinline__ bf16* XN() const { return (bf16*)(ap->ws + WS_XN); }
    __device__ __forceinline__ bf16* PROJ() const { return (bf16*)(ap->ws + WS_BIG); }
    __device__ __forceinline__ bf16* ABUF() const { return (bf16*)(ap->ws + WS_ABUF); }
    __device__ __forceinline__ bf16* GATE() const { return (bf16*)(ap->ws + WS_GATE); }
    __device__ __forceinline__ bf16* Y5() const { return (bf16*)(ap->ws + WS_Y5); }
    __device__ __forceinline__ float* ROPE() const { return (float*)(ap->ws + WS_ROPE); }
    __device__ __forceinline__ float* SEG() const { return (float*)(ap->ws + WS_SEG); }
    __device__ __forceinline__ float* PART() const { return (float*)(ap->ws + WS_BIG); }
};
__device__ __forceinline__ Ctx mkctx() {
    Ctx c; KArgs p = (KArgs)__builtin_amdgcn_kernarg_segment_ptr(); asm volatile("" : "+s"(p)); c.ap = p;
    int t_ = threadIdx.x; asm volatile("" : "+v"(t_)); int b_ = blockIdx.x; asm volatile("" : "+s"(b_)); int g_ = gridDim.x; asm volatile("" : "+s"(g_));
    c.tid = t_; c.lane = c.tid & 63; c.wave = __builtin_amdgcn_readfirstlane(c.tid >> 6); c.bx = b_; c.G = g_;
    c.gw = b_ * 8 + c.wave; c.ngw = g_ * 8; return c;
}

__device__ __forceinline__ void transpose_item(const float* W, int K, int N, bf16* WT, float* scr, int item, int lane, bool ILV = false) {
    const int nblk = (N + 31) / 32, kb = item / nblk, nb = item % nblk, k0 = 64 * kb, n0 = 32 * nb;
    const int dst0 = !ILV ? n0 : (n0 < DFF ? 256 * (n0 >> 7) + (n0 & 127) : 256 * ((n0 - DFF) >> 7) + 128 + ((n0 - DFF) & 127));
    const int nn = n0 + (lane & 31);
    float tv[32];
#pragma unroll
    for (int i = 0; i < 32; ++i) { const int kk = 2 * i + (lane >> 5); tv[i] = (nn < N) ? W[(size_t)(k0 + kk) * N + nn] : 0.f; }
#pragma unroll
    for (int i = 0; i < 32; ++i) { const int kk = 2 * i + (lane >> 5); scr[kk * 33 + (lane & 31)] = tv[i]; }
    asm volatile("s_waitcnt lgkmcnt(0)" ::: "memory");
    const int c = lane & 7;
#pragma unroll
    for (int j = 0; j < 4; ++j) { const int n = (lane >> 3) + 8 * j; const float* s = scr + (8 * c) * 33 + n;
        u32x4 o; o.x = pk2(s[0 * 33], s[1 * 33]); o.y = pk2(s[2 * 33], s[3 * 33]); o.z = pk2(s[4 * 33], s[5 * 33]); o.w = pk2(s[6 * 33], s[7 * 33]);
        *(u32x4*)(WT + (size_t)(dst0 + n) * K + k0 + 8 * c) = o; }
    asm volatile("s_waitcnt lgkmcnt(0)" ::: "memory");
}
__device__ __forceinline__ void norm_row_bf16(const float* xrow, const float* g, bf16* orow, int lane, const float* part = nullptr, int nS = 0, float* xout = nullptr) {
    const f32x4* xr = (const f32x4*)xrow + lane; const f32x4* gr = (const f32x4*)g + lane;
    f32x4 v[4]; float s = 0.f;
#pragma unroll
    for (int j = 0; j < 4; ++j) v[j] = xr[64 * j];
    if (part) { for (int q = 0; q < nS; ++q) { const f32x4* pp = (const f32x4*)(part + (size_t)q * TS * D) + lane;
#pragma unroll
            for (int j = 0; j < 4; ++j) v[j] += pp[64 * j]; }
#pragma unroll
        for (int j = 0; j < 4; ++j) ((f32x4*)xout + lane)[64 * j] = v[j]; }
#pragma unroll
    for (int j = 0; j < 4; ++j) { s += (v[j].x * v[j].x + v[j].y * v[j].y) + (v[j].z * v[j].z + v[j].w * v[j].w); }
    const float rs = rsqrtf(wave_sum(s) * (1.f / D) + EPS);
    u32x2* o8 = (u32x2*)orow + lane;
#pragma unroll
    for (int j = 0; j < 4; ++j) { const f32x4 gg = gr[64 * j]; u32x2 w; w.x = pk2(v[j].x * rs * gg.x, v[j].y * rs * gg.y); w.y = pk2(v[j].z * rs * gg.z, v[j].w * rs * gg.w); o8[64 * j] = w; }
}
__device__ __forceinline__ void norm_row_f32(float* xrow, const float* g, int lane, const float* part = nullptr, int nS = 0) {
    f32x4* xr = (f32x4*)xrow + lane; const f32x4* gr = (const f32x4*)g + lane;
    f32x4 v[4]; float s = 0.f;
#pragma unroll
    for (int j = 0; j < 4; ++j) v[j] = xr[64 * j];
    if (part) { for (int q = 0; q < nS; ++q) { const f32x4* pp = (const f32x4*)(part + (size_t)q * TS * D) + lane;
#pragma unroll
            for (int j = 0; j < 4; ++j) v[j] += pp[64 * j]; } }
#pragma unroll
    for (int j = 0; j < 4; ++j) { s += (v[j].x * v[j].x + v[j].y * v[j].y) + (v[j].z * v[j].z + v[j].w * v[j].w); }
    const float rs = rsqrtf(wave_sum(s) * (1.f / D) + EPS);
#pragma unroll
    for (int j = 0; j < 4; ++j) { const f32x4 gg = gr[64 * j]; xr[64 * j] = v[j] * rs * gg; }
}

__device__ __forceinline__ void norm_rows2_bf16(const float* x0, const float* x1, const float* g, bf16* o0, bf16* o1, int lane) {
    const f32x4* xr0 = (const f32x4*)x0 + lane; const f32x4* xr1 = (const f32x4*)x1 + lane; const f32x4* gr = (const f32x4*)g + lane;
    f32x4 v0[4], v1[4]; float s0 = 0.f, s1 = 0.f;
#pragma unroll
    for (int j = 0; j < 4; ++j) { v0[j] = xr0[64 * j]; v1[j] = xr1[64 * j]; }
#pragma unroll
    for (int j = 0; j < 4; ++j) { s0 += (v0[j].x * v0[j].x + v0[j].y * v0[j].y) + (v0[j].z * v0[j].z + v0[j].w * v0[j].w); s1 += (v1[j].x * v1[j].x + v1[j].y * v1[j].y) + (v1[j].z * v1[j].z + v1[j].w * v1[j].w); }
#pragma unroll
    for (int o = 1; o < 64; o <<= 1) { s0 += __shfl_xor(s0, o); s1 += __shfl_xor(s1, o); }
    const float r0 = rsqrtf(s0 * (1.f / D) + EPS), r1 = rsqrtf(s1 * (1.f / D) + EPS);
    u32x2* p0 = (u32x2*)o0 + lane; u32x2* p1 = (u32x2*)o1 + lane;
#pragma unroll
    for (int j = 0; j < 4; ++j) { const f32x4 gg = gr[64 * j];
        u32x2 w; w.x = pk2(v0[j].x * r0 * gg.x, v0[j].y * r0 * gg.y); w.y = pk2(v0[j].z * r0 * gg.z, v0[j].w * r0 * gg.w); p0[64 * j] = w;
        u32x2 z; z.x = pk2(v1[j].x * r1 * gg.x, v1[j].y * r1 * gg.y); z.y = pk2(v1[j].z * r1 * gg.z, v1[j].w * r1 * gg.w); p1[64 * j] = z; }
}
__device__ __forceinline__ void norm_rows2_f32(float* x0, float* x1, const float* g, int lane) {
    f32x4* xr0 = (f32x4*)x0 + lane; f32x4* xr1 = (f32x4*)x1 + lane; const f32x4* gr = (const f32x4*)g + lane;
    f32x4 v0[4], v1[4]; float s0 = 0.f, s1 = 0.f;
#pragma unroll
    for (int j = 0; j < 4; ++j) { v0[j] = xr0[64 * j]; v1[j] = xr1[64 * j]; }
#pragma unroll
    for (int j = 0; j < 4; ++j) { s0 += (v0[j].x * v0[j].x + v0[j].y * v0[j].y) + (v0[j].z * v0[j].z + v0[j].w * v0[j].w); s1 += (v1[j].x * v1[j].x + v1[j].y * v1[j].y) + (v1[j].z * v1[j].z + v1[j].w * v1[j].w); }
#pragma unroll
    for (int o = 1; o < 64; o <<= 1) { s0 += __shfl_xor(s0, o); s1 += __shfl_xor(s1, o); }
    const float r0 = rsqrtf(s0 * (1.f / D) + EPS), r1 = rsqrtf(s1 * (1.f / D) + EPS);
#pragma unroll
    for (int j = 0; j < 4; ++j) { const f32x4 gg = gr[64 * j]; xr0[64 * j] = v0[j] * r0 * gg; xr1[64 * j] = v1[j] * r1 * gg; }
}

__device__ __forceinline__ void prep_phase(const Ctx& c, int l, float* L) {
    float* scr = L + c.wave * 4096;
    constexpr int I1 = 16 * 93, I2 = 16 * 32, I3 = 16 * 176, I4 = 44 * 32, I5 = 4 * 8;
    constexpr int NIT = I1 + I2 + I3 + I4 + I5;
    const float* w_in = c.in(I_WIN) + (size_t)l * D * INC;
    const float* w_out = c.in(I_WOUT) + (size_t)l * D * D;
    const float* f_in = c.in(I_FWIN) + (size_t)l * D * NUP;
    const float* f_out = c.in(I_FWOUT) + (size_t)l * DFF * D;
    const float* gluw = c.in(I_GLUW) + (size_t)l * 256 * 256;
    for (int it = c.gw; it < NIT; it += c.ngw) {
        int r = it;
        if (r < I1) { transpose_item(w_in, D, INC, c.W1T(), scr, r, c.lane); continue; } r -= I1;
        if (r < I2) { transpose_item(w_out, D, D, c.W2T(), scr, r, c.lane); continue; } r -= I2;
        if (r < I3) { transpose_item(f_in, D, NUP, c.W3T(), scr, r, c.lane, true); continue; } r -= I3;
        if (r < I4) { transpose_item(f_out, DFF, D, c.W4T(), scr, r, c.lane); continue; } r -= I4;
        transpose_item(gluw, 256, 256, c.GLUT(), scr, r, c.lane);
    }
    { const int gt = c.gw * 64 + c.lane, ngt = c.ngw * 64; u32x4 z = {0u, 0u, 0u, 0u};
      for (int i = gt; i < (NPROJ - 2976) * D / 8; i += ngt) *(u32x4*)(c.W1T() + (size_t)2976 * D + (size_t)i * 8) = z; }
    const float* g = c.in(I_NMG) + (size_t)l * D;
    { const float* xp = (l == 0) ? c.in(I_XP) : (const float*)c.out();
      for (int m = c.gw; m < TP; m += 2 * c.ngw) { const int m1 = m + c.ngw;
          if (m1 < TP) norm_rows2_bf16(xp + (size_t)m * D, xp + (size_t)m1 * D, g, c.XN() + (size_t)m * D, c.XN() + (size_t)m1 * D, c.lane);
          else norm_row_bf16(xp + (size_t)m * D, g, c.XN() + (size_t)m * D, c.lane); } }
    for (int m = TP + c.gw; m < MR; m += c.ngw) {
        const float* xr = (l == 0) ? c.in(I_XS) + (size_t)(m - TP) * D : c.out() + (size_t)m * D;
        if (l > 0) norm_row_bf16(xr, g, c.XN() + (size_t)m * D, c.lane, c.PART() + (size_t)(m - TP) * D, DFF / 256, c.out() + (size_t)m * D);
        else norm_row_bf16(xr, g, c.XN() + (size_t)m * D, c.lane);
    }
    if (l == 0) {
        const int gt = c.gw * 64 + c.lane, ngt = c.ngw * 64;
        for (int i = gt; i < 2052 * 32; i += ngt) { const int ps = i >> 5, f = i & 31; const int pos = ps < 2048 ? ps : 16384 + (ps - 2048);
            const float inv = exp2f(-(float)f * (13.287712379549449f / 32.f));
            double a = (double)pos * (double)inv; a -= 6.283185307179586 * rint(a * 0.15915494309189535);
            const float af = (float)a; c.ROPE()[i] = cosf(af); c.ROPE()[2052 * 32 + i] = sinf(af); }
    }
}

template <bool PASSA>
__device__ __forceinline__ void ret_task(const Ctx& c, int l, bool sample, int b, int h, int seg, float* L) {
    const int tid = c.tid, lane = c.lane, w = c.wave, vl = lane & 7, dg = lane >> 3;
    const int len = sample ? DSEQ : LSEG;
    const int row0 = sample ? TP + b * DSEQ : b * SEQ + seg * LSEG;
    const int ridx0 = sample ? 2048 : seg * LSEG;
    const float gamma = 1.f - exp2f(-5.f - (float)h);
    float S[8];
    if (sample) { const float* s0 = c.in(I_SRET) + ((size_t)((l * DB + b) * 6 + h) * 64 + 8 * dg) * 64 + 8 * w + vl;
#pragma unroll
        for (int i = 0; i < 8; ++i) S[i] = s0[i * 64]; }
    else {
#pragma unroll
        for (int i = 0; i < 8; ++i) S[i] = 0.f;
        const float lg = log2f(gamma);
        if (!PASSA) for (int m = 0; m < seg; ++m) { const float f = exp2f((float)(LSEG * (seg - 1 - m)) * lg);
            const float* E = c.SEG() + SEG_RET / 4 + (size_t)((b * 6 + h) * (NSEG - 1) + m) * 4096 + (8 * dg) * 64 + 8 * w + vl;
#pragma unroll
            for (int i = 0; i < 8; ++i) S[i] += f * E[i * 64]; }
    }
    float* Qs = L; float* Ks = L + 4096; float* Vs = L + 8192; float* Os = L + 12288;
    const float* rg_g = c.in(I_RNG) + l * 384 + h * 64; const float* rg_b = c.in(I_RNB) + l * 384 + h * 64;
    for (int c0 = 0; c0 < len; c0 += 64) {
        const int n = (len - c0) < 64 ? (len - c0) : 64;
        { const int t = tid >> 3, cc = tid & 7;
          if (t < n) { const bf16* pr = c.PROJ() + (size_t)(row0 + c0 + t) * NPROJ;
            const float* rc = c.ROPE() + (size_t)(ridx0 + c0 + t) * 32 + 4 * cc; const float* rsn = rc + 2052 * 32;
            const f32x4 cs = *(const f32x4*)rc, sn = *(const f32x4*)rsn;
            { const u32x2 lo = *(const u32x2*)(pr + C_RK + h * 64 + 4 * cc), hi = *(const u32x2*)(pr + C_RK + h * 64 + 32 + 4 * cc);
              const f32x4 x1 = {bflo(lo.x), bfhi(lo.x), bflo(lo.y), bfhi(lo.y)}, x2 = {bflo(hi.x), bfhi(hi.x), bflo(hi.y), bfhi(hi.y)};
              *(f32x4*)(Ks + t * 64 + 4 * cc) = (x1 * cs - x2 * sn) * 0.125f; *(f32x4*)(Ks + t * 64 + 32 + 4 * cc) = (x1 * sn + x2 * cs) * 0.125f; }
            if (!PASSA) { const u32x2 lo = *(const u32x2*)(pr + C_RQ + h * 64 + 4 * cc), hi = *(const u32x2*)(pr + C_RQ + h * 64 + 32 + 4 * cc);
              const f32x4 x1 = {bflo(lo.x), bfhi(lo.x), bflo(lo.y), bfhi(lo.y)}, x2 = {bflo(hi.x), bfhi(hi.x), bflo(hi.y), bfhi(hi.y)};
              *(f32x4*)(Qs + t * 64 + 4 * cc) = x1 * cs - x2 * sn; *(f32x4*)(Qs + t * 64 + 32 + 4 * cc) = x1 * sn + x2 * cs; }
            { const u32x4 vv = *(const u32x4*)(pr + C_RV + h * 64 + 8 * cc);
              *(f32x4*)(Vs + t * 64 + 8 * cc) = (f32x4){bflo(vv.x), bfhi(vv.x), bflo(vv.y), bfhi(vv.y)};
              *(f32x4*)(Vs + t * 64 + 8 * cc + 4) = (f32x4){bflo(vv.z), bfhi(vv.z), bflo(vv.w), bfhi(vv.w)}; } } }
        __syncthreads();
        for (int tl0 = 0; tl0 < n; tl0 += 4) {
            float po[4];
#pragma unroll
            for (int u = 0; u < 4; ++u) { const int tl = tl0 + u;
                const f32x4 k0 = *(const f32x4*)(Ks + tl * 64 + 8 * dg), k1 = *(const f32x4*)(Ks + tl * 64 + 8 * dg + 4);
                const float vv = Vs[tl * 64 + 8 * w + vl];
                const float kk[8] = {k0.x, k0.y, k0.z, k0.w, k1.x, k1.y, k1.z, k1.w};
#pragma unroll
                for (int i = 0; i < 8; ++i) S[i] = fmaf(gamma, S[i], kk[i] * vv);
                if (!PASSA) {
                    const f32x4 q0 = *(const f32x4*)(Qs + tl * 64 + 8 * dg), q1 = *(const f32x4*)(Qs + tl * 64 + 8 * dg + 4);
                    po[u] = q0.x * S[0] + q0.y * S[1] + q0.z * S[2] + q0.w * S[3] + q1.x * S[4] + q1.y * S[5] + q1.z * S[6] + q1.w * S[7]; } }
            if (!PASSA) {
#pragma unroll
                for (int u = 0; u < 4; ++u) po[u] += __shfl_xor(po[u], 8);
#pragma unroll
                for (int u = 0; u < 4; ++u) po[u] += __shfl_xor(po[u], 16);
#pragma unroll
                for (int u = 0; u < 4; ++u) po[u] += __shfl_xor(po[u], 32);
                if (dg == 0) {
#pragma unroll
                    for (int u = 0; u < 4; ++u) Os[(tl0 + u) * 64 + 8 * w + vl] = po[u]; } }
        }
        __syncthreads();
        if (!PASSA) { const int t = tid >> 3, cc = tid & 7;
          if (t < n) { const int row = row0 + c0 + t;
            const f32x4 o0 = *(const f32x4*)(Os + t * 64 + 8 * cc), o1 = *(const f32x4*)(Os + t * 64 + 8 * cc + 4);
            float o[8] = {o0.x, o0.y, o0.z, o0.w, o1.x, o1.y, o1.z, o1.w};
            float s = 0.f;
#pragma unroll
            for (int i = 0; i < 8; ++i) s += o[i];
            s += __shfl_xor(s, 1); s += __shfl_xor(s, 2); s += __shfl_xor(s, 4);
            const float mu = s * (1.f / 64.f); float q = 0.f;
#pragma unroll
            for (int i = 0; i < 8; ++i) { o[i] -= mu; q += o[i] * o[i]; }
            q += __shfl_xor(q, 1); q += __shfl_xor(q, 2); q += __shfl_xor(q, 4);
            const float rstd = rsqrtf(q * (1.f / 64.f) + EPS);
            const u32x4 gv = *(const u32x4*)(c.PROJ() + (size_t)row * NPROJ + C_RG + h * 64 + 8 * cc);
            const float gt[8] = {bflo(gv.x), bfhi(gv.x), bflo(gv.y), bfhi(gv.y), bflo(gv.z), bfhi(gv.z), bflo(gv.w), bfhi(gv.w)};
            float r[8];
#pragma unroll
            for (int i = 0; i < 8; ++i) r[i] = (o[i] * rstd * rg_g[8 * cc + i] + rg_b[8 * cc + i]) * silu(gt[i]);
            u32x4 wv; wv.x = pk2(r[0], r[1]); wv.y = pk2(r[2], r[3]); wv.z = pk2(r[4], r[5]); wv.w = pk2(r[6], r[7]);
            *(u32x4*)(c.XN() + (size_t)row * D + h * 64 + 8 * cc) = wv; } }
    }
    if (PASSA) { float* E = c.SEG() + SEG_RET / 4 + (size_t)((b * 6 + h) * (NSEG - 1) + seg) * 4096 + (8 * dg) * 64 + 8 * w + vl;
#pragma unroll
        for (int i = 0; i < 8; ++i) E[i * 64] = S[i]; }
    else if (sample || seg == NSEG - 1) {
        float* so = c.out() + (sample ? O_RETS + ((size_t)(l * DB + b) * 6 + h) * 4096 : O_RETP + ((size_t)(l * NB + b) * 6 + h) * 4096) + (8 * dg) * 64 + 8 * w + vl;
#pragma unroll
        for (int i = 0; i < 8; ++i) so[i * 64] = S[i]; }
}

template <bool PASSA>
__device__ __forceinline__ void gla_task(const Ctx& c, int l, bool sample, int b, int h, int seg, float* L) {
    const int tid = c.tid, lane = c.lane, w = c.wave;
    const int vl = lane % 12, dgr = lane / 12, dg = dgr > 3 ? 3 : dgr;
    const int len = sample ? DSEQ : LSEG;
    const int row0 = sample ? TP + b * DSEQ : b * SEQ + seg * LSEG;
    float* Qs = L; float* Ks = L + 3072; float* As = L + 6144; float* Vs = L + 9216; float* Os = L + 15360; float* GW = L + 21504; float* DS = L + 22272;
    for (int i = tid; i < 768; i += 512) { const int r = i / 48, d = i % 48; GW[i] = c.in(I_GGW)[(size_t)(l * 16 + r) * 192 + h * 48 + d]; }
    if (tid < 48) DS[tid] = 0.f;
    float S[12];
    const int vcol = 12 * w + vl;
    if (sample) { const float* s0 = c.in(I_SGLA) + ((size_t)((l * DB + b) * 4 + h) * 48 + 12 * dg) * 96 + vcol;
#pragma unroll
        for (int i = 0; i < 12; ++i) S[i] = s0[i * 96]; }
    else {
#pragma unroll
        for (int i = 0; i < 12; ++i) S[i] = 0.f;
        if (!PASSA) for (int m = 0; m < seg; ++m) { const float* E = c.SEG() + SEG_GLA / 4 + (size_t)((b * 4 + h) * (NSEG - 1) + m) * 4672;
#pragma unroll
            for (int i = 0; i < 12; ++i) S[i] = __expf(E[4608 + 12 * dg + i]) * S[i] + E[(12 * dg + i) * 96 + vcol]; }
    }
    const float* gb = c.in(I_GGB) + l * 192 + h * 48;
    const float* gng = c.in(I_GNG) + l * 96;
    __syncthreads();
    for (int c0 = 0; c0 < len; c0 += 64) {
        const int n = (len - c0) < 64 ? (len - c0) : 64;
        { const int t = tid >> 3, cc = tid & 7;
          if (t < n) { const bf16* pr = c.PROJ() + (size_t)(row0 + c0 + t) * NPROJ;
            const u32x4 g0 = *(const u32x4*)(pr + C_GLR), g1 = *(const u32x4*)(pr + C_GLR + 8);
            const float gl[16] = {bflo(g0.x), bfhi(g0.x), bflo(g0.y), bfhi(g0.y), bflo(g0.z), bfhi(g0.z), bflo(g0.w), bfhi(g0.w),
                                  bflo(g1.x), bfhi(g1.x), bflo(g1.y), bfhi(g1.y), bflo(g1.z), bfhi(g1.z), bflo(g1.w), bfhi(g1.w)};
#pragma unroll
            for (int j = 0; j < 6; ++j) { const int d = 6 * cc + j; float x = gb[d];
#pragma unroll
                for (int r = 0; r < 16; ++r) x = fmaf(gl[r], GW[r * 48 + d], x);
                const float lg = (fminf(x, 0.f) - __logf(1.f + __expf(-fabsf(x)))) * (1.f / 16.f);
                As[t * 48 + d] = __expf(lg);
                if (PASSA) atomicAdd(&DS[d], lg); }
            const unsigned* kq = (const unsigned*)(pr + C_GK + h * 48 + 6 * cc);
#pragma unroll
            for (int j = 0; j < 3; ++j) { const unsigned wv = kq[j]; Ks[t * 48 + 6 * cc + 2 * j] = bflo(wv); Ks[t * 48 + 6 * cc + 2 * j + 1] = bfhi(wv); }
            if (!PASSA) { const unsigned* qq = (const unsigned*)(pr + C_GQ + h * 48 + 6 * cc);
#pragma unroll
                for (int j = 0; j < 3; ++j) { const unsigned wv = qq[j]; Qs[t * 48 + 6 * cc + 2 * j] = bflo(wv) * 0.14433756729740643f; Qs[t * 48 + 6 * cc + 2 * j + 1] = bfhi(wv) * 0.14433756729740643f; } }
            const u32x2* vp = (const u32x2*)(pr + C_GV + h * 96 + 12 * cc);
#pragma unroll
            for (int j = 0; j < 3; ++j) { const u32x2 wv = vp[j]; *(f32x4*)(Vs + t * 96 + 12 * cc + 4 * j) = (f32x4){bflo(wv.x), bfhi(wv.x), bflo(wv.y), bfhi(wv.y)}; } } }
        __syncthreads();
        for (int tl0 = 0; tl0 < n; tl0 += 4) {
            float po[4];
#pragma unroll
            for (int u = 0; u < 4; ++u) { const int tl = tl0 + u;
                const f32x4* kp = (const f32x4*)(Ks + tl * 48 + 12 * dg); const f32x4* ap = (const f32x4*)(As + tl * 48 + 12 * dg);
                const f32x4 k0 = kp[0], k1 = kp[1], k2 = kp[2], a0 = ap[0], a1 = ap[1], a2 = ap[2];
                const float vv = Vs[tl * 96 + vcol];
                const float kk[12] = {k0.x, k0.y, k0.z, k0.w, k1.x, k1.y, k1.z, k1.w, k2.x, k2.y, k2.z, k2.w};
                const float aa[12] = {a0.x, a0.y, a0.z, a0.w, a1.x, a1.y, a1.z, a1.w, a2.x, a2.y, a2.z, a2.w};
#pragma unroll
                for (int i = 0; i < 12; ++i) S[i] = fmaf(aa[i], S[i], kk[i] * vv);
                if (!PASSA) {
                    const f32x4* qp = (const f32x4*)(Qs + tl * 48 + 12 * dg); const f32x4 q0 = qp[0], q1 = qp[1], q2 = qp[2];
                    po[u] = q0.x * S[0] + q0.y * S[1] + q0.z * S[2] + q0.w * S[3] + q1.x * S[4] + q1.y * S[5] + q1.z * S[6] + q1.w * S[7] + q2.x * S[8] + q2.y * S[9] + q2.z * S[10] + q2.w * S[11]; } }
            if (!PASSA) {
#pragma unroll
                for (int u = 0; u < 4; ++u) po[u] += __shfl(po[u], (lane + 24) & 63);
#pragma unroll
                for (int u = 0; u < 4; ++u) po[u] += __shfl(po[u], (lane + 12) & 63);
                if (lane < 12) {
#pragma unroll
                    for (int u = 0; u < 4; ++u) Os[(tl0 + u) * 96 + vcol] = po[u]; } }
        }
        __syncthreads();
        if (!PASSA) { const int t = tid >> 3, cc = tid & 7;
          if (t < n) { const int row = row0 + c0 + t;
            const f32x4* op = (const f32x4*)(Os + t * 96 + 12 * cc); const f32x4 o0 = op[0], o1 = op[1], o2 = op[2];
            const float o[12] = {o0.x, o0.y, o0.z, o0.w, o1.x, o1.y, o1.z, o1.w, o2.x, o2.y, o2.z, o2.w};
            float q = 0.f;
#pragma unroll
            for (int i = 0; i < 12; ++i) q += o[i] * o[i];
            q += __shfl_xor(q, 1); q += __shfl_xor(q, 2); q += __shfl_xor(q, 4);
            const float rs = rsqrtf(q * (1.f / 96.f) + EPS);
            const u32x2* gp = (const u32x2*)(c.PROJ() + (size_t)row * NPROJ + C_GG + h * 96 + 12 * cc);
            u32x2* dst = (u32x2*)(c.XN() + (size_t)row * D + 640 + h * 96 + 12 * cc);
#pragma unroll
            for (int j = 0; j < 3; ++j) { const u32x2 gv = gp[j];
                const float r0 = o[4 * j] * rs * gng[12 * cc + 4 * j] * silu(bflo(gv.x)), r1 = o[4 * j + 1] * rs * gng[12 * cc + 4 * j + 1] * silu(bfhi(gv.x));
                const float r2 = o[4 * j + 2] * rs * gng[12 * cc + 4 * j + 2] * silu(bflo(gv.y)), r3 = o[4 * j + 3] * rs * gng[12 * cc + 4 * j + 3] * silu(bfhi(gv.y));
                u32x2 wv; wv.x = pk2(r0, r1); wv.y = pk2(r2, r3); dst[j] = wv; } } }
    }
    if (PASSA) { float* E = c.SEG() + SEG_GLA / 4 + (size_t)((b * 4 + h) * (NSEG - 1) + seg) * 4672;
        if (lane < 48) {
#pragma unroll
            for (int i = 0; i < 12; ++i) E[(12 * dg + i) * 96 + vcol] = S[i]; }
        if (tid < 48) E[4608 + tid] = DS[tid]; }
    else if (sample || seg == NSEG - 1) {
        float* so = c.out() + (sample ? O_GLAS + ((size_t)(l * DB + b) * 4 + h) * 4608 : O_GLAP + ((size_t)(l * NB + b) * 4 + h) * 4608);
        if (lane < 48) {
#pragma unroll
            for (int i = 0; i < 12; ++i) so[(12 * dg + i) * 96 + vcol] = S[i]; } }
}

template <bool GLA, bool PASSA>
__device__ __forceinline__ void lin_task(const Ctx& c, int l, int b, int h, int seg, float* L) {
    typedef short bf16x8_t __attribute__((ext_vector_type(8)));
    constexpr int DK = GLA ? 48 : 64, DV = GLA ? 96 : 64, NVT = DV / 16, NT = GLA ? 3 : 2, RS = 72;
    const int tid = c.tid, lane = c.lane, w = c.wave, fr = lane & 15, fq = lane >> 4;
    const int row0 = b * SEQ + seg * LSEG;
    bf16* QT = (bf16*)L; bf16* KT = QT + 64 * RS; bf16* KH = KT + 64 * RS; bf16* VT = KH + 64 * RS; bf16* PP = VT + 96 * RS; bf16* ST = PP + 64 * RS;
    float* Os = (float*)(ST + 96 * RS); float* LG = Os + 64 * 96; float* SEGS = LG + 64 * 48; float* BEND = SEGS + 8 * 48; float* GW = BEND + 64;
    const float gamma = 1.f - exp2f(-5.f - (float)h), lg2 = log2f(gamma);
    if (GLA) {
        for (int i = tid; i < 16 * RS; i += 512) KH[48 * RS + i] = 0;
        if (tid < 16) BEND[48 + tid] = 0.f;
    }
    pg8::f32x4 accS[NT];
#pragma unroll
    for (int i = 0; i < NT; ++i) { const int id = w * NT + i, dt = id / NVT, vt = id % NVT, d0 = 16 * dt + 4 * fq, v = 16 * vt + fr;
        accS[i] = (pg8::f32x4){0.f, 0.f, 0.f, 0.f};
        if (!PASSA) {
            if (!GLA) {
#pragma unroll
                for (int m = 0; m < NSEG - 1; ++m) { if (m >= seg) break; const float f = exp2f((float)(LSEG * (seg - 1 - m)) * lg2);
                    const float* E = c.SEG() + SEG_RET / 4 + (size_t)((b * 6 + h) * (NSEG - 1) + m) * 4096;
                    const f32x4 ev = *(const f32x4*)(E + v * 64 + d0);
#pragma unroll
                    for (int r = 0; r < 4; ++r) accS[i][r] += f * ev[r]; } }
            else if (d0 < 48) {
#pragma unroll
                for (int m = 0; m < NSEG - 1; ++m) { if (m >= seg) break; const float* E = c.SEG() + SEG_GLA / 4 + (size_t)((b * 4 + h) * (NSEG - 1) + m) * 4672;
                    const f32x4 dl4 = *(const f32x4*)(E + 4608 + d0), ev4 = *(const f32x4*)(E + v * 48 + d0);
#pragma unroll
                    for (int r = 0; r < 4; ++r) accS[i][r] = m < seg ? __expf(dl4[r]) * accS[i][r] + ev4[r] : accS[i][r]; } }
            u32x2 sv; sv.x = pk2(accS[i][0], accS[i][1]); sv.y = pk2(accS[i][2], accS[i][3]); *(u32x2*)(ST + v * RS + d0) = sv;
        } }
    float dlsum[6] = {0.f, 0.f, 0.f, 0.f, 0.f, 0.f};
    const float* gb = c.in(I_GGB) + l * 192 + h * 48;
    const int gt0 = w, gt1 = w + 8, gmt0 = gt0 / 3, gnt0 = gt0 % 3, gmt1 = (gt1 < 12 ? gt1 : 0) / 3, gnt1 = (gt1 < 12 ? gt1 : 0) % 3;
    bf16x8_t gwf0 = {0, 0, 0, 0, 0, 0, 0, 0}, gwf1 = {0, 0, 0, 0, 0, 0, 0, 0};
    if (GLA && fq < 2) { const float* gw = c.in(I_GGW) + (size_t)(l * 16 + 8 * fq) * 192 + h * 48 + fr;
        float t0[8], t1[8];
#pragma unroll
        for (int j = 0; j < 8; ++j) { t0[j] = gw[(size_t)j * 192 + 16 * gnt0]; t1[j] = gw[(size_t)j * 192 + 16 * gnt1]; }
        u32x4 a = {pk2(t0[0], t0[1]), pk2(t0[2], t0[3]), pk2(t0[4], t0[5]), pk2(t0[6], t0[7])}, bq = {pk2(t1[0], t1[1]), pk2(t1[2], t1[3]), pk2(t1[4], t1[5]), pk2(t1[6], t1[7])};
        gwf0 = __builtin_bit_cast(bf16x8_t, a); gwf1 = __builtin_bit_cast(bf16x8_t, bq); }
    __syncthreads();
    const int t = tid >> 3, cc = tid & 7;
    u32x2 r_klo, r_khi, r_qlo, r_qhi; u32x4 r_v4, r_g4; f32x4 r_cs, r_sn;
    u32x4 r_glr0 = {0u, 0u, 0u, 0u}, r_glr1 = {0u, 0u, 0u, 0u}; unsigned r_k[3], r_q[3]; u32x2 r_v2[3], r_g2[3];
#define LIN_LOAD(cn) do { const bf16* pr_ = c.PROJ() + (size_t)(row0 + (cn) + t) * NPROJ; \
        if (!GLA) { const float* rc_ = c.ROPE() + (size_t)(seg * LSEG + (cn) + t) * 32 + 4 * cc; r_cs = *(const f32x4*)rc_; r_sn = *(const f32x4*)(rc_ + 2052 * 32); \
            r_klo = *(const u32x2*)(pr_ + C_RK + h * 64 + 4 * cc); r_khi = *(const u32x2*)(pr_ + C_RK + h * 64 + 32 + 4 * cc); r_v4 = *(const u32x4*)(pr_ + C_RV + h * 64 + 8 * cc); \
            if (!PASSA) { r_qlo = *(const u32x2*)(pr_ + C_RQ + h * 64 + 4 * cc); r_qhi = *(const u32x2*)(pr_ + C_RQ + h * 64 + 32 + 4 * cc); r_g4 = *(const u32x4*)(pr_ + C_RG + h * 64 + 8 * cc); } } \
        else { if (fq < 2) { r_glr0 = *(const u32x4*)(c.PROJ() + (size_t)(row0 + (cn) + 16 * gmt0 + fr) * NPROJ + C_GLR + 8 * fq); if (gt1 < 12) r_glr1 = *(const u32x4*)(c.PROJ() + (size_t)(row0 + (cn) + 16 * gmt1 + fr) * NPROJ + C_GLR + 8 * fq); } \
            _Pragma("unroll") for (int j_ = 0; j_ < 3; ++j_) { r_k[j_] = ((const unsigned*)(pr_ + C_GK + h * 48 + 6 * cc))[j_]; r_v2[j_] = ((const u32x2*)(pr_ + C_GV + h * 96 + 12 * cc))[j_]; \
                if (!PASSA) { r_q[j_] = ((const unsigned*)(pr_ + C_GQ + h * 48 + 6 * cc))[j_]; r_g2[j_] = ((const u32x2*)(pr_ + C_GG + h * 96 + 12 * cc))[j_]; } } } } while (0)
    LIN_LOAD(0);
    for (int c0 = 0; c0 < LSEG; c0 += 64) {
        u32x4 g4c = {0u, 0u, 0u, 0u}; u32x2 g2c[3] = {{0u, 0u}, {0u, 0u}, {0u, 0u}};
        if (!PASSA) { if (!GLA) g4c = r_g4; else { g2c[0] = r_g2[0]; g2c[1] = r_g2[1]; g2c[2] = r_g2[2]; } }
        if (!GLA) {
            const f32x4 cs = r_cs, sn = r_sn;
            const float eq = __builtin_amdgcn_exp2f((float)(t + 1) * lg2), ek = __builtin_amdgcn_exp2f(-(float)(t + 1) * lg2) * 0.125f, eh = __builtin_amdgcn_exp2f((float)(63 - t) * lg2) * 0.125f;
            { const u32x2 lo = r_klo, hi = r_khi;
              const f32x4 x1 = {bflo(lo.x), bfhi(lo.x), bflo(lo.y), bfhi(lo.y)}, x2 = {bflo(hi.x), bfhi(hi.x), bflo(hi.y), bfhi(hi.y)};
              const f32x4 k1 = x1 * cs - x2 * sn, k2 = x1 * sn + x2 * cs;
              if (!PASSA) { u32x2 a; a.x = pk2(k1.x * ek, k1.y * ek); a.y = pk2(k1.z * ek, k1.w * ek); *(u32x2*)(KT + t * RS + 4 * cc) = a;
                            u32x2 bq; bq.x = pk2(k2.x * ek, k2.y * ek); bq.y = pk2(k2.z * ek, k2.w * ek); *(u32x2*)(KT + t * RS + 32 + 4 * cc) = bq; }
#pragma unroll
              for (int e = 0; e < 4; ++e) { KH[(4 * cc + e) * RS + t] = (bf16)f2bf(k1[e] * eh); KH[(32 + 4 * cc + e) * RS + t] = (bf16)f2bf(k2[e] * eh); } }
            if (!PASSA) { const u32x2 lo = r_qlo, hi = r_qhi;
              const f32x4 x1 = {bflo(lo.x), bfhi(lo.x), bflo(lo.y), bfhi(lo.y)}, x2 = {bflo(hi.x), bfhi(hi.x), bflo(hi.y), bfhi(hi.y)};
              const f32x4 q1 = (x1 * cs - x2 * sn) * eq, q2 = (x1 * sn + x2 * cs) * eq;
              u32x2 a; a.x = pk2(q1.x, q1.y); a.y = pk2(q1.z, q1.w); *(u32x2*)(QT + t * RS + 4 * cc) = a;
              u32x2 bq; bq.x = pk2(q2.x, q2.y); bq.y = pk2(q2.z, q2.w); *(u32x2*)(QT + t * RS + 32 + 4 * cc) = bq; }
            { const unsigned vw[4] = {r_v4.x, r_v4.y, r_v4.z, r_v4.w};
#pragma unroll
              for (int e = 0; e < 4; ++e) { VT[(8 * cc + 2 * e) * RS + t] = (bf16)(vw[e] & 0xffffu); VT[(8 * cc + 2 * e + 1) * RS + t] = (bf16)(vw[e] >> 16); } }
            if (c0 + 64 < LSEG) LIN_LOAD(c0 + 64);
        } else {
            float kf[6], qf[6]; unsigned vw[6];
            { { const pg8::f32x4 z4 = {0.f, 0.f, 0.f, 0.f};
                const pg8::f32x4 x0 = __builtin_amdgcn_mfma_f32_16x16x32_bf16(__builtin_bit_cast(bf16x8_t, r_glr0), gwf0, z4, 0, 0, 0);
                const float b0 = gb[16 * gnt0 + fr];
#pragma unroll
                for (int j = 0; j < 4; ++j) { const float x = x0[j] + b0; LG[(16 * gmt0 + 4 * fq + j) * 48 + 16 * gnt0 + fr] = (fminf(x, 0.f) - __logf(1.f + __expf(-fabsf(x)))) * (1.f / 16.f); }
                if (gt1 < 12) { const pg8::f32x4 x1 = __builtin_amdgcn_mfma_f32_16x16x32_bf16(__builtin_bit_cast(bf16x8_t, r_glr1), gwf1, z4, 0, 0, 0);
                    const float b1 = gb[16 * gnt1 + fr];
#pragma unroll
                    for (int j = 0; j < 4; ++j) { const float x = x1[j] + b1; LG[(16 * gmt1 + 4 * fq + j) * 48 + 16 * gnt1 + fr] = (fminf(x, 0.f) - __logf(1.f + __expf(-fabsf(x)))) * (1.f / 16.f); } } }
#pragma unroll
              for (int j = 0; j < 3; ++j) { const unsigned wv = r_k[j]; kf[2 * j] = bflo(wv); kf[2 * j + 1] = bfhi(wv); }
              if (!PASSA) {
#pragma unroll
                  for (int j = 0; j < 3; ++j) { const unsigned wv = r_q[j]; qf[2 * j] = bflo(wv) * 0.14433756729740643f; qf[2 * j + 1] = bfhi(wv) * 0.14433756729740643f; } }
#pragma unroll
              for (int j = 0; j < 3; ++j) { vw[2 * j] = r_v2[j].x; vw[2 * j + 1] = r_v2[j].y; } }
            if (c0 + 64 < LSEG) LIN_LOAD(c0 + 64);
            __syncthreads();
            if (tid < 384) { const int d = tid % 48, sg = tid / 48; float lv[8];
#pragma unroll
                for (int i = 0; i < 8; ++i) lv[i] = LG[(8 * sg + i) * 48 + d];
#pragma unroll
                for (int i = 1; i < 8; ++i) lv[i] += lv[i - 1];
#pragma unroll
                for (int i = 0; i < 8; ++i) LG[(8 * sg + i) * 48 + d] = lv[i];
                SEGS[sg * 48 + d] = lv[7]; }
            __syncthreads();
            { float qv[6], kv[6];
#pragma unroll
              for (int j = 0; j < 6; ++j) { const int d = 6 * cc + j; float pre = 0.f, tot = 0.f;
#pragma unroll
                for (int s = 0; s < 8; ++s) { const float sv = SEGS[s * 48 + d]; tot += sv; if (s < (t >> 3)) pre += sv; }
                pre += LG[t * 48 + d];
                if (!PASSA) { qv[j] = qf[j] * __expf(pre); kv[j] = kf[j] * __expf(-pre); }
                KH[d * RS + t] = (bf16)f2bf(kf[j] * __expf(tot - pre));
                if (t == 0) { BEND[d] = tot; dlsum[j] += tot; } }
              if (!PASSA) {
#pragma unroll
                for (int j = 0; j < 3; ++j) { *(unsigned*)(QT + t * RS + 6 * cc + 2 * j) = pk2(qv[2 * j], qv[2 * j + 1]); *(unsigned*)(KT + t * RS + 6 * cc + 2 * j) = pk2(kv[2 * j], kv[2 * j + 1]); } } }
            if (!PASSA) { *(unsigned*)(QT + t * RS + 48 + 2 * cc) = 0u; *(unsigned*)(KT + t * RS + 48 + 2 * cc) = 0u; }
#pragma unroll
            for (int e = 0; e < 6; ++e) { VT[(12 * cc + 2 * e) * RS + t] = (bf16)(vw[e] & 0xffffu); VT[(12 * cc + 2 * e + 1) * RS + t] = (bf16)(vw[e] >> 16); }
        }
        __syncthreads();
        __builtin_amdgcn_s_setprio(1);
        if (!PASSA) {
#pragma unroll
            for (int i = 0; i < 2; ++i) { const int id = 2 * w + i, it = id >> 2, jt = id & 3;
                pg8::f32x4 acc = {0.f, 0.f, 0.f, 0.f};
                if (jt <= it) {
#pragma unroll
                    for (int ks = 0; ks < 2; ++ks) { const bf16x8_t a = *(const bf16x8_t*)(KT + (16 * jt + fr) * RS + 32 * ks + 8 * fq), bq = *(const bf16x8_t*)(QT + (16 * it + fr) * RS + 32 * ks + 8 * fq);
                        acc = __builtin_amdgcn_mfma_f32_16x16x32_bf16(a, bq, acc, 0, 0, 0); } }
                { const int ii = 16 * it + fr, j0 = 16 * jt + 4 * fq;
                  u32x2 pw; pw.x = pk2(j0 <= ii ? acc[0] : 0.f, j0 + 1 <= ii ? acc[1] : 0.f); pw.y = pk2(j0 + 2 <= ii ? acc[2] : 0.f, j0 + 3 <= ii ? acc[3] : 0.f);
                  *(u32x2*)(PP + ii * RS + j0) = pw; } } }
#pragma unroll
        for (int i = 0; i < NT; ++i) { const int id = w * NT + i, dt = id / NVT, vt = id % NVT;
            if (GLA) {
#pragma unroll
                for (int r = 0; r < 4; ++r) accS[i][r] *= __expf(BEND[16 * dt + 4 * fq + r]); }
            else { const float g64 = exp2f(64.f * lg2); accS[i] = accS[i] * g64; }
#pragma unroll
            for (int ks = 0; ks < 2; ++ks) { const bf16x8_t a = *(const bf16x8_t*)(KH + (16 * dt + fr) * RS + 32 * ks + 8 * fq), bv = *(const bf16x8_t*)(VT + (16 * vt + fr) * RS + 32 * ks + 8 * fq);
                accS[i] = __builtin_amdgcn_mfma_f32_16x16x32_bf16(a, bv, accS[i], 0, 0, 0); } }
        __builtin_amdgcn_s_setprio(0);
        __syncthreads();
        __builtin_amdgcn_s_setprio(1);
        if (!PASSA) {
#pragma unroll
            for (int i = 0; i < NT; ++i) { const int id = w * NT + i, it = id / NVT, vt = id % NVT;
                pg8::f32x4 acc = {0.f, 0.f, 0.f, 0.f};
#pragma unroll
                for (int ks = 0; ks < 2; ++ks) { const bf16x8_t a = *(const bf16x8_t*)(PP + (16 * it + fr) * RS + 32 * ks + 8 * fq), bv = *(const bf16x8_t*)(VT + (16 * vt + fr) * RS + 32 * ks + 8 * fq);
                    acc = __builtin_amdgcn_mfma_f32_16x16x32_bf16(a, bv, acc, 0, 0, 0); }
#pragma unroll
                for (int ks = 0; ks < 2; ++ks) { const bf16x8_t a = *(const bf16x8_t*)(QT + (16 * it + fr) * RS + 32 * ks + 8 * fq), bs = *(const bf16x8_t*)(ST + (16 * vt + fr) * RS + 32 * ks + 8 * fq);
                    acc = __builtin_amdgcn_mfma_f32_16x16x32_bf16(a, bs, acc, 0, 0, 0); }
#pragma unroll
                for (int r = 0; r < 4; ++r) Os[(16 * it + 4 * fq + r) * DV + 16 * vt + fr] = acc[r]; } }
        __builtin_amdgcn_s_setprio(0);
        __syncthreads();
        if (!PASSA) {
#pragma unroll
            for (int i = 0; i < NT; ++i) { const int id = w * NT + i, dt = id / NVT, vt = id % NVT, d0 = 16 * dt + 4 * fq, v = 16 * vt + fr;
                u32x2 sv; sv.x = pk2(accS[i][0], accS[i][1]); sv.y = pk2(accS[i][2], accS[i][3]); *(u32x2*)(ST + v * RS + d0) = sv; }
            const int row = row0 + c0 + t;
            if (!GLA) {
                const f32x4 o0 = *(const f32x4*)(Os + t * 64 + 8 * cc), o1 = *(const f32x4*)(Os + t * 64 + 8 * cc + 4);
                float o[8] = {o0.x, o0.y, o0.z, o0.w, o1.x, o1.y, o1.z, o1.w};
                float s = 0.f;
#pragma unroll
                for (int i = 0; i < 8; ++i) s += o[i];
                s += __shfl_xor(s, 1); s += __shfl_xor(s, 2); s += __shfl_xor(s, 4);
                const float mu = s * (1.f / 64.f); float q = 0.f;
#pragma unroll
                for (int i = 0; i < 8; ++i) { o[i] -= mu; q += o[i] * o[i]; }
                q += __shfl_xor(q, 1); q += __shfl_xor(q, 2); q += __shfl_xor(q, 4);
                const float rstd = rsqrtf(q * (1.f / 64.f) + EPS);
                const float* rg_g = c.in(I_RNG) + l * 384 + h * 64; const float* rg_b = c.in(I_RNB) + l * 384 + h * 64;
                const u32x4 gv = g4c;
                const float gt[8] = {bflo(gv.x), bfhi(gv.x), bflo(gv.y), bfhi(gv.y), bflo(gv.z), bfhi(gv.z), bflo(gv.w), bfhi(gv.w)};
                float r[8];
#pragma unroll
                for (int i = 0; i < 8; ++i) r[i] = (o[i] * rstd * rg_g[8 * cc + i] + rg_b[8 * cc + i]) * silu(gt[i]);
                u32x4 wv; wv.x = pk2(r[0], r[1]); wv.y = pk2(r[2], r[3]); wv.z = pk2(r[4], r[5]); wv.w = pk2(r[6], r[7]);
                *(u32x4*)(c.XN() + (size_t)row * D + h * 64 + 8 * cc) = wv;
            } else {
                const float* gng = c.in(I_GNG) + l * 96;
                const f32x4* op = (const f32x4*)(Os + t * 96 + 12 * cc); const f32x4 o0 = op[0], o1 = op[1], o2 = op[2];
                const float o[12] = {o0.x, o0.y, o0.z, o0.w, o1.x, o1.y, o1.z, o1.w, o2.x, o2.y, o2.z, o2.w};
                float q = 0.f;
#pragma unroll
                for (int i = 0; i < 12; ++i) q += o[i] * o[i];
                q += __shfl_xor(q, 1); q += __shfl_xor(q, 2); q += __shfl_xor(q, 4);
                const float rs = rsqrtf(q * (1.f / 96.f) + EPS);
                u32x2* dst = (u32x2*)(c.XN() + (size_t)row * D + 640 + h * 96 + 12 * cc);
#pragma unroll
                for (int j = 0; j < 3; ++j) { const u32x2 gv = g2c[j];
                    const float r0 = o[4 * j] * rs * gng[12 * cc + 4 * j] * silu(bflo(gv.x)), r1 = o[4 * j + 1] * rs * gng[12 * cc + 4 * j + 1] * silu(bfhi(gv.x));
                    const float r2 = o[4 * j + 2] * rs * gng[12 * cc + 4 * j + 2] * silu(bflo(gv.y)), r3 = o[4 * j + 3] * rs * gng[12 * cc + 4 * j + 3] * silu(bfhi(gv.y));
                    u32x2 wv; wv.x = pk2(r0, r1); wv.y = pk2(r2, r3); dst[j] = wv; }
            }
        }
    }
    if (PASSA || seg == NSEG - 1) {
        float* E = PASSA ? c.SEG() + (GLA ? SEG_GLA / 4 + (size_t)((b * 4 + h) * (NSEG - 1) + seg) * 4672 : SEG_RET / 4 + (size_t)((b * 6 + h) * (NSEG - 1) + seg) * 4096)
                         : c.out() + (GLA ? O_GLAP + ((size_t)(l * NB + b) * 4 + h) * 4608 : O_RETP + ((size_t)(l * NB + b) * 6 + h) * 4096);
#pragma unroll
        for (int i = 0; i < NT; ++i) { const int id = w * NT + i, dt = id / NVT, vt = id % NVT, d0 = 16 * dt + 4 * fq, v = 16 * vt + fr;
            if (d0 < DK) {
                if (PASSA) *(f32x4*)(E + v * DK + d0) = (f32x4){accS[i][0], accS[i][1], accS[i][2], accS[i][3]};
                else {
#pragma unroll
                    for (int r = 0; r < 4; ++r) E[(d0 + r) * DV + v] = accS[i][r]; } } }
        if (GLA && PASSA && tid < 8) {
#pragma unroll
            for (int j = 0; j < 6; ++j) E[4608 + 6 * tid + j] = dlsum[j]; }
    }
}

template <bool PASSA>
__device__ __forceinline__ void s5_task(const Ctx& c, int l, bool sample, int b, int oct, int seg, float* L) {
    typedef short bf16x8_t __attribute__((ext_vector_type(8)));
    const int tid = c.tid, lane = c.lane, w = c.wave, fr = lane & 15, fq = lane >> 4;
    const int g = 8 * oct + w, p = lane;
    const int len = sample ? 64 : LSEG5;
    const int row0 = sample ? TP + b * 64 : b * SEQ + seg * LSEG5;
    constexpr int HS = 136;
    bf16* Ub = (bf16*)L;
    float* Xw = L + 4096 + w * 2048;
    bf16* Hw = (bf16*)(L + 20480) + w * (16 * HS);
    float ar, ai;
    bf16x8_t bx[8], cb[4];
    { const int gp = (l * 16 + g) * 64 + p;
      const float lr = fminf(c.in(I_LRE)[gp], -1e-4f), li = c.in(I_LIM)[gp], dt = expf(c.in(I_LDT)[l * 16 + g]);
      const float mag = expf(lr * dt), ang = li * dt; ar = mag * cosf(ang); ai = mag * sinf(ang);
      const float den = lr * lr + li * li, cr = ((ar - 1.f) * lr + ai * li) / den, ci = (ai * lr - (ar - 1.f) * li) / den;
#pragma unroll
      for (int n = 0; n < 8; ++n) { const int ps = 16 * (n & 3) + fr; const float crs = __shfl(cr, ps), cis = __shfl(ci, ps);
          u32x4 t4 = {0u, 0u, 0u, 0u};
          if (fq < 2) { const float* brp = c.in(I_BRE) + ((size_t)((l * 16 + g) * 64 + ps)) * 16 + 8 * fq; const float* bip = c.in(I_BIM) + ((size_t)((l * 16 + g) * 64 + ps)) * 16 + 8 * fq;
              const f32x4 r0 = *(const f32x4*)brp, r1 = *(const f32x4*)(brp + 4), i0 = *(const f32x4*)bip, i1 = *(const f32x4*)(bip + 4);
              float v[8];
#pragma unroll
              for (int e = 0; e < 4; ++e) { v[e] = n < 4 ? crs * r0[e] - cis * i0[e] : crs * i0[e] + cis * r0[e]; v[4 + e] = n < 4 ? crs * r1[e] - cis * i1[e] : crs * i1[e] + cis * r1[e]; }
              t4 = (u32x4){pk2(v[0], v[1]), pk2(v[2], v[3]), pk2(v[4], v[5]), pk2(v[6], v[7])}; }
          bx[n] = __builtin_bit_cast(bf16x8_t, t4); }
      if (!PASSA) {
#pragma unroll
          for (int s = 0; s < 4; ++s) { const float* src = (s < 2 ? c.in(I_CRE) : c.in(I_CIM)) + (size_t)((l * 16 + g) * 16 + fr) * 64 + 32 * (s & 1) + 8 * fq;
              const f32x4 v0 = *(const f32x4*)src, v1 = *(const f32x4*)(src + 4); const float sg = s < 2 ? 1.f : -1.f;
              u32x4 t4 = {pk2(sg * v0.x, sg * v0.y), pk2(sg * v0.z, sg * v0.w), pk2(sg * v1.x, sg * v1.y), pk2(sg * v1.z, sg * v1.w)}; cb[s] = __builtin_bit_cast(bf16x8_t, t4); } }
    }
    float hr = 0.f, hi = 0.f;
    float s0r[16], s0i[16];
    if (sample) {
#pragma unroll
        for (int j = 0; j < 16; ++j) { s0r[j] = c.in(I_S5R)[(size_t)(l * DB + 16 * b + j) * 1024 + g * 64 + p]; s0i[j] = c.in(I_S5I)[(size_t)(l * DB + 16 * b + j) * 1024 + g * 64 + p]; } }
    else {
        if (!PASSA && seg > 0) { float pr = ar, pi = ai;
#pragma unroll
            for (int k = 0; k < LOG2_LSEG5; ++k) { const float nr = pr * pr - pi * pi, ni = 2.f * pr * pi; pr = nr; pi = ni; }
            float er[NSEG5 - 1], ei[NSEG5 - 1];
#pragma unroll
            for (int m = 0; m < NSEG5 - 1; ++m) { const float* E = c.SEG() + SEG_S5 / 4 + (size_t)(b * (NSEG5 - 1) + m) * 2048 + g * 64 + p; er[m] = E[0]; ei[m] = E[1024]; }
#pragma unroll
            for (int m = 0; m < NSEG5 - 1; ++m) { if (m < seg) { const float nr = pr * hr - pi * hi + er[m], ni = pr * hi + pi * hr + ei[m]; hr = nr; hi = ni; } } }
    }
    static_assert(LSEG5 == (1 << LOG2_LSEG5), "A^LSEG5 squaring count");
    const float dval = c.in(I_S5D)[l * 256 + 128 * oct + 16 * w + fr];
    for (int c0 = 0; c0 < len; c0 += 64) {
        const int n = (len - c0) < 64 ? (len - c0) : 64;
        { const int t = tid >> 3, cc = tid & 7;
          if (t < n) { const bf16* pr = c.PROJ() + (size_t)(row0 + c0 + t) * NPROJ + C_SU + 128 * oct + 16 * cc;
            const u32x4 u0 = *(const u32x4*)pr, u1 = *(const u32x4*)(pr + 8);
            *(u32x4*)(Ub + t * 128 + 16 * cc) = u0; *(u32x4*)(Ub + t * 128 + 16 * cc + 8) = u1; } }
        __syncthreads();
#pragma unroll
        for (int tb = 0; tb < 64; tb += 16) { if (tb >= n) break;
            const int nb = (n - tb) < 16 ? (n - tb) : 16;
            { bf16x8_t a = {0, 0, 0, 0, 0, 0, 0, 0};
              if (fq < 2) a = *(const bf16x8_t*)(Ub + (tb + fr) * 128 + 16 * w + 8 * fq);
              __builtin_amdgcn_s_setprio(1);
#pragma unroll
              for (int n8 = 0; n8 < 8; ++n8) { const pg8::f32x4 z4 = {0.f, 0.f, 0.f, 0.f};
                  const pg8::f32x4 xa = __builtin_amdgcn_mfma_f32_16x16x32_bf16(a, bx[n8], z4, 0, 0, 0);
#pragma unroll
                  for (int j = 0; j < 4; ++j) Xw[(4 * fq + j) * 128 + 16 * n8 + fr] = xa[j]; } }
            __builtin_amdgcn_s_setprio(0);
            asm volatile("s_waitcnt lgkmcnt(0)" ::: "memory");
#pragma unroll
            for (int tt = 0; tt < 16; ++tt) { if (tt >= nb) break;
                if (sample && (tt & 3) == 0) { hr = s0r[(tb + tt) >> 2]; hi = s0i[(tb + tt) >> 2]; }
                typedef float f32x2 __attribute__((ext_vector_type(2)));
                f32x2 hn = (f32x2){Xw[tt * 128 + p], Xw[tt * 128 + 64 + p]} + (f32x2){hr, hi} * ar;
                hn += (f32x2){-hi, hr} * ai; hr = hn.x; hi = hn.y;
                if (!PASSA && sample && (tt & 3) == 3) { const size_t so = (size_t)(l * DB + 16 * b + ((tb + tt) >> 2)) * 1024 + g * 64 + p; c.out()[O_S5RS + so] = hr; c.out()[O_S5IS + so] = hi; }
                if (!PASSA) { const unsigned hh = pk2(hr, hi); Hw[tt * HS + p] = (bf16)(hh & 0xffffu); Hw[tt * HS + 64 + p] = (bf16)(hh >> 16); }
            }
            if (!PASSA) {
                asm volatile("s_waitcnt lgkmcnt(0)" ::: "memory");
                pg8::f32x4 acc = {0.f, 0.f, 0.f, 0.f};
#pragma unroll
                for (int s = 0; s < 4; ++s) { const bf16x8_t a = *(const bf16x8_t*)(Hw + fr * HS + 32 * s + 8 * fq);
                    acc = __builtin_amdgcn_mfma_f32_16x16x32_bf16(a, cb[s], acc, 0, 0, 0); }
#pragma unroll
                for (int j = 0; j < 4; ++j) { const int tq = 4 * fq + j;
                    if (tq < nb) { const int t = tb + tq; const float u = bflo((unsigned)Ub[t * 128 + 16 * w + fr]);
                        c.Y5()[(size_t)(row0 + c0 + t) * 256 + 128 * oct + 16 * w + fr] = (bf16)f2bf(gelu_tanh(acc[j] + dval * u)); } }
            }
            asm volatile("s_waitcnt lgkmcnt(0)" ::: "memory");
        }
        __syncthreads();
    }
    if (PASSA) { float* E = c.SEG() + SEG_S5 / 4 + (size_t)(b * (NSEG5 - 1) + seg) * 2048 + g * 64 + p; E[0] = hr; E[1024] = hi; }
    else if (sample) { }
    else if (seg == NSEG5 - 1) { c.out()[O_S5RP + (size_t)(l * NB + b) * 1024 + g * 64 + p] = hr; c.out()[O_S5IP + (size_t)(l * NB + b) * 1024 + g * 64 + p] = hi; }
}

__device__ __forceinline__ void ret_sample_wave(const Ctx& c, int l, int b, int h) {
    const int lane = c.lane, f = lane & 31;
    const float gamma = 1.f - exp2f(-5.f - (float)h);
    float S[64];
    const float* s0 = c.in(I_SRET) + ((size_t)((l * DB + b) * 6 + h) * 64) * 64 + lane;
#pragma unroll
    for (int d = 0; d < 64; ++d) { S[d] = s0[d * 64]; if ((d & 15) == 15) asm volatile("" ::: "memory"); }
    const float ng = c.in(I_RNG)[l * 384 + h * 64 + lane], nb = c.in(I_RNB)[l * 384 + h * 64 + lane];
#pragma unroll 1
    for (int t = 0; t < DSEQ; ++t) {
        const int row = TP + b * DSEQ + t;
        const bf16* pr = c.PROJ() + (size_t)row * NPROJ;
        const float cs = c.ROPE()[(2048 + t) * 32 + f], sn = c.ROPE()[2052 * 32 + (2048 + t) * 32 + f];
        const float ka = bflo((unsigned)pr[C_RK + h * 64 + f]), kb = bflo((unsigned)pr[C_RK + h * 64 + 32 + f]);
        const float qa = bflo((unsigned)pr[C_RQ + h * 64 + f]), qb = bflo((unsigned)pr[C_RQ + h * 64 + 32 + f]);
        const float kk = (lane < 32 ? ka * cs - kb * sn : ka * sn + kb * cs) * 0.125f;
        const float qq = lane < 32 ? qa * cs - qb * sn : qa * sn + qb * cs;
        const float vv = bflo((unsigned)pr[C_RV + h * 64 + lane]), gt = bflo((unsigned)pr[C_RG + h * 64 + lane]);
        float o = 0.f;
#pragma unroll
        for (int d = 0; d < 64; ++d) { const float kd = rdl(kk, d), qd = rdl(qq, d); S[d] = fmaf(gamma, S[d], kd * vv); o = fmaf(qd, S[d], o); }
        const float mu = wave_sum(o) * (1.f / 64.f), dv = o - mu, rstd = rsqrtf(wave_sum(dv * dv) * (1.f / 64.f) + EPS);
        c.XN()[(size_t)row * D + h * 64 + lane] = (bf16)f2bf((dv * rstd * ng + nb) * silu(gt));
    }
    float* so = c.out() + O_RETS + ((size_t)(l * DB + b) * 6 + h) * 4096 + lane;
#pragma unroll
    for (int d = 0; d < 64; ++d) { so[d * 64] = S[d]; if ((d & 15) == 15) asm volatile("" ::: "memory"); }
}
__device__ __forceinline__ void gla_sample_wave(const Ctx& c, int l, int b, int h) {
    const int lane = c.lane, l2 = 64 + (lane & 31), dl = lane < 48 ? lane : 47;
    float S1[48], S2[48];
    const float* s0 = c.in(I_SGLA) + ((size_t)((l * DB + b) * 4 + h) * 48) * 96;
#pragma unroll
    for (int d = 0; d < 48; ++d) { S1[d] = s0[d * 96 + lane]; S2[d] = s0[d * 96 + l2]; if ((d & 3) == 3) asm volatile("" ::: "memory"); }
    const float* gwp = c.in(I_GGW) + (size_t)(l * 16) * 192 + h * 48 + dl;
    const float gbd = c.in(I_GGB)[l * 192 + h * 48 + dl];
    const float n1 = c.in(I_GNG)[l * 96 + lane], n2 = c.in(I_GNG)[l * 96 + l2];
#pragma unroll 1
    for (int t = 0; t < DSEQ; ++t) {
        const int row = TP + b * DSEQ + t;
        const bf16* pr = c.PROJ() + (size_t)row * NPROJ;
        const u32x4 g0 = *(const u32x4*)(pr + C_GLR), g1 = *(const u32x4*)(pr + C_GLR + 8);
        const float gl[16] = {bflo(g0.x), bfhi(g0.x), bflo(g0.y), bfhi(g0.y), bflo(g0.z), bfhi(g0.z), bflo(g0.w), bfhi(g0.w),
                              bflo(g1.x), bfhi(g1.x), bflo(g1.y), bfhi(g1.y), bflo(g1.z), bfhi(g1.z), bflo(g1.w), bfhi(g1.w)};
        float x = gbd;
#pragma unroll
        for (int r = 0; r < 16; ++r) x = fmaf(gl[r], gwp[r * 192], x);
        const float al = __expf((fminf(x, 0.f) - __logf(1.f + __expf(-fabsf(x)))) * (1.f / 16.f));
        const float kk = lane < 48 ? bflo((unsigned)pr[C_GK + h * 48 + dl]) : 0.f;
        const float qq = lane < 48 ? bflo((unsigned)pr[C_GQ + h * 48 + dl]) * 0.14433756729740643f : 0.f;
        const float v1 = bflo((unsigned)pr[C_GV + h * 96 + lane]), v2 = bflo((unsigned)pr[C_GV + h * 96 + l2]);
        const float t1 = bflo((unsigned)pr[C_GG + h * 96 + lane]), t2 = bflo((unsigned)pr[C_GG + h * 96 + l2]);
        float o1 = 0.f, o2 = 0.f;
#pragma unroll
        for (int d = 0; d < 48; ++d) { const float ad = rdl(al, d), kd = rdl(kk, d), qd = rdl(qq, d);
            S1[d] = fmaf(ad, S1[d], kd * v1); o1 = fmaf(qd, S1[d], o1); S2[d] = fmaf(ad, S2[d], kd * v2); o2 = fmaf(qd, S2[d], o2); }
        const float rs = rsqrtf(wave_sum(o1 * o1 + (lane < 32 ? o2 * o2 : 0.f)) * (1.f / 96.f) + EPS);
        bf16* dst = c.XN() + (size_t)row * D + 640 + h * 96;
        dst[lane] = (bf16)f2bf(o1 * rs * n1 * silu(t1));
        if (lane < 32) dst[l2] = (bf16)f2bf(o2 * rs * n2 * silu(t2));
    }
    float* so = c.out() + O_GLAS + ((size_t)(l * DB + b) * 4 + h) * 4608;
#pragma unroll
    for (int d = 0; d < 48; ++d) { so[d * 96 + lane] = S1[d]; if (lane < 32) so[d * 96 + l2] = S2[d]; if ((d & 3) == 3) asm volatile("" ::: "memory"); }
}

struct OneUnit {
    int pm, pn;
    __device__ bool next(int i, pg8::Unit& u) const { if (i != 0) return false; u.pm = pm; u.pn = pn; u.ko = 0; return true; }
    __device__ __forceinline__ void a_ready(const pg8::Unit&) const {}
    __device__ __forceinline__ void done(const pg8::Unit&) const {}
};
#define MIX_QUEUE_BEGIN(NTASK, CTR) \
    volatile __attribute__((address_space(3))) unsigned* qw_ = (volatile __attribute__((address_space(3))) unsigned*)((PG8_LAS unsigned char*)L_las + 143360 + 64); \
    unsigned* ctr_ = (unsigned*)c0_.ap->ws + (CTR); \
    int qi_ = 0; \
    for (int task = c0_.bx; task < (NTASK); ) { \
        Ctx c = c0_; asm volatile("" : "+v"(c.tid)); c.lane = c.tid & 63; c.wave = __builtin_amdgcn_readfirstlane(c.tid >> 6); \
        unsigned nxt_ = 0u; if (c.tid == 0) nxt_ = __hip_atomic_fetch_add(ctr_, 1u, __ATOMIC_RELAXED, __HIP_MEMORY_SCOPE_AGENT); \
        int r = task;
#define MIX_QUEUE_END() \
        __syncthreads(); \
        if (c.tid == 0) qw_[qi_] = nxt_ + (unsigned)c0_.G; \
        __syncthreads(); \
        task = (int)qw_[qi_]; qi_ ^= 1; }

__device__ __forceinline__ void mixA_phase(const Ctx& c0_, int l, float* L, PG8_LAS unsigned char* L_las) {
    constexpr int NS = NSEG - 1, NS5 = NSEG5 - 1;
    constexpr int NQ = 24, NG = NB * NS * 4, N5 = NB * NS5 * 2, NR = NB * NS * 6;
    MIX_QUEUE_BEGIN(NQ + NG + N5 + NR, 8192 + 64 * (2 * l))
        if (r < NQ) {
            pg8::Gemm g{c.XN(), c.W1T(), MR, NPROJ, D, D, 256}; OneUnit S{TP / 256 + r / 12, r % 12};
            pg8::EpiBf16<0> E{c.PROJ(), NPROJ, nullptr, 0, 0, 1.f};
            pg8::gemm_phase<pg8::EpiBf16<0>, OneUnit, true, true>(L_las, g, S, E); }
        else if ((r -= NQ) < NG) { const int h = r % 4, seg = (r / 4) % NS, b = r / (4 * NS); lin_task<true, true>(c, l, b, h, seg, L); }
        else if ((r -= NG) < N5) { const int oct = r % 2, seg = (r / 2) % NS5, b = r / (2 * NS5); s5_task<true>(c, l, false, b, oct, seg, L); }
        else { r -= N5; const int h = r % 6, seg = (r / 6) % NS, b = r / (6 * NS); lin_task<false, true>(c, l, b, h, seg, L); }
    MIX_QUEUE_END()
}
__device__ __forceinline__ void mixC_phase(const Ctx& c0_, int l, float* L, PG8_LAS unsigned char* L_las) {
    constexpr int NG = NB * NSEG * 4, N5 = NB * NSEG5 * 2, NR = NB * NSEG * 6;
    constexpr int M5 = (TS / 64) * 2, MG = DB * 4 / 8, MRT = DB * 6 / 8;
    MIX_QUEUE_BEGIN(NG + N5 + NR + M5 + MG + MRT, 8192 + 64 * (2 * l + 1))
        if (r < NG) { const int h = r % 4, seg = (r / 4) % NSEG, b = r / (4 * NSEG); lin_task<true, false>(c, l, b, h, seg, L); }
        else if ((r -= NG) < N5) { const int oct = r % 2, seg = (r / 2) % NSEG5, b = r / (2 * NSEG5); s5_task<false>(c, l, false, b, oct, seg, L); }
        else if ((r -= N5) < NR) { const int h = r % 6, seg = (r / 6) % NSEG, b = r / (6 * NSEG); lin_task<false, false>(c, l, b, h, seg, L); }
        else if ((r -= NR) < M5) { s5_task<false>(c, l, true, r / 2, r % 2, 0, L); }
        else if ((r -= M5) < MG) { const int q = 8 * r + c.wave; gla_sample_wave(c, l, q / 4, q % 4); }
        else { r -= MG; const int q = 8 * r + c.wave; ret_sample_wave(c, l, q / 6, q % 6); }
    MIX_QUEUE_END()
}

__device__ __forceinline__ void act_phase(const Ctx& c, int l) {
    constexpr int JB = DFF / 8, RB = MR / 16;
    const int gt = c.bx * 512 + c.tid, ngt = c.G * 512;
    const float* cw = c.in(I_FCW) + (size_t)l * 3 * DFF; const float* cb = c.in(I_FCB) + (size_t)l * DFF;
    for (int it = gt; it < JB * RB; it += ngt) {
        const int jb = it % JB, rb = it / JB, j0 = 8 * jb, r0 = 16 * rb;
        float w0[8], w1[8], w2[8], bb[8];
#pragma unroll
        for (int e = 0; e < 8; ++e) { w0[e] = cw[j0 + e]; w1[e] = cw[DFF + j0 + e]; w2[e] = cw[2 * DFF + j0 + e]; bb[e] = cb[j0 + e]; }
        float x2[8], x1[8];
        const bool sample = r0 >= TP;
        for (int rr = 0; rr < 16; ++rr) {
            const int r = r0 + rr;
            const int t = sample ? ((r - TP) & 3) : (r & (SEQ - 1));
            if (rr == 0 || t == 0) {
                if (t >= 2) { const u32x4 a = *(const u32x4*)(c.ABUF() + (size_t)(r - 2) * DFF + j0), bq = *(const u32x4*)(c.ABUF() + (size_t)(r - 1) * DFF + j0);
                    x2[0] = bflo(a.x); x2[1] = bfhi(a.x); x2[2] = bflo(a.y); x2[3] = bfhi(a.y); x2[4] = bflo(a.z); x2[5] = bfhi(a.z); x2[6] = bflo(a.w); x2[7] = bfhi(a.w);
                    x1[0] = bflo(bq.x); x1[1] = bfhi(bq.x); x1[2] = bflo(bq.y); x1[3] = bfhi(bq.y); x1[4] = bflo(bq.z); x1[5] = bfhi(bq.z); x1[6] = bflo(bq.w); x1[7] = bfhi(bq.w); }
                else {
                    if (sample) { const float* cs = c.in(I_SCONV) + ((size_t)(l * DB + ((r - TP) >> 2)) * 2) * DFF + j0;
#pragma unroll
                        for (int e = 0; e < 8; ++e) { x2[e] = cs[e]; x1[e] = cs[DFF + e]; } }
                    else {
#pragma unroll
                        for (int e = 0; e < 8; ++e) { x2[e] = 0.f; x1[e] = 0.f; } } }
            }
            const u32x4 a = *(const u32x4*)(c.ABUF() + (size_t)r * DFF + j0);
            const u32x4 gq = *(const u32x4*)(c.GATE() + (size_t)r * DFF + j0);
            const float x0[8] = {bflo(a.x), bfhi(a.x), bflo(a.y), bfhi(a.y), bflo(a.z), bfhi(a.z), bflo(a.w), bfhi(a.w)};
            const float gv[8] = {bflo(gq.x), bfhi(gq.x), bflo(gq.y), bfhi(gq.y), bflo(gq.z), bfhi(gq.z), bflo(gq.w), bfhi(gq.w)};
            float o[8];
#pragma unroll
            for (int e = 0; e < 8; ++e) { const float cv = bb[e] + w0[e] * x2[e] + w1[e] * x1[e] + w2[e] * x0[e]; o[e] = gelu_tanh(cv) * gv[e]; x2[e] = x1[e]; x1[e] = x0[e]; }
            u32x4 wv; wv.x = pk2(o[0], o[1]); wv.y = pk2(o[2], o[3]); wv.z = pk2(o[4], o[5]); wv.w = pk2(o[6], o[7]);
            *(u32x4*)(c.GATE() + (size_t)r * DFF + j0) = wv;
        }
    }
}

#define XB_TMO      128
#define XB_XCNT(j)  (256  + 64 * (j))
#define XB_XSUB(j)  (1280 + 64 * (j))
#define XB_XGEN(j)  (2304 + 64 * (j))
#define XB_TOP      3328
#define XB_TOPGEN   3392
#define XCD_BAR_WORDS 3456
#define XB_SPIN_CAP (1u << 18)

__device__ __forceinline__ unsigned xb_ld(unsigned* p)              { return __hip_atomic_load(p, __ATOMIC_RELAXED, __HIP_MEMORY_SCOPE_AGENT); }
__device__ __forceinline__ unsigned xb_add(unsigned* p, unsigned v) { return __hip_atomic_fetch_add(p, v, __ATOMIC_RELAXED, __HIP_MEMORY_SCOPE_AGENT); }
__device__ __forceinline__ unsigned xb_xcc_id() { return (unsigned)__builtin_amdgcn_s_getreg((3 << 11) | 20) & 0xFu; }
#define XB_SPIN(cond, bar) do { unsigned _sp = 0; while (cond) { __builtin_amdgcn_s_sleep(1); \
    if ((++_sp & 255u) == 0u) { if (xb_ld(&(bar)[XB_TMO])) break; if (_sp > XB_SPIN_CAP) { atomicAdd(&(bar)[XB_TMO], 1u); break; } } } } while (0)

struct XcdBarrier {
    unsigned* bar; unsigned x;
    volatile __attribute__((address_space(3))) unsigned* st;
};

__device__ __forceinline__ XcdBarrier xcd_barrier_post(unsigned* bar, volatile __attribute__((address_space(3))) unsigned* st) {
    XcdBarrier b; b.bar = bar; b.x = xb_xcc_id(); b.st = st;
    if (threadIdx.x == 0) (void)xb_add(&bar[XB_XCNT(b.x)], 1u);
    return b;
}
__device__ __forceinline__ void xcd_barrier_complete(unsigned* bar, unsigned x, unsigned& nloc, unsigned& nx) {
    const unsigned G = gridDim.x * gridDim.y * gridDim.z;
    unsigned sum, cnt, mine, sp = 0u;
    for (;;) {
        sum = 0u; cnt = 0u; mine = 0u;
#pragma unroll
        for (unsigned j = 0; j < 16; ++j) { const unsigned c = xb_ld(&bar[XB_XCNT(j)]); sum += c; cnt += (c > 0u) ? 1u : 0u; mine = (j == x) ? c : mine; }
        if (sum == G) break;
        __builtin_amdgcn_s_sleep(1);
        if ((++sp & 255u) == 0u) { if (xb_ld(&bar[XB_TMO])) break; if (sp > XB_SPIN_CAP) { atomicAdd(&bar[XB_TMO], 1u); break; } }
    }
    nloc = mine > 0u ? mine : 1u; nx = cnt > 0u ? cnt : 1u;
}

__device__ __forceinline__ void xcd_barrier(const XcdBarrier& b) {
    asm volatile("s_waitcnt vmcnt(0)" ::: "memory");
    __syncthreads();
    if (threadIdx.x == 0) {
        unsigned* bar = b.bar;
        __builtin_amdgcn_s_waitcnt(0);
        unsigned nloc = b.st[0], nx = b.st[1];
        if (nloc == 0u) { xcd_barrier_complete(bar, b.x, nloc, nx); b.st[0] = nloc; b.st[1] = nx; }
        const unsigned old = xb_add(&bar[XB_XSUB(b.x)], 1u);
        const unsigned gen = old / nloc;
        if (old + 1u == (gen + 1u) * nloc) {
            __builtin_amdgcn_fence(__ATOMIC_RELEASE, "agent");
            asm volatile("s_waitcnt vmcnt(0)" ::: "memory");
            const unsigned og = xb_add(&bar[XB_TOP], 1u);
            const unsigned tg = og / nx;
            if (og + 1u == (tg + 1u) * nx) xb_add(&bar[XB_TOPGEN], 1u);
            else XB_SPIN(xb_ld(&bar[XB_TOPGEN]) == tg, bar);
            __builtin_amdgcn_fence(__ATOMIC_ACQUIRE, "agent");
            xb_add(&bar[XB_XGEN(b.x)], 1u);
            asm volatile("s_waitcnt vmcnt(0)" ::: "memory");
        } else {
            XB_SPIN(xb_ld(&bar[XB_XGEN(b.x)]) == gen, bar);
            __builtin_amdgcn_fence(__ATOMIC_ACQUIRE, "agent");
            asm volatile("s_waitcnt vmcnt(0)" ::: "memory");
        }
    }
    __syncthreads();
}

#define gsync(B) xcd_barrier(B)
template <int l>
__device__ __forceinline__ void layer_body(float* L, PG8_LAS unsigned char* ring, const XcdBarrier& grid) {

        { const Ctx c = mkctx(); prep_phase(c, l, L); }
        gsync(grid);
        {
            const Ctx c = mkctx();
            pg8::Gemm g{c.XN(), c.W1T(), TP, NPROJ, D, D, 256}; pg8::StaticOrder S; S.init(TP, NPROJ, c.G, c.bx);
            pg8::EpiBf16<0> E{c.PROJ(), NPROJ, nullptr, 0, 0, 1.f};
            pg8::gemm_phase<pg8::EpiBf16<0>, pg8::StaticOrder, true, true>(ring, g, S, E);
        }
        gsync(grid);
        if (NSEG > 1) { { const Ctx c = mkctx(); mixA_phase(c, l, L, ring); } gsync(grid); }
        { const Ctx c = mkctx(); mixC_phase(c, l, L, ring); }
        gsync(grid);
        {
            const Ctx c = mkctx();
            int kglu = 256; asm volatile("" : "+s"(kglu)); pg8::Gemm g{c.Y5(), c.GLUT(), MR, 256, 256, kglu, 256}; pg8::StaticOrder S; S.init(MR, 256, c.G, c.bx);
            EpiGlu E{c.Y5(), c.in(I_GLUB) + l * 256, c.XN()};
            pg8::gemm_phase<EpiGlu, pg8::StaticOrder, true, true>(ring, g, S, E);
        }
        gsync(grid);
        {
            const Ctx c = mkctx();
            pg8::Gemm g{c.XN(), c.W2T(), TP, D, D, D, 256}; pg8::StaticOrder S; S.init(TP, D, c.G, c.bx);
            EpiRes E{l == 0 ? c.in(I_XP) : (const float*)c.out(), l == 0 ? c.in(I_XS) : (const float*)(c.out() + (size_t)TP * D), c.out()};
            pg8::gemm_phase<EpiRes, pg8::StaticOrder, true, true>(ring, g, S, E);
            int ks_ = 256; asm volatile("" : "+s"(ks_));
            pg8::Gemm gt{c.XN(), c.W2T(), MR, D, D, ks_, 256}; TailOrder ST_; ST_.init(D / 256, c.G, c.bx);
            EpiPart EP{c.PART()};
            pg8::gemm_phase<EpiPart, TailOrder, true, true>(ring, gt, ST_, EP);
        }
        gsync(grid);
        { const Ctx c = mkctx(); const float* gg = c.in(I_NFG) + (size_t)l * D; float* xo = c.out(); bf16* xn = c.XN();
          for (int m = c.gw; m < TP; m += 2 * c.ngw) { const int m1 = m + c.ngw;
              if (m1 < TP) norm_rows2_bf16(xo + (size_t)m * D, xo + (size_t)m1 * D, gg, xn + (size_t)m * D, xn + (size_t)m1 * D, c.lane);
              else norm_row_bf16(xo + (size_t)m * D, gg, xn + (size_t)m * D, c.lane); }
          for (int m = TP + c.gw; m < MR; m += c.ngw)
              norm_row_bf16(l == 0 ? c.in(I_XS) + (size_t)(m - TP) * D : (const float*)(xo + (size_t)m * D), gg, xn + (size_t)m * D, c.lane, c.PART() + (size_t)(m - TP) * D, D / 256, xo + (size_t)m * D); }
        gsync(grid);
        {
            const Ctx c = mkctx();
            pg8::Gemm g{c.XN() - 2 * D, c.W3T(), 67 * 256, NUP, D, D, 254}; pg8::StaticOrder S; S.init(67 * 256, NUP, c.G, c.bx);
            EpiAct E{c.GATE(), c.out() + O_CONVP + (size_t)l * NB * 2 * DFF, c.out() + O_CONVS + (size_t)l * DB * 2 * DFF,
                     c.in(I_FCW) + (size_t)l * 3 * DFF, c.in(I_FCB) + (size_t)l * DFF, c.in(I_SCONV) + (size_t)l * DB * 2 * DFF, (PG8_LAS float*)(ring + 131072)};
            pg8::gemm_phase<EpiAct, pg8::StaticOrder, true, true>(ring, g, S, E);
        }
        gsync(grid);
        {
            const Ctx c = mkctx();
            pg8::Gemm g{c.GATE(), c.W4T(), TP, D, DFF, DFF, 256}; pg8::StaticOrder S; S.init(TP, D, c.G, c.bx);
            EpiRes E{c.out(), c.out() + (size_t)TP * D, c.out()};
            pg8::gemm_phase<EpiRes, pg8::StaticOrder, true, true>(ring, g, S, E);
            int ks_ = 256; asm volatile("" : "+s"(ks_));
            pg8::Gemm gt{c.GATE(), c.W4T(), MR, D, DFF, ks_, 256}; TailOrder ST_; ST_.init(DFF / 256, c.G, c.bx);
            EpiPart EP{c.PART()};
            pg8::gemm_phase<EpiPart, TailOrder, true, true>(ring, gt, ST_, EP);
        }
        gsync(grid);
    }

__global__ void __launch_bounds__(512, 2) fwd(Args args) {
    extern __shared__ __attribute__((aligned(16))) unsigned char lds[];
    float* L = (float*)lds;
    PG8_LAS unsigned char* ring = (PG8_LAS unsigned char*)lds;

    volatile __attribute__((address_space(3))) unsigned* bst = (volatile __attribute__((address_space(3))) unsigned*)((PG8_LAS unsigned char*)lds + 143360);
    if (threadIdx.x < 2) bst[threadIdx.x] = 0u;
    __syncthreads();
    unsigned* barw; { KArgs kp = (KArgs)__builtin_amdgcn_kernarg_segment_ptr(); barw = (unsigned*)kp->ws; }
    const XcdBarrier grid = xcd_barrier_post(barw, bst);
    cg::this_grid().sync();
    layer_body<0>(L, ring, grid);
    layer_body<1>(L, ring, grid);
    { const Ctx c = mkctx(); const float* gg = c.in(I_NFIN); float* xo = c.out();
      for (int m = c.gw; m < TP; m += 2 * c.ngw) { const int m1 = m + c.ngw;
          if (m1 < TP) norm_rows2_f32(xo + (size_t)m * D, xo + (size_t)m1 * D, gg, c.lane); else norm_row_f32(xo + (size_t)m * D, gg, c.lane); }
      for (int m = TP + c.gw; m < MR; m += c.ngw) norm_row_f32(xo + (size_t)m * D, gg, c.lane, c.PART() + (size_t)(m - TP) * D, DFF / 256); }
}
}

extern "C" void kernel_launch(void* const* d_in, const int* in_sizes, int n_in, void* d_out, int out_size, void* d_ws, size_t ws_size, hipStream_t stream) {
    static int grid = 0;
    if (grid == 0) {
        if (n_in != mk::N_IN || out_size != (int)mk::O_END || ws_size < mk::WS_END) { fprintf(stderr, "kernel_launch: unexpected sizes n_in %d out %d ws %zu (need %zu)\n", n_in, out_size, ws_size, (size_t)mk::WS_END); }
        int dev = 0, cus = 0, per_cu = 0;
        hipGetDevice(&dev); hipDeviceGetAttribute(&cus, hipDeviceAttributeMultiprocessorCount, dev);
        hipFuncSetAttribute((const void*)mk::fwd, hipFuncAttributeMaxDynamicSharedMemorySize, mk::LDS_BYTES);
        hipOccupancyMaxActiveBlocksPerMultiprocessor(&per_cu, (const void*)mk::fwd, 512, mk::LDS_BYTES);
        if (per_cu < 1) { fprintf(stderr, "kernel_launch: occupancy query says %d blocks per CU\n", per_cu); per_cu = 1; }
        grid = cus * 1;
        (void)hipGetLastError();
    }
    (void)hipMemsetAsync(d_ws, 0, 65536, stream);
    mk::Args a{};
    for (int i = 0; i < mk::N_IN; ++i) a.in[i] = (const float*)d_in[i];
    a.out = (float*)d_out; a.ws = (unsigned char*)d_ws;
    void* kargs[] = {&a};
    hipError_t e = hipLaunchCooperativeKernel((const void*)mk::fwd, dim3(grid), dim3(512), kargs, mk::LDS_BYTES, stream);
    if (e != hipSuccess) fprintf(stderr, "cooperative launch failed: %s (grid %d)\n", hipGetErrorString(e), grid);
}
```
